# Optimizing an MI355X kernel written in HIP

```python
import jax, jax.numpy as jnp
from jax import lax
import numpy as np

D_MODEL = 1024
BATCH = 8
SEQ = 4096
DEPTH = 1

A_HEADS = 8
A_HEAD_DIM = 64
A_W = A_HEADS * A_HEAD_DIM
IDX_HEADS = 8
IDX_DIM = 64
IDX_TOPK_MAX = 256
M_HEADS = 8
M_Q_RANK = 384
M_KV_RANK = 256
M_NOPE = 64
M_ROPE = 32
M_QK = M_NOPE + M_ROPE
M_V = 64
M_W = M_HEADS * M_V
P_HEADS = 8
P_NKEYS = 128
P_NEXP = P_NKEYS * P_NKEYS
P_DKEY = 256
P_TOPK = 16

ROPE_THETA = 10000.0
EPS = 1e-6
Q_BLOCK = 128
TOK_BLOCK = 128

IN_SPLITS = (A_W, A_W, A_W,
             IDX_HEADS * IDX_DIM, IDX_DIM, IDX_HEADS,
             M_Q_RANK, M_KV_RANK, M_ROPE,
             D_MODEL, D_MODEL)
IN_WIDTH = sum(IN_SPLITS)

kernel_name = "hybrid_dsa_mla_peer_adaln"


def rms_norm(x, g):
    xf = x.astype(jnp.float32)
    y = xf * lax.rsqrt(jnp.mean(xf * xf, axis=-1, keepdims=True) + EPS)
    return (y * g.astype(jnp.float32)).astype(x.dtype)


def rope(x, pos):
    d = x.shape[-1]
    half = d // 2
    inv = ROPE_THETA ** (-jnp.arange(half, dtype=jnp.float32) / half)
    ang = pos.astype(jnp.float32)[..., None] * inv
    ang = ang.reshape(ang.shape[:2] + (1,) * (x.ndim - 3) + (half,))
    cos, sin = jnp.cos(ang), jnp.sin(ang)
    xf = x.astype(jnp.float32)
    x1, x2 = xf[..., :half], xf[..., half:]
    return jnp.concatenate([x1 * cos - x2 * sin, x2 * cos + x1 * sin], axis=-1).astype(x.dtype)


def to_blocks(a, nb):
    return a.reshape((a.shape[0], nb, Q_BLOCK) + a.shape[2:]).swapaxes(0, 1)


def dsa_sparse_attention(q, k, v, qi, ki, wi):
    B, S, H, Dh = q.shape
    n_sel = min(IDX_TOPK_MAX, S // 4)
    nb = S // Q_BLOCK
    key_pos = jnp.arange(S)
    scale = Dh ** -0.5

    def block(args):
        qb, qib, wib, start = args
        t = start + jnp.arange(Q_BLOCK)
        causal = key_pos[None, :] <= t[:, None]
        dots = jnp.einsum('bqhd,bsd->bqhs', qib, ki, preferred_element_type=jnp.float32)
        score = jnp.einsum('bqhs,bqh->bqs', jax.nn.relu(dots), wib.astype(jnp.float32))
        score = jnp.where(causal[None], score, -jnp.inf)
        _, idx = lax.top_k(score, n_sel)
        valid = idx <= t[None, :, None]
        k_sel = jax.vmap(lambda kb, ib: kb[ib])(k, idx)
        v_sel = jax.vmap(lambda vb, ib: vb[ib])(v, idx)
        logits = jnp.einsum('bqhd,bqnhd->bhqn', qb, k_sel, preferred_element_type=jnp.float32) * scale
        logits = jnp.where(valid[:, None], logits, -jnp.inf)
        p = jax.nn.softmax(logits, axis=-1)
        return jnp.einsum('bhqn,bqnhd->bqhd', p.astype(v.dtype), v_sel)

    starts = jnp.arange(nb) * Q_BLOCK
    out = lax.map(block, (to_blocks(q, nb), to_blocks(qi, nb), to_blocks(wi, nb), starts))
    return out.swapaxes(0, 1).reshape(B, S, H, Dh)


def causal_block_attention(q, k, v):
    B, S, H, Dq = q.shape
    nb = S // Q_BLOCK
    key_pos = jnp.arange(S)
    scale = Dq ** -0.5

    def block(args):
        qb, start = args
        t = start + jnp.arange(Q_BLOCK)
        logits = jnp.einsum('bqhd,bshd->bhqs', qb, k, preferred_element_type=jnp.float32) * scale
        logits = jnp.where((key_pos[None, :] <= t[:, None])[None, None], logits, -jnp.inf)
        p = jax.nn.softmax(logits, axis=-1)
        return jnp.einsum('bhqs,bshd->bqhd', p.astype(v.dtype), v)

    starts = jnp.arange(nb) * Q_BLOCK
    out = lax.map(block, (to_blocks(q, nb), starts))
    return out.swapaxes(0, 1).reshape(B, S, H, v.shape[-1])


def peer(h, w_q, subkeys, u, v):
    B, S, D = h.shape
    q = (h @ w_q).reshape(B, S, P_HEADS, 2, P_DKEY // 2)
    s = jnp.einsum('bshpd,hpnd->bshpn', q, subkeys, preferred_element_type=jnp.float32)
    top_s, top_i = lax.top_k(s, P_TOPK)
    cand = (top_s[..., 0, :, None] + top_s[..., 1, None, :]).reshape(B, S, P_HEADS, P_TOPK * P_TOPK)
    cand_idx = (top_i[..., 0, :, None] * P_NKEYS + top_i[..., 1, None, :]).reshape(B, S, P_HEADS, P_TOPK * P_TOPK)
    best_s, best_pos = lax.top_k(cand, P_TOPK)
    expert = jnp.take_along_axis(cand_idx, best_pos, axis=-1)
    gate = jax.nn.softmax(best_s, axis=-1)
    T = B * S
    nb = T // TOK_BLOCK
    hb = h.reshape(nb, TOK_BLOCK, D)
    eb = expert.reshape(nb, TOK_BLOCK, P_HEADS * P_TOPK)
    gb = gate.reshape(nb, TOK_BLOCK, P_HEADS * P_TOPK)

    def block(args):
        ht, et, gt = args
        act = jax.nn.gelu(jnp.einsum('td,ted->te', ht, u[et], preferred_element_type=jnp.float32))
        coef = (gt * act).astype(v.dtype)
        return jnp.einsum('te,ted->td', coef, v[et])

    return lax.map(block, (hb, eb, gb)).reshape(B, S, D)


def hybrid_layer(x, c_act, pos, g_norm1, g_norm2, w_ada, b_ada, w_in, g_a_q, g_a_k, g_idx_k,
                 g_mq_a, w_mq_up, g_mkv_a, w_mkv_up, g_m_q, g_m_k, w_o_a, w_o_m, w_out,
                 w_peer_q, peer_subkeys, peer_u, peer_v):
    B, S, D = x.shape
    mod = (c_act @ w_ada + b_ada)[:, None, :]
    sh1, sc1, gt1, sh2, sc2, gt2 = jnp.split(mod, 6, axis=-1)

    h = rms_norm(x, g_norm1) * (1 + sc1) + sh1
    offs = [int(o) for o in np.cumsum(IN_SPLITS)[:-1]]
    qa, ka, va, qi, ki, wi, cq, ckv, kpe, ga, gm = jnp.split(h @ w_in, offs, axis=-1)

    qa = rope(rms_norm(qa.reshape(B, S, A_HEADS, A_HEAD_DIM), g_a_q), pos)
    ka = rope(rms_norm(ka.reshape(B, S, A_HEADS, A_HEAD_DIM), g_a_k), pos)
    va = va.reshape(B, S, A_HEADS, A_HEAD_DIM)
    qi = rope(qi.reshape(B, S, IDX_HEADS, IDX_DIM), pos)
    ki = rope(rms_norm(ki, g_idx_k), pos)
    wi = wi * (IDX_HEADS * IDX_DIM) ** -0.5
    ya = dsa_sparse_attention(qa, ka, va, qi, ki, wi).reshape(B, S, A_W) @ w_o_a

    qm = (rms_norm(cq, g_mq_a) @ w_mq_up).reshape(B, S, M_HEADS, M_QK)
    kv = (rms_norm(ckv, g_mkv_a) @ w_mkv_up).reshape(B, S, M_HEADS, M_NOPE + M_V)
    k_nope, vm = kv[..., :M_NOPE], kv[..., M_NOPE:]
    km = jnp.concatenate([k_nope, jnp.broadcast_to(kpe[:, :, None, :], (B, S, M_HEADS, M_ROPE))], axis=-1)
    qm = rms_norm(qm, g_m_q)
    km = rms_norm(km, g_m_k)
    qm = jnp.concatenate([qm[..., :M_NOPE], rope(qm[..., M_NOPE:], pos)], axis=-1)
    km = jnp.concatenate([km[..., :M_NOPE], rope(km[..., M_NOPE:], pos)], axis=-1)
    ym = causal_block_attention(qm, km, vm).reshape(B, S, M_W) @ w_o_m

    mixed = jax.nn.sigmoid(ga) * ya + jax.nn.sigmoid(gm) * ym
    x = x + gt1 * (mixed @ w_out)

    h2 = rms_norm(x, g_norm2) * (1 + sc2) + sh2
    x = x + gt2 * peer(h2, w_peer_q, peer_subkeys, peer_u, peer_v)
    return x


def setup_inputs(seed: int = 0) -> dict:
    key = jax.random.key(seed)
    ks = jax.random.split(key, 24)

    def nrm(k, shape, scale):
        return jax.random.normal(k, (DEPTH,) + shape, jnp.float32) * scale

    def gain(k, n):
        return 1.0 + 0.02 * jax.random.normal(k, (DEPTH, n), jnp.float32)

    x = jax.random.normal(ks[0], (BATCH, SEQ, D_MODEL), jnp.float32)
    c = jax.random.normal(ks[1], (BATCH, D_MODEL), jnp.float32)
    positions = jnp.broadcast_to(jnp.arange(SEQ, dtype=jnp.int32)[None, :], (BATCH, SEQ))
    return {
        "x": x,
        "c": c,
        "positions": positions,
        "g_norm1": gain(ks[2], D_MODEL),
        "g_norm2": gain(ks[3], D_MODEL),
        "w_ada": nrm(ks[4], (D_MODEL, 6 * D_MODEL), 0.5 * D_MODEL ** -0.5),
        "b_ada": nrm(ks[5], (6 * D_MODEL,), 0.02),
        "w_in": nrm(ks[6], (D_MODEL, IN_WIDTH), D_MODEL ** -0.5),
        "g_a_q": gain(ks[7], A_HEAD_DIM),
        "g_a_k": gain(ks[8], A_HEAD_DIM),
        "g_idx_k": gain(ks[9], IDX_DIM),
        "g_mq_a": gain(ks[10], M_Q_RANK),
        "w_mq_up": nrm(ks[11], (M_Q_RANK, M_HEADS * M_QK), M_Q_RANK ** -0.5),
        "g_mkv_a": gain(ks[12], M_KV_RANK),
        "w_mkv_up": nrm(ks[13], (M_KV_RANK, M_HEADS * (M_NOPE + M_V)), M_KV_RANK ** -0.5),
        "g_m_q": gain(ks[14], M_QK),
        "g_m_k": gain(ks[15], M_QK),
        "w_o_a": nrm(ks[16], (A_W, D_MODEL), A_W ** -0.5),
        "w_o_m": nrm(ks[17], (M_W, D_MODEL), M_W ** -0.5),
        "w_out": nrm(ks[18], (D_MODEL, D_MODEL), D_MODEL ** -0.5),
        "w_peer_q": nrm(ks[19], (D_MODEL, P_HEADS * P_DKEY), D_MODEL ** -0.5),
        "peer_subkeys": nrm(ks[20], (P_HEADS, 2, P_NKEYS, P_DKEY // 2), (P_DKEY // 2) ** -0.5),
        "peer_u": nrm(ks[21], (P_NEXP, D_MODEL), D_MODEL ** -0.5),
        "peer_v": nrm(ks[22], (P_NEXP, D_MODEL), P_HEADS ** -0.5),
    }


def reference(x, c, positions, g_norm1, g_norm2, w_ada, b_ada, w_in, g_a_q, g_a_k, g_idx_k,
              g_mq_a, w_mq_up, g_mkv_a, w_mkv_up, g_m_q, g_m_k, w_o_a, w_o_m, w_out,
              w_peer_q, peer_subkeys, peer_u, peer_v):
    c_act = jax.nn.silu(c)
    for i in range(DEPTH):
        x = hybrid_layer(x, c_act, positions, g_norm1[i], g_norm2[i], w_ada[i], b_ada[i], w_in[i],
                         g_a_q[i], g_a_k[i], g_idx_k[i], g_mq_a[i], w_mq_up[i], g_mkv_a[i],
                         w_mkv_up[i], g_m_q[i], g_m_k[i], w_o_a[i], w_o_m[i], w_out[i],
                         w_peer_q[i], peer_subkeys[i], peer_u[i], peer_v[i])
    return x
```

```cpp
#include <hip/hip_runtime.h>
#include <hip/hip_cooperative_groups.h>
#include <cstdio>
#include <cstdint>
namespace cg = cooperative_groups;

#define LAS __attribute__((address_space(3)))
typedef unsigned short bf16_t;
typedef short bf16x8 __attribute__((ext_vector_type(8)));
typedef short s16x4 __attribute__((ext_vector_type(4)));
typedef float f32x2 __attribute__((ext_vector_type(2)));
typedef float f32x4 __attribute__((ext_vector_type(4)));
typedef float f32x16 __attribute__((ext_vector_type(16)));
typedef unsigned u32x2 __attribute__((ext_vector_type(2)));
typedef unsigned u32x4 __attribute__((ext_vector_type(4)));
typedef __bf16 bf16x2_t __attribute__((ext_vector_type(2)));
typedef _Float16 f16x2 __attribute__((ext_vector_type(2)));

constexpr int NB = 8, SEQ = 4096, DM = 1024, T = NB * SEQ;
constexpr int AW = 512, NH = 8, HD = 64;
constexpr int QRANK = 384, KVRANK = 256, NOPE = 64, ROPED = 32, MQK = 96;
constexpr int IN_WIDTH = 4840, IN_PAD = 5120;
constexpr int PH = 8, PNK = 128, PNEXP = 16384, PDK = 256, PTOPK = 16;
constexpr int NSEL = 256;
constexpr float EPS = 1e-6f;
constexpr float LOG2E = 1.4426950408889634f;
constexpr float C2A = 0.125f * LOG2E;
constexpr float C2B = 0.10206207261596577f * LOG2E;

constexpr size_t MiB = 1u << 20;
constexpr size_t WS_ZERO = 0, ZERO_BYTES = 2 * MiB;
constexpr size_t WS_SSQ_CQ = 0;
constexpr size_t WS_SSQ_CKV = WS_SSQ_CQ + (size_t)T * 4;
constexpr size_t WS_SSQ_X1 = WS_SSQ_CKV + (size_t)T * 4;
constexpr size_t WS_SSQ_QM = WS_SSQ_X1 + (size_t)T * 4;
constexpr size_t WS_MOD = WS_SSQ_QM + (size_t)T * 8 * 4;
constexpr size_t WS_BIASQ = WS_MOD + (size_t)NB * 6144 * 4;
constexpr size_t WS_BAR = WS_BIASQ + (size_t)NB * 2048 * 4;
static_assert(WS_BAR + 3456 * 4 <= ZERO_BYTES, "zero region");
constexpr size_t WS_WIN = 3 * MiB;
constexpr size_t WS_WQUP = WS_WIN + (size_t)IN_PAD * DM * 2;
constexpr size_t WS_WKVUP = WS_WQUP + (size_t)768 * 384 * 2;
constexpr size_t WS_WOA = WS_WKVUP + (size_t)1024 * 256 * 2;
constexpr size_t WS_WOM = WS_WOA + (size_t)1024 * 512 * 2;
constexpr size_t WS_WOUT = WS_WOM + (size_t)1024 * 512 * 2;
constexpr size_t WS_WPQ = WS_WOUT + (size_t)1024 * 1024 * 2;
constexpr size_t WS_SUBK = WS_WPQ + (size_t)2048 * 1024 * 2;
constexpr size_t WS_ROPE32 = WS_SUBK + (size_t)16 * 128 * 128 * 2;
constexpr size_t WS_ROPE16 = WS_ROPE32 + (size_t)T * 64 * 4;
constexpr size_t WS_W_END = WS_ROPE16 + (size_t)T * 32 * 4;
static_assert(WS_W_END <= 36 * MiB, "weights region");
constexpr size_t R1 = 36 * MiB;
constexpr size_t WS_XN = R1, WS_QMN = R1, WS_QMR = R1 + 32 * MiB;
constexpr size_t R2 = 100 * MiB;
constexpr size_t WS_QA = R2, WS_KA = R2 + 32 * MiB, WS_VA = R2 + 64 * MiB, WS_QI = R2 + 96 * MiB, WS_PQ = R2;
constexpr size_t R3 = 228 * MiB;
constexpr size_t WS_GA = R3, WS_GM = R3 + 64 * MiB, WS_X1G = R3;
constexpr size_t R4 = 356 * MiB;
constexpr size_t WS_KMN = R4, WS_KMR = R4 + 32 * MiB, WS_VM = R4 + 48 * MiB, WS_PU = R4, WS_PV = R4 + 16 * MiB, WS_USC = R4 + 32 * MiB, WS_VSC = R4 + 33 * MiB;
constexpr size_t R5 = 436 * MiB;
constexpr size_t WS_CQ = R5, WS_CKV = R5 + 24 * MiB, WS_KI = R5 + 40 * MiB, WS_WI = R5 + 44 * MiB, WS_KPER = R5 + 45 * MiB,
                 WS_KPESSQ = R5 + 49 * MiB, WS_MASK = R5 + 50 * MiB, WS_MIXED = R5;
constexpr size_t WS_END = 502 * MiB;
static_assert(WS_MASK + (size_t)NB * 64 * SEQ * 8 <= WS_END, "ws map");

constexpr int LDS_BYTES = 155648;
constexpr int NWAVES = 8, NTHREADS = 512;

__device__ __forceinline__ unsigned cvt_pk_bf16(float lo, float hi) { unsigned r; asm volatile("v_cvt_pk_bf16_f32 %0, %1, %2" : "=v"(r) : "v"(lo), "v"(hi)); return r; }
__device__ __forceinline__ unsigned cvtpk_s(float lo, float hi) { f32x2 v = {lo, hi}; bf16x2_t b = __builtin_convertvector(v, bf16x2_t); return __builtin_bit_cast(unsigned, b); }
__device__ __forceinline__ float bf2f(unsigned short b) { return __uint_as_float((unsigned)b << 16); }
__device__ __forceinline__ float bflo(unsigned w) { return __uint_as_float(w << 16); }
__device__ __forceinline__ float bfhi(unsigned w) { return __uint_as_float(w & 0xffff0000u); }
__device__ __forceinline__ float rdlane_f(float v, int l) { return __int_as_float(__builtin_amdgcn_readlane(__float_as_int(v), l)); }
__device__ __forceinline__ float sigmoidf_(float v) { return __builtin_amdgcn_rcpf(1.0f + __builtin_amdgcn_exp2f(-v * LOG2E)); }
#define LDS_WAIT() asm volatile("s_waitcnt lgkmcnt(0)" ::: "memory")
#define VM_WAIT() asm volatile("s_waitcnt vmcnt(0)" ::: "memory")

namespace pg8 {
constexpr int BM = 256, BK = 64, HALF = 128, HTB = HALF * BK * 2, STAGE_BYTES = 8 * HTB, NXCD = 8, WGM = 8;
__host__ __device__ __forceinline__ int lds_byte(int r, int c) { const int st = (r >> 4) * 2 + (c >> 5), rr = r & 15, cc = c & 31, ob = rr * 64 + cc * 2; return st * 1024 + (ob ^ (((ob >> 9) & 1) << 5)); }
__host__ __device__ __forceinline__ void stage_rc(int b, int& R, int& C) { const int st = b / 1024, sb = b % 1024, swz = sb ^ (((sb >> 9) & 1) << 5); R = (st >> 1) * 16 + swz / 64; C = (st & 1) * 32 + (swz % 64) / 2; }

struct Unit { int pm, pn, tag; const char* A; const char* B; };

__device__ __forceinline__ bool tile_order(int L, int nM, int nN, int& pm, int& pn) {
    const int nwg = nM * nN; if (L >= nwg) return false;
    int wgid = L; { const int q = nwg / NXCD, r = nwg % NXCD, xcd = wgid % NXCD, off = wgid / NXCD; wgid = (xcd < r ? xcd * (q + 1) : r * (q + 1) + (xcd - r) * q) + off; }
    const int nig = WGM * nN, gid = wgid / nig, fm = gid * WGM, gsz = (nM - fm) < WGM ? (nM - fm) : WGM;
    pm = fm + ((wgid % nig) % gsz); pn = (wgid % nig) / gsz; return true;
}
struct StaticOrder {
    const char* A; const char* Bt; int nM, nN, G, c; size_t tstep;
    __device__ void init(const bf16_t* A_, const bf16_t* Bt_, int M, int N, int K, int G_, int c_) { A = (const char*)A_; Bt = (const char*)Bt_; nM = M / BM; nN = N / BM; G = G_; c = c_; tstep = (size_t)BM * K * 2; }
    __device__ __forceinline__ bool next(int i, Unit& u) const {
        int pm, pn; if (!tile_order(i * G + c, nM, nN, pm, pn)) return false;
        u.pm = pm; u.pn = pn; u.tag = 0; u.A = A + (size_t)pm * tstep; u.B = Bt + (size_t)pn * tstep; return true;
    }
};
struct DualOrder {
    const char* A0; const char* B0; const char* A1; const char* B1; int nM, nN, G, c; size_t tstep;
    __device__ __forceinline__ bool next(int i, Unit& u) const {
        int pm, pn; if (!tile_order((i >> 1) * G + c, nM, nN, pm, pn)) return false;
        u.pm = pm; u.pn = pn; u.tag = i & 1; u.A = ((i & 1) ? A1 : A0) + (size_t)pm * tstep; u.B = ((i & 1) ? B1 : B0) + (size_t)pn * tstep; return true;
    }
};

template <bool MERGE = false, class Epi, class Sched>
__device__ __forceinline__ void gemm_phase(LAS unsigned char* lds, const int K, const Sched& S, const Epi& E) {
    const int tid = threadIdx.x, wid = __builtin_amdgcn_readfirstlane(tid >> 6), lane = tid & 63, wr = wid >> 2, wc = wid & 3, fr = lane & 15, fq = lane >> 4;
    const int nt = K / BK;
    unsigned voffA[2];
#pragma unroll
    for (int i = 0; i < 2; ++i) { int R, C; stage_rc(tid * 16 + i * 8192, R, C); voffA[i] = (unsigned)(R * K + C) * 2u; }
    const size_t kstep = (size_t)(BK * 2);
    const size_t hstep = (size_t)HALF * K * 2;
    const unsigned ldsw = (unsigned)wid * 1024u;
    const int aoff = lds_byte(wr * 64 + fr, fq * 8), boff = lds_byte(wc * 32 + fr, fq * 8);
#define PG8_SA(b, h) (((b) * 2 + (h)) * HTB)
#define PG8_SB(b, h) ((4 + (b) * 2 + (h)) * HTB)
#define PG8_STAGE(bufoff, gbase) do { _Pragma("unroll") for (int _i = 0; _i < 2; ++_i) \
        __builtin_amdgcn_global_load_lds((const unsigned*)((const char*)(gbase) + voffA[_i]), (LAS unsigned*)(lds + (bufoff) + ldsw + _i * 8192), 16, 0, 0); } while (0)
#define PG8_LDA(dst, b, h) do { _Pragma("unroll") for (int m = 0; m < 4; ++m) _Pragma("unroll") for (int k = 0; k < 2; ++k) dst[m][k] = *(const LAS bf16x8*)(lds + PG8_SA(b, h) + aoff + m * 2048 + k * 1024); } while (0)
#define PG8_LDB(dst, b, h) do { _Pragma("unroll") for (int n = 0; n < 2; ++n) _Pragma("unroll") for (int k = 0; k < 2; ++k) dst[n][k] = *(const LAS bf16x8*)(lds + PG8_SB(b, h) + boff + n * 2048 + k * 1024); } while (0)
#define PG8_MMA(ai, bj, At, Bt) do { __builtin_amdgcn_s_setprio(1); _Pragma("unroll") for (int m = 0; m < 4; ++m) _Pragma("unroll") for (int n = 0; n < 2; ++n) _Pragma("unroll") for (int k = 0; k < 2; ++k) \
        acc[ai][bj][m][n] = __builtin_amdgcn_mfma_f32_16x16x32_bf16(Bt[n][k], At[m][k], acc[ai][bj][m][n], 0, 0, 0); __builtin_amdgcn_s_setprio(0); } while (0)
#define PG8_WAIT_V(n) asm volatile("s_waitcnt vmcnt(" #n ")" ::: "memory")
#define PG8_WAIT_L(n) asm volatile("s_waitcnt lgkmcnt(" #n ")" ::: "memory")
#define PG8_BAR __builtin_amdgcn_s_barrier()
#define PG8_SCHED __builtin_amdgcn_sched_barrier(0)
    Unit cur, nxt; int ui = 0;
    if (!S.next(0, cur)) return;
    f32x4 acc[2][2][4][2];
#pragma unroll
    for (int a = 0; a < 2; ++a)
#pragma unroll
        for (int b = 0; b < 2; ++b)
#pragma unroll
            for (int m = 0; m < 4; ++m)
#pragma unroll
                for (int n = 0; n < 2; ++n) acc[a][b][m][n] = (f32x4){0.f, 0.f, 0.f, 0.f};
    bf16x8 At[4][2], B0[2][2], B1[2][2];
    const char* cA = cur.A; const char* cB = cur.B;
    PG8_STAGE(PG8_SB(0, 0), cB); PG8_STAGE(PG8_SB(0, 1), cB + hstep); PG8_STAGE(PG8_SA(0, 0), cA); PG8_STAGE(PG8_SA(0, 1), cA + hstep);
    if (wr == 1) PG8_BAR;
    PG8_WAIT_V(2); PG8_BAR;
    PG8_STAGE(PG8_SB(1, 0), cB + kstep); PG8_STAGE(PG8_SA(1, 0), cA + kstep); PG8_STAGE(PG8_SB(1, 1), cB + hstep + kstep);
    PG8_WAIT_V(6); PG8_BAR;
    for (;;) {
        const bool has_next = S.next(ui + 1, nxt);
        const char* nA = has_next ? nxt.A : cA; const char* nB = has_next ? nxt.B : cB;
#pragma unroll 1
        for (int t = 0; t < nt; t += 2) {
            const bool last = (t == nt - 2);
            const char* a1 = cA + (size_t)(t + 1) * kstep;
            const char* a2 = last ? nA : cA + (size_t)(t + 2) * kstep; const char* b2 = last ? nB : cB + (size_t)(t + 2) * kstep;
            const char* a3 = a2 + kstep; const char* b3 = b2 + kstep;
            PG8_LDB(B0, 0, 0); PG8_LDB(B1, 0, 1); PG8_SCHED; PG8_LDA(At, 0, 0); PG8_STAGE(PG8_SA(1, 1), a1 + hstep);
            PG8_WAIT_V(8); PG8_WAIT_L(0); PG8_BAR; PG8_MMA(0, 0, At, B0); PG8_MMA(0, 1, At, B1); PG8_BAR; PG8_SCHED;
            PG8_LDA(At, 0, 1); PG8_STAGE(PG8_SB(0, 0), b2); PG8_STAGE(PG8_SB(0, 1), b2 + hstep); PG8_STAGE(PG8_SA(0, 0), a2);
            PG8_WAIT_V(8); PG8_WAIT_L(0); PG8_BAR; PG8_MMA(1, 0, At, B0); PG8_MMA(1, 1, At, B1); PG8_BAR; PG8_SCHED;
            PG8_LDB(B0, 1, 0); PG8_LDB(B1, 1, 1); PG8_SCHED; PG8_LDA(At, 1, 0); PG8_STAGE(PG8_SA(0, 1), a2 + hstep);
            PG8_WAIT_V(8); PG8_WAIT_L(0); PG8_BAR; PG8_MMA(0, 0, At, B0); PG8_MMA(0, 1, At, B1); PG8_BAR; PG8_SCHED;
            PG8_LDA(At, 1, 1); PG8_STAGE(PG8_SB(1, 0), b3); PG8_STAGE(PG8_SB(1, 1), b3 + hstep); PG8_STAGE(PG8_SA(1, 0), a3);
            PG8_WAIT_V(8); PG8_WAIT_L(0); PG8_BAR; PG8_MMA(1, 0, At, B0); PG8_MMA(1, 1, At, B1); PG8_BAR; PG8_SCHED;
        }
        if (wr == 0) PG8_BAR;
        bool keep = false;
        if constexpr (MERGE) { if (cur.tag == 0) { E.mid(acc, cur, wr, wc, fr, fq); keep = true; } else E(acc, cur, wr, wc, fr, fq); } else E(acc, cur, wr, wc, fr, fq);
        if (!has_next) break;
        if (!keep) {
#pragma unroll
        for (int a = 0; a < 2; ++a)
#pragma unroll
            for (int b = 0; b < 2; ++b)
#pragma unroll
                for (int m = 0; m < 4; ++m)
#pragma unroll
                    for (int n = 0; n < 2; ++n) acc[a][b][m][n] = (f32x4){0.f, 0.f, 0.f, 0.f};
        }
        cur = nxt; cA = nA; cB = nB; ++ui;
        if (wr == 1) PG8_BAR;
    }
    PG8_WAIT_V(0);
    PG8_BAR;
#undef PG8_SA
#undef PG8_SB
#undef PG8_STAGE
#undef PG8_LDA
#undef PG8_LDB
#undef PG8_MMA
#undef PG8_WAIT_V
#undef PG8_WAIT_L
#undef PG8_BAR
#undef PG8_SCHED
}
}

struct Args {
    const float* in[24]; float* out; unsigned char* ws; int ph_lo, ph_hi;
};
struct Frame {
    LAS unsigned char* lds; unsigned char* ws;
    int tid, lane, wave, G, bid;
    const float* in[24]; float* out;
};
#define IN_X 0
#define IN_C 1
#define IN_POS 2
#define IN_G1 3
#define IN_G2 4
#define IN_WADA 5
#define IN_BADA 6
#define IN_WIN 7
#define IN_GAQ 8
#define IN_GAK 9
#define IN_GIDXK 10
#define IN_GMQA 11
#define IN_WMQUP 12
#define IN_GMKVA 13
#define IN_WMKVUP 14
#define IN_GMQ 15
#define IN_GMK 16
#define IN_WOA 17
#define IN_WOM 18
#define IN_WOUT 19
#define IN_WPQ 20
#define IN_SUBK 21
#define IN_PU 22
#define IN_PV 23

__device__ __forceinline__ void gemv8_block(const float* vec, int vstride, bool silu, const float* W, int N, float* out, const float* bias, int cb, LAS float* red, int wave, int lane, int tid, int kbeg = 0, int nkc = 2, bool accumulate = false) {
    const int j = cb * 64 + lane;
    float acc[8];
#pragma unroll
    for (int b = 0; b < 8; ++b) acc[b] = 0.f;
#pragma unroll 1
    for (int kc = 0; kc < nkc; ++kc) {
        const int k0 = kbeg + wave * (64 * nkc) + kc * 64;
        float cv[8];
#pragma unroll
        for (int b = 0; b < 8; ++b) { float v = vec[(size_t)b * vstride + k0 + lane]; if (silu) v = v * sigmoidf_(v); cv[b] = v; }
#pragma unroll 8
        for (int kk = 0; kk < 64; ++kk) {
            const float w = W[(size_t)(k0 + kk) * N + j];
#pragma unroll
            for (int b = 0; b < 8; ++b) acc[b] += rdlane_f(cv[b], kk) * w;
        }
    }
#pragma unroll
    for (int b = 0; b < 8; ++b) red[(wave * 8 + b) * 64 + lane] = acc[b];
    __syncthreads();
    { const int b = tid >> 6, l = tid & 63; float s = bias ? bias[cb * 64 + l] : 0.f;
#pragma unroll
      for (int w = 0; w < 8; ++w) s += red[(w * 8 + b) * 64 + l];
      if (accumulate) atomicAdd(out + (size_t)b * N + cb * 64 + l, s); else out[(size_t)b * N + cb * 64 + l] = s; }
    __syncthreads();
}

__device__ __forceinline__ int headperm(int d, int wc) { return 128 * (d >> 5) + 32 * wc + (d & 31); }
__device__ __forceinline__ int dest_win(int c) {
    if (c < 2048) { const int seg = c >> 9, hc = c & 511, h = hc >> 6, d = hc & 63; return (2 * seg + (h >> 2)) * 256 + headperm(d, h & 3); }
    if (c < 2112) { const int d = c - 2048; return 8 * 256 + headperm(d, 0); }
    if (c < 2120) return 8 * 256 + 128 + 32 + (c - 2112);
    if (c < 2504) return 9 * 256 + (c - 2120);
    if (c < 2760) return 11 * 256 + (c - 2504);
    if (c < 2792) return 8 * 256 + 32 + (c - 2760);
    if (c < 3816) return 12 * 256 + (c - 2792);
    return 16 * 256 + (c - 3816);
}
__device__ __forceinline__ int dest_qup(int c) {
    const int h = c / 96, dd = c % 96;
    if (dd < 64) return (h >> 2) * 256 + headperm(dd, h & 3);
    return 512 + 128 * (h & 1) + 32 * (h >> 1) + (dd - 64);
}
__device__ __forceinline__ int dest_kvup(int c) {
    const int h = c >> 7, dd = c & 127;
    return ((dd >> 6) * 2 + (h >> 2)) * 256 + headperm(dd & 63, h & 3);
}
template <int MODE>
__device__ __forceinline__ void transpose_item(const float* W, int K, int N, bf16_t* WT, const float* kscale, LAS float* scr, int item, int lane) {
    const int nblk = (N + 31) / 32, kb = item / nblk, nb = item % nblk, k0 = 64 * kb, n0 = 32 * nb;
#pragma unroll 8
    for (int i = 0; i < 32; ++i) {
        const int kk = 2 * i + (lane >> 5), n = n0 + (lane & 31);
        float v = (n < N) ? W[(size_t)(k0 + kk) * N + n] : 0.f;
        if (kscale) v *= kscale[k0 + kk];
        scr[kk * 33 + (lane & 31)] = v;
    }
    LDS_WAIT(); asm volatile("" ::: "memory");
    const int c = lane & 7;
#pragma unroll
    for (int j = 0; j < 4; ++j) {
        const int nn = (lane >> 3) + 8 * j, n = n0 + nn;
        if (n < N) {
            const LAS float* s = scr + (8 * c) * 33 + nn;
            u32x4 o; o.x = cvtpk_s(s[0 * 33], s[1 * 33]); o.y = cvtpk_s(s[2 * 33], s[3 * 33]); o.z = cvtpk_s(s[4 * 33], s[5 * 33]); o.w = cvtpk_s(s[6 * 33], s[7 * 33]);
            const int d = (MODE == 0) ? n : (MODE == 1) ? dest_win(n) : (MODE == 2) ? dest_qup(n) : dest_kvup(n);
            *(u32x4*)(WT + (size_t)d * K + k0 + 8 * c) = o;
        }
    }
    LDS_WAIT(); asm volatile("" ::: "memory");
}
__device__ __forceinline__ void cvt_bf16_stream(const float* src, bf16_t* dst, size_t n, size_t gtid, size_t gthreads) {
    for (size_t i = gtid * 8; i < n; i += gthreads * 8) {
        const f32x4 a = *(const f32x4*)(src + i), b = *(const f32x4*)(src + i + 4);
        u32x4 o; o.x = cvtpk_s(a.x, a.y); o.y = cvtpk_s(a.z, a.w); o.z = cvtpk_s(b.x, b.y); o.w = cvtpk_s(b.z, b.w);
        *(u32x4*)(dst + i) = o;
    }
}
__device__ __forceinline__ void cvt_fp4_rows(const float* src, unsigned char* dst, float* inv, int nrows, int gw, int NGW, int lane) {
    for (int row = gw; row < nrows; row += NGW) {
        const f32x4* p = (const f32x4*)(src + (size_t)row * DM) + 4 * lane;
        f32x4 v[4]; float am = 0.f;
#pragma unroll
        for (int j = 0; j < 4; ++j) { v[j] = p[j]; am = __builtin_fmaxf(am, __builtin_fmaxf(__builtin_fmaxf(fabsf(v[j].x), fabsf(v[j].y)), __builtin_fmaxf(fabsf(v[j].z), fabsf(v[j].w)))); }
#pragma unroll
        for (int o = 1; o < 64; o <<= 1) am = __builtin_fmaxf(am, __shfl_xor(am, o));
        am = __builtin_fmaxf(am, 1e-30f);
        const float sc = 6.f / am;
        if (lane == 0) inv[row] = am * (1.f / 6.f);
        unsigned w0 = 0u, w1 = 0u;
        w0 = __builtin_amdgcn_cvt_scalef32_pk_fp4_f32(w0, v[0].x * sc, v[0].y * sc, 1.0f, 0); w0 = __builtin_amdgcn_cvt_scalef32_pk_fp4_f32(w0, v[0].z * sc, v[0].w * sc, 1.0f, 1);
        w0 = __builtin_amdgcn_cvt_scalef32_pk_fp4_f32(w0, v[1].x * sc, v[1].y * sc, 1.0f, 2); w0 = __builtin_amdgcn_cvt_scalef32_pk_fp4_f32(w0, v[1].z * sc, v[1].w * sc, 1.0f, 3);
        w1 = __builtin_amdgcn_cvt_scalef32_pk_fp4_f32(w1, v[2].x * sc, v[2].y * sc, 1.0f, 0); w1 = __builtin_amdgcn_cvt_scalef32_pk_fp4_f32(w1, v[2].z * sc, v[2].w * sc, 1.0f, 1);
        w1 = __builtin_amdgcn_cvt_scalef32_pk_fp4_f32(w1, v[3].x * sc, v[3].y * sc, 1.0f, 2); w1 = __builtin_amdgcn_cvt_scalef32_pk_fp4_f32(w1, v[3].z * sc, v[3].w * sc, 1.0f, 3);
        *((u32x2*)(dst + (size_t)row * (DM / 2)) + lane) = (u32x2){w0, w1};
    }
}
__device__ __forceinline__ void cvt_i4_rows(const float* src, unsigned char* dst, float* inv, int nrows, int gw, int NGW, int lane) {
    for (int row = gw; row < nrows; row += NGW) {
        const f32x4* p = (const f32x4*)(src + (size_t)row * DM) + 4 * lane;
        f32x4 v[4]; float am = 0.f;
#pragma unroll
        for (int j = 0; j < 4; ++j) { v[j] = p[j]; am = __builtin_fmaxf(am, __builtin_fmaxf(__builtin_fmaxf(fabsf(v[j].x), fabsf(v[j].y)), __builtin_fmaxf(fabsf(v[j].z), fabsf(v[j].w)))); }
#pragma unroll
        for (int o = 1; o < 64; o <<= 1) am = __builtin_fmaxf(am, __shfl_xor(am, o));
        am = __builtin_fmaxf(am, 1e-30f);
        const float sc = 9.5f / am;
        if (lane == 0) inv[row] = am * (1.f / 9.5f);
        unsigned w[2] = {0u, 0u};
#pragma unroll
        for (int j = 0; j < 4; ++j) {
#pragma unroll
            for (int e = 0; e < 4; ++e) { const float x = __builtin_amdgcn_fmed3f(__builtin_rintf(v[j][e] * sc), -7.f, 7.f); w[j >> 1] |= ((unsigned)(int)x & 15u) << (4 * (4 * (j & 1) + e)); }
        }
        *((u32x2*)(dst + (size_t)row * (DM / 2)) + lane) = (u32x2){w[0], w[1]};
    }
}
__device__ __forceinline__ void rope_cs(int pos, int i, int half, float& c, float& s) {
    const float inv = (float)exp(-9.210340371976184 * (double)i / (double)half);
    const float ang = (float)pos * inv;
    double x = (double)ang * 0.15915494309189535;
    x -= rint(x);
    const float xf = (float)x;
    c = __builtin_amdgcn_cosf(xf); s = __builtin_amdgcn_sinf(xf);
}

__device__ __forceinline__ void phase0(Frame& F) {
    const int gw = F.bid * NWAVES + F.wave, NGW = F.G * NWAVES;
    unsigned char* ws = F.ws;
    for (int cb = F.G - 1 - F.bid; cb < 96; cb += F.G) gemv8_block(F.in[IN_C], DM, true, F.in[IN_WADA], 6144, (float*)(ws + WS_MOD), F.in[IN_BADA], cb, (LAS float*)(F.lds + 8 * 16384), F.wave, F.lane, F.tid);
    { const size_t gt = (size_t)F.bid * NTHREADS + F.tid, gn = (size_t)F.G * NTHREADS; u32x4* z = (u32x4*)(ws + WS_SSQ_CQ);
      for (size_t i = gt; i < (WS_MOD - WS_SSQ_CQ) / 16; i += gn) z[i] = (u32x4){0u, 0u, 0u, 0u};
      for (size_t i = gt; i < (size_t)NB * 2048 / 4; i += gn) ((u32x4*)(ws + WS_BIASQ))[i] = (u32x4){0u, 0u, 0u, 0u};
      for (size_t i = gt; i < 3456; i += gn) ((unsigned*)(ws + WS_BAR))[i] = 0u;
    }
}
__device__ __forceinline__ void phase0b(Frame& F) {
    const int gw = F.bid * NWAVES + F.wave, NGW = F.G * NWAVES; (void)gw; (void)NGW;
    unsigned char* ws = F.ws;
    LAS float* scr = (LAS float*)(F.lds + F.wave * 16384);
    constexpr int I_WIN = 16 * 152, I_QUP = 6 * 24, I_KVUP = 4 * 32, I_OA = 8 * 32, I_OUT = 16 * 32, I_PQ = 16 * 64;
    constexpr int NITEMS = I_WIN + I_QUP + I_KVUP + 2 * I_OA + I_OUT + I_PQ;
    const int ntw_ = F.G; const bool tr_wg = true;
    for (int it = F.bid * NWAVES + F.wave; tr_wg && it < NITEMS; it += ntw_ * NWAVES) {
        int r = it;
        if (r < I_WIN) { transpose_item<1>(F.in[IN_WIN], DM, IN_WIDTH, (bf16_t*)(ws + WS_WIN), nullptr, scr, r, F.lane); continue; } r -= I_WIN;
        if (r < I_QUP) { transpose_item<2>(F.in[IN_WMQUP], QRANK, 768, (bf16_t*)(ws + WS_WQUP), F.in[IN_GMQA], scr, r, F.lane); continue; } r -= I_QUP;
        if (r < I_KVUP) { transpose_item<3>(F.in[IN_WMKVUP], KVRANK, 1024, (bf16_t*)(ws + WS_WKVUP), F.in[IN_GMKVA], scr, r, F.lane); continue; } r -= I_KVUP;
        if (r < I_OA) { transpose_item<0>(F.in[IN_WOA], AW, DM, (bf16_t*)(ws + WS_WOA), nullptr, scr, r, F.lane); continue; } r -= I_OA;
        if (r < I_OA) { transpose_item<0>(F.in[IN_WOM], AW, DM, (bf16_t*)(ws + WS_WOM), nullptr, scr, r, F.lane); continue; } r -= I_OA;
        if (r < I_OUT) { transpose_item<0>(F.in[IN_WOUT], DM, DM, (bf16_t*)(ws + WS_WOUT), nullptr, scr, r, F.lane); continue; } r -= I_OUT;
        transpose_item<0>(F.in[IN_WPQ], DM, 2048, (bf16_t*)(ws + WS_WPQ), nullptr, scr, r, F.lane);
    }
    const size_t gtid = (size_t)F.bid * NTHREADS + F.tid, gth = (size_t)F.G * NTHREADS;
    cvt_bf16_stream(F.in[IN_SUBK], (bf16_t*)(ws + WS_SUBK), (size_t)16 * 128 * 128, gtid, gth);
    const int* pos = (const int*)F.in[IN_POS];
    float* r32 = (float*)(ws + WS_ROPE32); float* r16 = (float*)(ws + WS_ROPE16);
    for (size_t e = gtid; e < (size_t)T * 48; e += gth) {
        const int t = (int)(e / 48), i = (int)(e % 48); const int p = pos[t]; float c, s;
        if (i < 32) { rope_cs(p, i, 32, c, s); r32[(size_t)t * 64 + i] = c; r32[(size_t)t * 64 + 32 + i] = s; }
        else { rope_cs(p, i - 32, 16, c, s); r16[(size_t)t * 32 + (i - 32)] = c; r16[(size_t)t * 32 + 16 + (i - 32)] = s; }
    }
}

__device__ __forceinline__ float wave_sum(float v) {
#pragma unroll
    for (int o = 1; o < 64; o <<= 1) v += __shfl_xor(v, o);
    return v;
}
__device__ __forceinline__ void phase1(Frame& F) {
    phase0b(F);
    __syncthreads();
    const int gw = F.bid * NWAVES + F.wave, NGW = F.G * NWAVES;
    const float* mod = (const float*)(F.ws + WS_MOD);
    for (int tk = F.G - 1 - F.bid; tk < 64; tk += F.G) gemv8_block(mod + 3072, 6144, false, F.in[IN_WPQ], 2048, (float*)(F.ws + WS_BIASQ), nullptr, tk & 31, (LAS float*)F.lds, F.wave, F.lane, F.tid, (tk >> 5) * 512, 1, true);
    const float* g1 = F.in[IN_G1];
    bf16_t* XN = (bf16_t*)(F.ws + WS_XN);
    for (int m0 = 2 * gw; m0 < T; m0 += 2 * NGW) {
        f32x4 v[2][4]; float s[2] = {0.f, 0.f};
#pragma unroll
        for (int u = 0; u < 2; ++u) { const f32x4* xr = (const f32x4*)(F.in[IN_X] + (size_t)(m0 + u) * DM) + F.lane;
#pragma unroll
            for (int j = 0; j < 4; ++j) v[u][j] = xr[64 * j]; }
#pragma unroll
        for (int u = 0; u < 2; ++u)
#pragma unroll
            for (int j = 0; j < 4; ++j) s[u] += (v[u][j].x * v[u][j].x + v[u][j].y * v[u][j].y) + (v[u][j].z * v[u][j].z + v[u][j].w * v[u][j].w);
#pragma unroll
        for (int u = 0; u < 2; ++u) {
            const int m = m0 + u, b = m / SEQ;
            const float rinv = __builtin_amdgcn_rsqf(wave_sum(s[u]) * (1.f / DM) + EPS);
            unsigned long long* o8 = (unsigned long long*)(XN + (size_t)m * DM) + F.lane;
#pragma unroll
            for (int j = 0; j < 4; ++j) {
                const int col = 4 * F.lane + 256 * j;
                const f32x4 g = *(const f32x4*)(g1 + col), sh = *(const f32x4*)(mod + (size_t)b * 6144 + col), sc = *(const f32x4*)(mod + (size_t)b * 6144 + 1024 + col);
                const f32x4 h = v[u][j] * rinv * g * (sc + 1.0f) + sh;
                o8[64 * j] = (unsigned long long)cvtpk_s(h.x, h.y) | ((unsigned long long)cvtpk_s(h.z, h.w) << 32);
            }
        }
    }
}

__device__ __forceinline__ u32x2 pk4(const f32x4 v) { u32x2 o; o.x = cvtpk_s(v.x, v.y); o.y = cvtpk_s(v.z, v.w); return o; }
__device__ __forceinline__ void st8(bf16_t* grp, const u32x2 X, const u32x2 Y, int fq) {
    auto r0 = __builtin_amdgcn_permlane16_swap(X.x, Y.x, false, false); auto r1 = __builtin_amdgcn_permlane16_swap(X.y, Y.y, false, false);
    *(u32x4*)(grp + 8 * (fq >> 1) + 16 * (fq & 1)) = (u32x4){r0[0], r1[0], r0[1], r1[1]};
}
__device__ __forceinline__ void ld8(const bf16_t* grp, u32x2& X, u32x2& Y, int fq) {
    const u32x4 w = *(const u32x4*)(grp + 8 * (fq >> 1) + 16 * (fq & 1));
    auto r0 = __builtin_amdgcn_permlane16_swap(w[0], w[2], false, false); auto r1 = __builtin_amdgcn_permlane16_swap(w[1], w[3], false, false);
    X = (u32x2){r0[0], r1[0]}; Y = (u32x2){r0[1], r1[1]};
}
__device__ __forceinline__ float sum4sq(const f32x4 v) { return (v.x * v.x + v.y * v.y) + (v.z * v.z + v.w * v.w); }
__device__ __forceinline__ float fq_sum(float s) {
    { auto r = __builtin_amdgcn_permlane16_swap(__float_as_uint(s), __float_as_uint(s), false, false); s = __uint_as_float(r[0]) + __uint_as_float(r[1]); }
    { auto r = __builtin_amdgcn_permlane32_swap(__float_as_uint(s), __float_as_uint(s), false, false); s = __uint_as_float(r[0]) + __uint_as_float(r[1]); }
    return s;
}

struct EpiIn {
    unsigned char* ws; const float* gaq; const float* gak; const float* gidxk; const float* gmk;
    template <bool NORM>
    __device__ __forceinline__ void normrope64(const f32x4 (&acc)[2][2][4][2], int row0, int fq, const float* gain, float scale, bf16_t* dst, int pitch, int colbase) const {
        const float* rope = (const float*)(ws + WS_ROPE32);
        f32x4 gv[2][2];
#pragma unroll
        for (int bj = 0; bj < 2; ++bj)
#pragma unroll
            for (int n = 0; n < 2; ++n) gv[bj][n] = NORM ? *(const f32x4*)(gain + 32 * bj + 16 * n + 4 * fq) * scale : (f32x4){scale, scale, scale, scale};
#pragma unroll
        for (int ai = 0; ai < 2; ++ai)
#pragma unroll
            for (int m = 0; m < 4; ++m) {
                const int row = row0 + 128 * ai + 16 * m;
                float rinv = 1.f;
                if (NORM) {
                    float s = 0.f;
#pragma unroll
                    for (int bj = 0; bj < 2; ++bj)
#pragma unroll
                        for (int n = 0; n < 2; ++n) s += sum4sq(acc[ai][bj][m][n]);
                    rinv = __builtin_amdgcn_rsqf(fq_sum(s) * (1.f / 64.f) + EPS);
                }
                bf16_t* o = dst + (size_t)row * pitch + colbase; u32x2 lo[2], hi[2];
#pragma unroll
                for (int n = 0; n < 2; ++n) {
                    const f32x4 cs = *(const f32x4*)(rope + (size_t)row * 64 + 16 * n + 4 * fq), sn = *(const f32x4*)(rope + (size_t)row * 64 + 32 + 16 * n + 4 * fq);
                    const f32x4 x1 = acc[ai][0][m][n] * rinv * gv[0][n], x2 = acc[ai][1][m][n] * rinv * gv[1][n];
                    lo[n] = pk4(x1 * cs - x2 * sn); hi[n] = pk4(x2 * cs + x1 * sn);
                }
                st8(o, lo[0], lo[1], fq); st8(o + 32, hi[0], hi[1], fq);
                asm volatile("" ::: "memory");
            }
    }
    __device__ __forceinline__ void operator()(const f32x4 (&acc)[2][2][4][2], const pg8::Unit& u, int wr, int wc, int fr, int fq) const {
        const int pn = u.pn, row0 = u.pm * 256 + wr * 64 + fr;
        if (pn < 2) { normrope64<true>(acc, row0, fq, gaq, C2A, (bf16_t*)(ws + WS_QA), AW, ((pn & 1) * 4 + wc) * 64); return; }
        if (pn < 4) { normrope64<true>(acc, row0, fq, gak, 1.f, (bf16_t*)(ws + WS_KA), AW, ((pn & 1) * 4 + wc) * 64); return; }
        if (pn < 6) {
            bf16_t* dst = (bf16_t*)(ws + WS_VA);
#pragma unroll
            for (int ai = 0; ai < 2; ++ai)
#pragma unroll
                for (int m = 0; m < 4; ++m) { bf16_t* o = dst + (size_t)(row0 + 128 * ai + 16 * m) * AW + ((pn & 1) * 4 + wc) * 64;
#pragma unroll
                    for (int bj = 0; bj < 2; ++bj) st8(o + 32 * bj, pk4(acc[ai][bj][m][0]), pk4(acc[ai][bj][m][1]), fq); asm volatile("" ::: "memory"); }
            return;
        }
        if (pn < 8) { normrope64<false>(acc, row0, fq, nullptr, 1.f, (bf16_t*)(ws + WS_QI), AW, ((pn & 1) * 4 + wc) * 64); return; }
        if (pn == 8) {
            if (wc == 0) { normrope64<true>(acc, row0, fq, gidxk, 1.f, (bf16_t*)(ws + WS_KI), 64, 0); return; }
            if (wc == 1) {
                const float* rope = (const float*)(ws + WS_ROPE16);
                float* kper = (float*)(ws + WS_KPER); float* kss = (float*)(ws + WS_KPESSQ); float* wi = (float*)(ws + WS_WI);
                const f32x4 g1 = *(const f32x4*)(gmk + 64 + 4 * fq), g2 = *(const f32x4*)(gmk + 80 + 4 * fq);
#pragma unroll
                for (int ai = 0; ai < 2; ++ai)
#pragma unroll
                    for (int m = 0; m < 4; ++m) {
                        const int row = row0 + 128 * ai + 16 * m;
                        const f32x4 a = acc[ai][0][m][0], b = acc[ai][0][m][1];
                        const float s = fq_sum(sum4sq(a) + sum4sq(b));
                        if (fq == 0) kss[row] = s;
                        const f32x4 cs = *(const f32x4*)(rope + (size_t)row * 32 + 4 * fq), sn = *(const f32x4*)(rope + (size_t)row * 32 + 16 + 4 * fq);
                        const f32x4 x1 = a * g1, x2 = b * g2;
                        *(f32x4*)(kper + (size_t)row * 32 + 4 * fq) = x1 * cs - x2 * sn;
                        *(f32x4*)(kper + (size_t)row * 32 + 16 + 4 * fq) = x2 * cs + x1 * sn;
                        if (fq < 2) *(f32x4*)(wi + (size_t)row * 8 + 4 * fq) = acc[ai][1][m][0] * 0.044194173824159216f;
                        asm volatile("" ::: "memory");
                    }
            }
            return;
        }
        if (pn < 12) {
            const bool isq = pn < 11; const int cb = isq ? (pn - 9) * 256 : 0, width = isq ? QRANK : KVRANK;
            bf16_t* dst = (bf16_t*)(ws + (isq ? WS_CQ : WS_CKV)); float* ssq = (float*)(ws + (isq ? WS_SSQ_CQ : WS_SSQ_CKV));
#pragma unroll
            for (int ai = 0; ai < 2; ++ai)
#pragma unroll
                for (int m = 0; m < 4; ++m) {
                    const int row = row0 + 128 * ai + 16 * m; float s = 0.f;
#pragma unroll
                    for (int bj = 0; bj < 2; ++bj) { const int col = cb + 128 * bj + 32 * wc;
                        if (col < width) { st8(dst + (size_t)row * width + col, pk4(acc[ai][bj][m][0]), pk4(acc[ai][bj][m][1]), fq); s += sum4sq(acc[ai][bj][m][0]) + sum4sq(acc[ai][bj][m][1]); } }
                    s = fq_sum(s);
                    if (fq == 0) atomicAdd(ssq + row, s);
                    asm volatile("" ::: "memory");
                }
            return;
        }
        {
            bf16_t* dst = (bf16_t*)(ws + (pn < 16 ? WS_GA : WS_GM)); const int cb = ((pn - 12) & 3) * 256 + 32 * wc;
#pragma unroll
            for (int ai = 0; ai < 2; ++ai)
#pragma unroll
                for (int m = 0; m < 4; ++m) { bf16_t* o = dst + (size_t)(row0 + 128 * ai + 16 * m) * DM + cb;
#pragma unroll
                    for (int bj = 0; bj < 2; ++bj) { const f32x4 v = acc[ai][bj][m][0], w = acc[ai][bj][m][1];
                        st8(o + 128 * bj, pk4((f32x4){sigmoidf_(v.x), sigmoidf_(v.y), sigmoidf_(v.z), sigmoidf_(v.w)}), pk4((f32x4){sigmoidf_(w.x), sigmoidf_(w.y), sigmoidf_(w.z), sigmoidf_(w.w)}), fq); } asm volatile("" ::: "memory"); }
        }
    }
};

struct EpiQup {
    unsigned char* ws; const float* gmq;
    __device__ __forceinline__ void operator()(const f32x4 (&acc)[2][2][4][2], const pg8::Unit& u, int wr, int wc, int fr, int fq) const {
        const int pn = u.pn, row0 = u.pm * 256 + wr * 64 + fr;
        const float* ssqc = (const float*)(ws + WS_SSQ_CQ); float* ssqm = (float*)(ws + WS_SSQ_QM);
        if (pn < 2) {
            const int head = pn * 4 + wc; bf16_t* dst = (bf16_t*)(ws + WS_QMN);
            f32x4 gv[2][2];
#pragma unroll
            for (int bj = 0; bj < 2; ++bj)
#pragma unroll
                for (int n = 0; n < 2; ++n) gv[bj][n] = *(const f32x4*)(gmq + 32 * bj + 16 * n + 4 * fq) * C2B;
#pragma unroll
            for (int ai = 0; ai < 2; ++ai)
#pragma unroll
                for (int m = 0; m < 4; ++m) {
                    const int row = row0 + 128 * ai + 16 * m;
                    const float rc = __builtin_amdgcn_rsqf(ssqc[row] * (1.f / QRANK) + EPS);
                    float s = 0.f; bf16_t* o = dst + (size_t)row * 512 + head * 64;
#pragma unroll
                    for (int bj = 0; bj < 2; ++bj) { const f32x4 q0 = acc[ai][bj][m][0] * rc, q1 = acc[ai][bj][m][1] * rc; s += sum4sq(q0) + sum4sq(q1); st8(o + 32 * bj, pk4(q0 * gv[bj][0]), pk4(q1 * gv[bj][1]), fq); }
                    s = fq_sum(s);
                    if (fq == 0) atomicAdd(ssqm + (size_t)row * 8 + head, s);
                    asm volatile("" ::: "memory");
                }
            return;
        }
        {
            const float* rope = (const float*)(ws + WS_ROPE16); bf16_t* dst = (bf16_t*)(ws + WS_QMR);
            const f32x4 g1 = *(const f32x4*)(gmq + 64 + 4 * fq) * C2B, g2 = *(const f32x4*)(gmq + 80 + 4 * fq) * C2B;
#pragma unroll
            for (int ai = 0; ai < 2; ++ai)
#pragma unroll
                for (int m = 0; m < 4; ++m) {
                    const int row = row0 + 128 * ai + 16 * m;
                    const float rc = __builtin_amdgcn_rsqf(ssqc[row] * (1.f / QRANK) + EPS);
                    const f32x4 cs = *(const f32x4*)(rope + (size_t)row * 32 + 4 * fq), sn = *(const f32x4*)(rope + (size_t)row * 32 + 16 + 4 * fq);
#pragma unroll
                    for (int bj = 0; bj < 2; ++bj) {
                        const int head = 2 * wc + bj;
                        const f32x4 a = acc[ai][bj][m][0] * rc, b = acc[ai][bj][m][1] * rc;
                        const float s = fq_sum(sum4sq(a) + sum4sq(b));
                        if (fq == 0) atomicAdd(ssqm + (size_t)row * 8 + head, s);
                        const f32x4 x1 = a * g1, x2 = b * g2;
                        st8(dst + (size_t)row * 256 + head * 32, pk4(x1 * cs - x2 * sn), pk4(x2 * cs + x1 * sn), fq);
                    }
                    asm volatile("" ::: "memory");
                }
        }
    }
};
struct EpiKVup {
    unsigned char* ws; const float* gmk;
    __device__ __forceinline__ void operator()(const f32x4 (&acc)[2][2][4][2], const pg8::Unit& u, int wr, int wc, int fr, int fq) const {
        const int pn = u.pn, row0 = u.pm * 256 + wr * 64 + fr, head = (pn & 1) * 4 + wc;
        const float* ssqc = (const float*)(ws + WS_SSQ_CKV);
        if (pn < 2) {
            const float* kss = (const float*)(ws + WS_KPESSQ); const float* kper = (const float*)(ws + WS_KPER);
            bf16_t* dn = (bf16_t*)(ws + WS_KMN); bf16_t* dr = (bf16_t*)(ws + WS_KMR);
            f32x4 gv[2][2];
#pragma unroll
            for (int bj = 0; bj < 2; ++bj)
#pragma unroll
                for (int n = 0; n < 2; ++n) gv[bj][n] = *(const f32x4*)(gmk + 32 * bj + 16 * n + 4 * fq);
#pragma unroll
            for (int ai = 0; ai < 2; ++ai)
#pragma unroll
                for (int m = 0; m < 4; ++m) {
                    const int row = row0 + 128 * ai + 16 * m;
                    const float rc = __builtin_amdgcn_rsqf(ssqc[row] * (1.f / KVRANK) + EPS);
                    float s = 0.f; f32x4 kn[2][2];
#pragma unroll
                    for (int bj = 0; bj < 2; ++bj)
#pragma unroll
                        for (int n = 0; n < 2; ++n) { kn[bj][n] = acc[ai][bj][m][n] * rc; s += sum4sq(kn[bj][n]); }
                    s = fq_sum(s) + kss[row];
                    const float rinv = __builtin_amdgcn_rsqf(s * (1.f / MQK) + EPS);
                    bf16_t* o = dn + (size_t)row * 512 + head * 64;
#pragma unroll
                    for (int bj = 0; bj < 2; ++bj) st8(o + 32 * bj, pk4(kn[bj][0] * gv[bj][0] * rinv), pk4(kn[bj][1] * gv[bj][1] * rinv), fq);
                    const f32x4 ra = *(const f32x4*)(kper + (size_t)row * 32 + 8 * fq) * rinv, rb = *(const f32x4*)(kper + (size_t)row * 32 + 8 * fq + 4) * rinv;
                    u32x4 w; w.x = cvtpk_s(ra.x, ra.y); w.y = cvtpk_s(ra.z, ra.w); w.z = cvtpk_s(rb.x, rb.y); w.w = cvtpk_s(rb.z, rb.w);
                    *(u32x4*)(dr + (size_t)row * 256 + head * 32 + 8 * fq) = w;
                    asm volatile("" ::: "memory");
                }
            return;
        }
        {
            bf16_t* dst = (bf16_t*)(ws + WS_VM);
#pragma unroll
            for (int ai = 0; ai < 2; ++ai)
#pragma unroll
                for (int m = 0; m < 4; ++m) {
                    const int row = row0 + 128 * ai + 16 * m;
                    const float rc = __builtin_amdgcn_rsqf(ssqc[row] * (1.f / KVRANK) + EPS);
                    bf16_t* o = dst + (size_t)row * 512 + head * 64;
#pragma unroll
                    for (int bj = 0; bj < 2; ++bj) st8(o + 32 * bj, pk4(acc[ai][bj][m][0] * rc), pk4(acc[ai][bj][m][1] * rc), fq);
                    asm volatile("" ::: "memory");
                }
        }
    }
};

constexpr int SC_PITCH = 4104, IDX_SC_BYTES = 16 * SC_PITCH * 2, IDX_MW_OFF = IDX_SC_BYTES;
static_assert(IDX_MW_OFF % 16 == 0 && IDX_MW_OFF + 16 * 64 * 8 <= LDS_BYTES, "indexer LDS");
__device__ __forceinline__ int suffix_sum64(int v, int lane) {
#pragma unroll
    for (int o = 1; o < 64; o <<= 1) { const int t = __shfl_down(v, o); v += (lane + o < 64) ? t : 0; }
    return v;
}
__device__ __forceinline__ void radix_level(LAS unsigned* hist, int lane, int want, int& bsel, int& cabove) {
    u32x4 c = *(const LAS u32x4*)(hist + 4 * lane);
#pragma unroll
    for (int k = 1; k < 4; ++k) c += *(const LAS u32x4*)(hist + 256 * k + 4 * lane);
#pragma unroll
    for (int k = 0; k < 4; ++k) *(LAS u32x4*)(hist + 256 * k + 4 * lane) = (u32x4){0u, 0u, 0u, 0u};
    const int s = (int)(c.x + c.y + c.z + c.w), S = suffix_sum64(s, lane);
    int above = S - s, b = -1, ca = 0;
    if (above < want && S >= want) {
        if (above + (int)c.w >= want) { b = 4 * lane + 3; ca = above; }
        else if (above + (int)(c.w + c.z) >= want) { b = 4 * lane + 2; ca = above + (int)c.w; }
        else if (above + (int)(c.w + c.z + c.y) >= want) { b = 4 * lane + 1; ca = above + (int)(c.w + c.z); }
        else { b = 4 * lane; ca = above + (int)(c.w + c.z + c.y); }
    }
    const unsigned long long m = __builtin_amdgcn_ballot_w64(b >= 0);
    const int src = (int)__builtin_ctzll(m | (1ull << 63));
    bsel = __builtin_amdgcn_readlane(b, src); cabove = __builtin_amdgcn_readlane(ca, src);
}
__device__ __forceinline__ void indexer_phase(Frame& F) {
    const bf16_t* QI = (const bf16_t*)(F.ws + WS_QI); const bf16_t* KI = (const bf16_t*)(F.ws + WS_KI); const float* WI = (const float*)(F.ws + WS_WI);
    unsigned long long* MASK = (unsigned long long*)(F.ws + WS_MASK);
    LAS unsigned short* SC = (LAS unsigned short*)F.lds;
    LAS unsigned long long* MW = (LAS unsigned long long*)(F.lds + IDX_MW_OFF);
    const int lane = F.lane, wid = F.wave;
    for (int item = F.bid; item < NB * 256; item += F.G) {
        int lq = lane; asm volatile("" : "+v"(lq)); const int q = lq & 15, kq = lq >> 4;
        const int b = item >> 8, gi = item & 255, g = (b & 1) ? 255 - gi : gi, t0 = 16 * g, nkt = g + 1;
        const size_t rowq = (size_t)b * SEQ + t0 + q;
        bf16x8 bq[8][2]; float wv[8];
#pragma unroll
        for (int h = 0; h < 8; ++h) {
#pragma unroll
            for (int ks = 0; ks < 2; ++ks) bq[h][ks] = *(const bf16x8*)(QI + rowq * 512 + h * 64 + 32 * ks + 8 * kq);
            wv[h] = WI[rowq * 8 + h];
        }
        const bf16_t* kbase = KI + ((size_t)b * SEQ + q) * 64 + 8 * kq;
        const int ntw = (nkt - wid + NWAVES - 1) / NWAVES;
        bf16x8 ka[4][2], kn[4][2];
#define IDX_KLOAD(u, jj) do { int kt_ = wid + NWAVES * (jj); kt_ = kt_ < nkt ? kt_ : nkt - 1; const bf16_t* kp = kbase + (size_t)16 * kt_ * 64; kn[u][0] = *(const bf16x8*)kp; kn[u][1] = *(const bf16x8*)(kp + 32); } while (0)
#define IDX_TILE(u, jj) do { const int kt = wid + NWAVES * (jj); \
                f32x4 sc = (f32x4){0.f, 0.f, 0.f, 0.f}; \
                _Pragma("unroll") for (int h = 0; h < 8; ++h) { \
                    f32x4 c = __builtin_amdgcn_mfma_f32_16x16x32_bf16(ka[u][0], bq[h][0], (f32x4){0.f, 0.f, 0.f, 0.f}, 0, 0, 0); \
                    c = __builtin_amdgcn_mfma_f32_16x16x32_bf16(ka[u][1], bq[h][1], c, 0, 0, 0); \
                    _Pragma("unroll") for (int i = 0; i < 4; ++i) sc[i] += __builtin_amdgcn_fmed3f(c[i], 0.f, 3.0e38f) * wv[h]; } \
                unsigned short kk[4]; \
                _Pragma("unroll") for (int i = 0; i < 4; ++i) { const _Float16 hsc = (_Float16)(sc[i] + 0.0f); const unsigned short bits = __builtin_bit_cast(unsigned short, hsc); \
                    kk[i] = (bits & 0x8000u) ? (unsigned short)~bits : (unsigned short)(bits | 0x8000u); } \
                u32x2 w; w.x = (unsigned)kk[0] | ((unsigned)kk[1] << 16); w.y = (unsigned)kk[2] | ((unsigned)kk[3] << 16); \
                *(LAS u32x2*)(SC + q * SC_PITCH + 16 * kt + 4 * kq) = w; } while (0)
#pragma unroll
        for (int u = 0; u < 4; ++u) IDX_KLOAD(u, u);
        for (int j0 = 0; j0 < ntw; j0 += 4) {
#pragma unroll
            for (int u = 0; u < 4; ++u) { ka[u][0] = kn[u][0]; ka[u][1] = kn[u][1]; }
#pragma unroll
            for (int u = 0; u < 4; ++u) IDX_KLOAD(u, j0 + 4 + u);
            if (j0 + 4 <= ntw) { IDX_TILE(0, j0); IDX_TILE(1, j0 + 1); IDX_TILE(2, j0 + 2); IDX_TILE(3, j0 + 3); }
            else { IDX_TILE(0, j0); if (j0 + 1 < ntw) IDX_TILE(1, j0 + 1); if (j0 + 2 < ntw) IDX_TILE(2, j0 + 2); }
        }
#undef IDX_KLOAD
#undef IDX_TILE
        __syncthreads();
#pragma unroll 1
        for (int qi = 0; qi < 2; ++qi) {
            const int qq = 2 * wid + qi, t = t0 + qq, nr = (t >> 6) + 1;
            unsigned key[64];
#pragma unroll
            for (int r = 0; r < 64; ++r) { const int s = 64 * r + lane; key[r] = (r < nr && s <= t) ? (unsigned)SC[qq * SC_PITCH + s] : 0u; }
            unsigned thr = 0u; int need = 0;
            LAS unsigned* hist = (LAS unsigned*)(SC + qq * SC_PITCH);
            if (t + 1 > NSEL) {
                LDS_WAIT();
#pragma unroll
                for (int k = 0; k < 4; ++k) *(LAS u32x4*)(hist + 256 * k + 4 * lane) = (u32x4){0u, 0u, 0u, 0u};
                LAS unsigned* hmine = hist + 256 * (lane & 3);
#pragma unroll
                for (int r8 = 0; r8 < 8; ++r8) if (8 * r8 < nr) {
#pragma unroll
                    for (int r = 8 * r8; r < 8 * r8 + 8; ++r) if (key[r] != 0u) __hip_atomic_fetch_add(hmine + (key[r] >> 8), 1u, __ATOMIC_RELAXED, __HIP_MEMORY_SCOPE_WORKGROUP);
                }
                LDS_WAIT();
                int bh, ca_h; radix_level(hist, lane, NSEL, bh, ca_h);
                LDS_WAIT();
#pragma unroll
                for (int r8 = 0; r8 < 8; ++r8) if (8 * r8 < nr) {
#pragma unroll
                    for (int r = 8 * r8; r < 8 * r8 + 8; ++r) if ((int)(key[r] >> 8) == bh) __hip_atomic_fetch_add(hmine + (key[r] & 255u), 1u, __ATOMIC_RELAXED, __HIP_MEMORY_SCOPE_WORKGROUP);
                }
                LDS_WAIT();
                int bl, ca_l; radix_level(hist, lane, NSEL - ca_h, bl, ca_l);
                LDS_WAIT();
                thr = ((unsigned)bh << 8) | (unsigned)bl; need = NSEL - ca_h - ca_l;
            }
            unsigned wlo = 0u, whi = 0u;
#pragma unroll
            for (int r = 0; r < 64; ++r) {
                unsigned long long word = 0ull;
                if (r < nr) {
                    if (t + 1 > NSEL) {
                        const unsigned long long mg = __builtin_amdgcn_ballot_w64(key[r] > thr);
                        unsigned long long me = __builtin_amdgcn_ballot_w64(key[r] == thr);
                        if (me) { const int c = __builtin_popcountll(me);
                            if (c > need) { int drop = c - need; while (drop > 0) { me &= ~(1ull << (63 - __builtin_clzll(me))); --drop; } need = 0; } else need -= c; }
                        word = mg | me;
                    } else word = __builtin_amdgcn_ballot_w64(key[r] != 0u);
                }
                { const unsigned w0_ = (unsigned)word, w1_ = (unsigned)(word >> 32); asm volatile("s_nop 0\n\tv_writelane_b32 %0, %2, %4\n\tv_writelane_b32 %1, %3, %4" : "+v"(wlo), "+v"(whi) : "s"(w0_), "s"(w1_), "n"(r)); }
            }
            MW[qq * 64 + lane] = ((unsigned long long)whi << 32) | wlo;
        }
        __syncthreads();
        for (int i = F.tid; i < 1024; i += NTHREADS) { const int w = i >> 4, qq = i & 15; MASK[((size_t)b * 64 + w) * SEQ + t0 + qq] = MW[qq * 64 + w]; }
        __syncthreads();
    }
}

namespace att {
constexpr int KV = 64, QB = 256;
constexpr int KSLOT = 12288, VSLOT = 8192;
constexpr int NSLOT = 4;
constexpr int L_K = 0, L_V = NSLOT * KSLOT, L_WS = L_V + NSLOT * VSLOT, L_OST = L_WS + NWAVES * 64 * 4, L_BYTES = L_OST + NWAVES * 4096;
static_assert(L_BYTES <= LDS_BYTES, "attention LDS");
__device__ __forceinline__ int crow(int r, int hi) { return (r & 3) + 8 * (r >> 2) + 4 * hi; }
__device__ __forceinline__ float max3f(float a, float b, float c) { float r; asm("v_max3_f32 %0, %1, %2, %3" : "=v"(r) : "v"(a), "v"(b), "v"(c)); return r; }
__device__ __forceinline__ void glds(const void* g, LAS unsigned char* l) { __builtin_amdgcn_global_load_lds((const unsigned*)g, (LAS unsigned*)l, 16, 0, 0); }

template <int MODE>
__device__ __forceinline__ void attn_unit(Frame& F, int b, int h, int qb) {
    constexpr int NCH = MODE ? 12 : 8, ND = NCH / 2;
    const int lane = F.lane, wid = F.wave, r32 = lane & 31, hi = lane >> 5;
    unsigned char* ws = F.ws; LAS unsigned char* lds = F.lds;
    const size_t rowbase = (size_t)b * SEQ; const int q0 = qb * QB;
    const bf16_t* Kn = (const bf16_t*)(ws + (MODE ? WS_KMN : WS_KA)) + rowbase * 512 + h * 64;
    const bf16_t* Kr = (const bf16_t*)(ws + WS_KMR) + rowbase * 256 + h * 32;
    const bf16_t* Vh = (const bf16_t*)(ws + (MODE ? WS_VM : WS_VA)) + rowbase * 512 + h * 64;
    bf16_t* Qn = (bf16_t*)(ws + (MODE ? WS_QMN : WS_QA)) + (rowbase + q0 + wid * 32) * 512 + h * 64;
    const bf16_t* Qr = (const bf16_t*)(ws + WS_QMR) + (rowbase + q0 + wid * 32) * 256 + h * 32;
    LAS float* wsf = (LAS float*)(lds + L_WS) + wid * 64;
    const int NT = (q0 + QB) / KV;
    const bf16_t* ksrc0 = Kn + (size_t)lane * 512 + wid * 8;
    const bf16_t* ksrc1 = Kr + (size_t)lane * 256 + (wid & 3) * 8;
    const bf16_t* vsrc = Vh + (size_t)(16 * (wid & 3) + (lane >> 2)) * 512 + (wid >> 2) * 32 + (lane & 3) * 8;
#define ATT_DMA(t, slot) do { glds(ksrc0 + (size_t)(t) * KV * 512, lds + L_K + (slot) * KSLOT + wid * 1024); \
        if (MODE) glds(ksrc1 + (size_t)(t) * KV * 256, lds + L_K + (slot) * KSLOT + (8 + (wid & 3)) * 1024); \
        glds(vsrc + (size_t)(t) * KV * 512, lds + L_V + (slot) * VSLOT + wid * 1024); } while (0)
    ATT_DMA(0, 0); ATT_DMA(1, 1); ATT_DMA(2, 2);
    bf16x8 qr[ND];
#pragma unroll
    for (int d0 = 0; d0 < 4; ++d0) qr[d0] = *(const bf16x8*)(Qn + (size_t)r32 * 512 + d0 * 16 + hi * 8);
    if (MODE) {
#pragma unroll
        for (int d0 = 4; d0 < ND; ++d0) qr[d0] = *(const bf16x8*)(Qr + (size_t)r32 * 256 + (d0 - 4) * 16 + hi * 8);
        const float rq = __builtin_amdgcn_rsqf(((const float*)(ws + WS_SSQ_QM))[(rowbase + q0 + wid * 32 + r32) * 8 + h] * (1.f / MQK) + EPS);
#pragma unroll
        for (int d0 = 0; d0 < ND; ++d0) {
            u32x4 w = __builtin_bit_cast(u32x4, qr[d0]);
#pragma unroll
            for (int j = 0; j < 4; ++j) w[j] = cvtpk_s(bflo(w[j]) * rq, bfhi(w[j]) * rq);
            qr[d0] = __builtin_bit_cast(bf16x8, w);
        }
    }
    const unsigned long long* mrow = (const unsigned long long*)(ws + WS_MASK) + (size_t)b * 64 * SEQ + q0 + wid * 32 + r32;
    float mref = 0.f; f32x16 o[2]; o[0] = f32x16{}; o[1] = f32x16{};
    float lrun = 0.f;
    f32x16 negm = f32x16{};
    const int qrel = wid * 32 + r32;
    const unsigned vb0 = (unsigned)(uintptr_t)(lds + L_V) + ((lane >> 4) & 1) * 32 + (lane & 3) * 8 + (4 * hi + ((lane & 15) >> 2)) * 64;
    unsigned long long mw = 0ull, mwn = 0ull;
    if (MODE == 0) mwn = mrow[0];
#define ATT_QK(P0, P1, SL) do { const LAS unsigned char* kb = lds + L_K + (SL) * KSLOT + hi * 1024 + r32 * 16; \
        _Pragma("unroll") for (int d0 = 0; d0 < ND; ++d0) { \
            const bf16x8 k0 = *(const LAS bf16x8*)(kb + d0 * 2048), k1 = *(const LAS bf16x8*)(kb + d0 * 2048 + 512); \
            if (d0 == 0) { P0 = __builtin_amdgcn_mfma_f32_32x32x16_bf16(k0, qr[0], negm, 0, 0, 0); P1 = __builtin_amdgcn_mfma_f32_32x32x16_bf16(k1, qr[0], negm, 0, 0, 0); } \
            else { P0 = __builtin_amdgcn_mfma_f32_32x32x16_bf16(k0, qr[d0], P0, 0, 0, 0); P1 = __builtin_amdgcn_mfma_f32_32x32x16_bf16(k1, qr[d0], P1, 0, 0, 0); } } } while (0)
    if (MODE) asm volatile("s_waitcnt vmcnt(3)" ::: "memory"); else asm volatile("s_waitcnt vmcnt(2)" ::: "memory");
    __builtin_amdgcn_s_barrier(); asm volatile("" ::: "memory");
    f32x16 pn0, pn1;
    ATT_QK(pn0, pn1, 0);
    int slot = 0, slot1 = 1, slot3 = 3;
    for (int t = 0; t < NT; ++t) {
        if (t + 2 < NT) { if (MODE) asm volatile("s_waitcnt vmcnt(3)" ::: "memory"); else asm volatile("s_waitcnt vmcnt(2)" ::: "memory"); }
        else asm volatile("s_waitcnt vmcnt(0)" ::: "memory");
        __builtin_amdgcn_s_barrier(); asm volatile("" ::: "memory");
        mw = mwn;
        if (MODE == 0 && t + 1 < NT) mwn = mrow[(size_t)(t + 1) * SEQ];
        if (t + 3 < NT) ATT_DMA(t + 3, slot3);
        f32x16 p0 = pn0, p1 = pn1;
        if (MODE == 1) {
            const int jb = t - (NT - 4);
            if (jb >= 0) { const int kb = 64 * jb + 4 * hi;
#pragma unroll
                for (int r = 0; r < 16; ++r) { const int kv = kb + (r & 3) + 8 * (r >> 2); if (kv > qrel) p0[r] = -INFINITY; if (kv + 32 > qrel) p1[r] = -INFINITY; } }
        }
        asm volatile("s_nop 15\n\ts_nop 7" : "+v"(p0), "+v"(p1));
        float rm = max3f(p0[0], p1[0], p0[1]), rm2 = max3f(p1[1], p0[2], p1[2]);
#pragma unroll
        for (int r = 3; r < 15; r += 2) { rm = max3f(rm, p0[r], p1[r]); rm2 = max3f(rm2, p0[r + 1], p1[r + 1]); }
        rm = max3f(rm, rm2, p0[15]); rm = __builtin_fmaxf(rm, p1[15]);
        { auto rr = __builtin_amdgcn_permlane32_swap(__float_as_uint(rm), __float_as_uint(rm), false, false); rm = __builtin_fmaxf(__uint_as_float(rr[0]), __uint_as_float(rr[1])); }
        if (__any(rm > 0.f) || t == 0) {
            const float dl = (t == 0) ? rm : __builtin_fmaxf(rm, 0.f);
            mref += dl;
#pragma unroll
            for (int r = 0; r < 16; ++r) { p0[r] -= dl; p1[r] -= dl; }
#pragma unroll
            for (int r = 0; r < 16; ++r) negm[r] = -mref;
            const float f = __builtin_amdgcn_exp2f(-dl);
            if (hi == 0) wsf[r32] = f;
            LDS_WAIT();
#pragma unroll
            for (int r = 0; r < 16; ++r) { const float fr = wsf[crow(r, hi)]; o[0][r] *= fr; o[1][r] *= fr; }
            lrun *= f;
        }
        ATT_QK(pn0, pn1, slot1);
#pragma unroll
        for (int r = 0; r < 16; ++r) { p0[r] = __builtin_amdgcn_exp2f(p0[r]); p1[r] = __builtin_amdgcn_exp2f(p1[r]); }
        if (MODE == 0) {
            const unsigned lo = (unsigned)mw >> (4 * hi), hw = (unsigned)(mw >> 32) >> (4 * hi);
#pragma unroll
            for (int r = 0; r < 16; ++r) { const int c = (r & 3) + 8 * (r >> 2);
                p0[r] = __uint_as_float(__float_as_uint(p0[r]) & (unsigned)__builtin_amdgcn_sbfe(lo, c, 1));
                p1[r] = __uint_as_float(__float_as_uint(p1[r]) & (unsigned)__builtin_amdgcn_sbfe(hw, c, 1)); }
        }
        { float sacc = 0.f;
#pragma unroll
          for (int r = 0; r < 16; ++r) sacc += p0[r] + p1[r];
          lrun += sacc; }
        u32x4 pw0, pw1, pw2, pw3;
#pragma unroll
        for (int j = 0; j < 4; ++j) { pw0[j] = cvtpk_s(p0[2 * j], p0[2 * j + 1]); pw1[j] = cvtpk_s(p0[8 + 2 * j], p0[9 + 2 * j]); pw2[j] = cvtpk_s(p1[2 * j], p1[2 * j + 1]); pw3[j] = cvtpk_s(p1[8 + 2 * j], p1[9 + 2 * j]); }
        { const unsigned vb = vb0 + slot * VSLOT;
#pragma unroll
          for (int d0 = 0; d0 < 2; ++d0) { s16x4 lo[4], hh[4];
#pragma unroll
              for (int ks = 0; ks < 4; ++ks) {
                  asm volatile("ds_read_b64_tr_b16 %0,%1 offset:%c2" : "=&v"(lo[ks]) : "v"(vb), "i"(d0 * 4096 + ks * 1024) : "memory");
                  asm volatile("ds_read_b64_tr_b16 %0,%1 offset:%c2" : "=&v"(hh[ks]) : "v"(vb), "i"(d0 * 4096 + ks * 1024 + 512) : "memory"); }
              asm volatile("s_waitcnt lgkmcnt(0)" ::: "memory"); __builtin_amdgcn_sched_barrier(0);
#define ATT_PK(k) (bf16x8){lo[k][0], lo[k][1], lo[k][2], lo[k][3], hh[k][0], hh[k][1], hh[k][2], hh[k][3]}
              o[d0] = __builtin_amdgcn_mfma_f32_32x32x16_bf16(__builtin_bit_cast(bf16x8, pw0), ATT_PK(0), o[d0], 0, 0, 0);
              o[d0] = __builtin_amdgcn_mfma_f32_32x32x16_bf16(__builtin_bit_cast(bf16x8, pw1), ATT_PK(1), o[d0], 0, 0, 0);
              o[d0] = __builtin_amdgcn_mfma_f32_32x32x16_bf16(__builtin_bit_cast(bf16x8, pw2), ATT_PK(2), o[d0], 0, 0, 0);
              o[d0] = __builtin_amdgcn_mfma_f32_32x32x16_bf16(__builtin_bit_cast(bf16x8, pw3), ATT_PK(3), o[d0], 0, 0, 0);
#undef ATT_PK
          } }
        LDS_WAIT();
        slot = slot1; slot1 = (slot1 == NSLOT - 1) ? 0 : slot1 + 1; slot3 = (slot3 == NSLOT - 1) ? 0 : slot3 + 1;
    }
#undef ATT_QK
    __builtin_amdgcn_s_barrier(); asm volatile("" ::: "memory");
#undef ATT_DMA
    { auto rr = __builtin_amdgcn_permlane32_swap(__float_as_uint(lrun), __float_as_uint(lrun), false, false); lrun = __uint_as_float(rr[0]) + __uint_as_float(rr[1]); }
    if (hi == 0) wsf[32 + r32] = lrun;
    LDS_WAIT();
    float rli[16];
#pragma unroll
    for (int r = 0; r < 16; ++r) rli[r] = __builtin_amdgcn_rcpf(wsf[32 + crow(r, hi)]);
    LAS bf16_t* stg = (LAS bf16_t*)(lds + L_OST) + wid * 2048;
#pragma unroll
    for (int r = 0; r < 16; ++r) { const int orow = crow(r, hi);
#pragma unroll
        for (int d0 = 0; d0 < 2; ++d0) stg[orow * 64 + d0 * 32 + r32] = (bf16_t)(cvtpk_s(o[d0][r] * rli[r], 0.f) & 0xffffu); }
    LDS_WAIT();
#pragma unroll
    for (int i = 0; i < 4; ++i) { const int row = i * 8 + (lane >> 3), ch = lane & 7; const u32x4 v = *(const LAS u32x4*)(stg + row * 64 + ch * 8); *(u32x4*)(Qn + (size_t)row * 512 + ch * 8) = v; }
    LDS_WAIT(); __builtin_amdgcn_s_barrier(); asm volatile("" ::: "memory");
}

__device__ __forceinline__ void attn_phase(Frame& F) {
    const int vcu = (F.G % 8 == 0) ? (F.bid % 8) * (F.G / 8) + F.bid / 8 : F.bid;
    for (int v = vcu; v < 256; v += F.G) {
        const int bh = v >> 2, s = v & 3;
#pragma unroll 1
        for (int i = 0; i < 4; ++i) { const int qb = (i == 0) ? s : (i == 1) ? 7 - s : (i == 2) ? 8 + s : 15 - s; attn_unit<0>(F, bh >> 3, bh & 7, qb); }
#pragma unroll 1
        for (int i = 0; i < 4; ++i) { const int qb = (i == 0) ? s : (i == 1) ? 7 - s : (i == 2) ? 8 + s : 15 - s; attn_unit<1>(F, bh >> 3, bh & 7, qb); }
    }
}
}

struct EpiMerge {
    unsigned char* ws;
    __device__ __forceinline__ void mid(f32x4 (&acc)[2][2][4][2], const pg8::Unit& u, int wr, int wc, int fr, int fq) const {
        const int row0 = u.pm * 256 + wr * 64 + fr, cb = u.pn * 256 + 32 * wc + 4 * fq;
        const bf16_t* ga = (const bf16_t*)(ws + WS_GA); const bf16_t* gm = (const bf16_t*)(ws + WS_GM);
#pragma unroll
        for (int ai = 0; ai < 2; ++ai)
#pragma unroll
            for (int m = 0; m < 4; ++m) { const size_t off = (size_t)(row0 + 128 * ai + 16 * m) * DM + cb;
#pragma unroll
                for (int bj = 0; bj < 2; ++bj) { u32x2 av[2], gv[2]; ld8(ga + (off - 4 * fq) + 128 * bj, av[0], av[1], fq); ld8(gm + (off - 4 * fq) + 128 * bj, gv[0], gv[1], fq);
#pragma unroll
                    for (int n = 0; n < 2; ++n) { const u32x2 a = av[n], g = gv[n];
                        const f32x4 den = (f32x4){fmaxf(bflo(g.x), 1e-30f), fmaxf(bfhi(g.x), 1e-30f), fmaxf(bflo(g.y), 1e-30f), fmaxf(bfhi(g.y), 1e-30f)};
                        acc[ai][bj][m][n] = acc[ai][bj][m][n] * ((f32x4){bflo(a.x), bfhi(a.x), bflo(a.y), bfhi(a.y)} * (f32x4){__builtin_amdgcn_rcpf(den.x), __builtin_amdgcn_rcpf(den.y), __builtin_amdgcn_rcpf(den.z), __builtin_amdgcn_rcpf(den.w)});
                    } } asm volatile("" ::: "memory"); }
    }
    __device__ __forceinline__ void operator()(const f32x4 (&acc)[2][2][4][2], const pg8::Unit& u, int wr, int wc, int fr, int fq) const {
        const int row0 = u.pm * 256 + wr * 64 + fr, cb = u.pn * 256 + 32 * wc + 4 * fq;
        const bf16_t* gm = (const bf16_t*)(ws + WS_GM); bf16_t* mix = (bf16_t*)(ws + WS_MIXED);
#pragma unroll
        for (int ai = 0; ai < 2; ++ai)
#pragma unroll
            for (int m = 0; m < 4; ++m) { const size_t off = (size_t)(row0 + 128 * ai + 16 * m) * DM + cb;
#pragma unroll
                for (int bj = 0; bj < 2; ++bj) { u32x2 pk[2], gv[2]; ld8(gm + (off - 4 * fq) + 128 * bj, gv[0], gv[1], fq);
#pragma unroll
                    for (int n = 0; n < 2; ++n) {
                        const u32x2 g = gv[n];
                        pk[n] = pk4(acc[ai][bj][m][n] * (f32x4){fmaxf(bflo(g.x), 1e-30f), fmaxf(bfhi(g.x), 1e-30f), fmaxf(bflo(g.y), 1e-30f), fmaxf(bfhi(g.y), 1e-30f)});
                    }
                    st8(mix + (off - 4 * fq) + 128 * bj, pk[0], pk[1], fq); } asm volatile("" ::: "memory"); }
    }
};
struct EpiOut {
    unsigned char* ws; const float* x; float* out; const float* g2;
    __device__ __forceinline__ void operator()(const f32x4 (&acc)[2][2][4][2], const pg8::Unit& u, int wr, int wc, int fr, int fq) const {
        const int row0 = u.pm * 256 + wr * 64 + fr, cb = u.pn * 256 + 32 * wc + 4 * fq, b = (u.pm * 256) / SEQ;
        const float* mod = (const float*)(ws + WS_MOD) + (size_t)b * 6144; bf16_t* x1g = (bf16_t*)(ws + WS_X1G); float* ssq = (float*)(ws + WS_SSQ_X1);
        f32x4 gt[2][2], gm[2][2];
#pragma unroll
        for (int bj = 0; bj < 2; ++bj)
#pragma unroll
            for (int n = 0; n < 2; ++n) { const int c = cb + 128 * bj + 16 * n; gt[bj][n] = *(const f32x4*)(mod + 2048 + c); gm[bj][n] = *(const f32x4*)(g2 + c) * (*(const f32x4*)(mod + 4096 + c) + 1.0f); }
#pragma unroll
        for (int ai = 0; ai < 2; ++ai)
#pragma unroll
            for (int m = 0; m < 4; ++m) { const int row = row0 + 128 * ai + 16 * m; const size_t off = (size_t)row * DM + cb; float s = 0.f;
#pragma unroll
                for (int bj = 0; bj < 2; ++bj) { u32x2 pk[2];
#pragma unroll
                    for (int n = 0; n < 2; ++n) {
                        const f32x4 x1 = *(const f32x4*)(x + off + 128 * bj + 16 * n) + gt[bj][n] * acc[ai][bj][m][n];
                        s += sum4sq(x1);
                        pk[n] = pk4(x1 * gm[bj][n]);
                    }
                    st8(x1g + (off - 4 * fq) + 128 * bj, pk[0], pk[1], fq); }
                s = fq_sum(s);
                if (fq == 0) atomicAdd(ssq + row, s); asm volatile("" ::: "memory"); }
    }
};
struct EpiPQ {
    unsigned char* ws;
    __device__ __forceinline__ void operator()(const f32x4 (&acc)[2][2][4][2], const pg8::Unit& u, int wr, int wc, int fr, int fq) const {
        const int row0 = u.pm * 256 + wr * 64 + fr, cb = u.pn * 256 + 32 * wc + 4 * fq, b = (u.pm * 256) / SEQ;
        const float* bias = (const float*)(ws + WS_BIASQ) + (size_t)b * 2048; const float* ssq = (const float*)(ws + WS_SSQ_X1); bf16_t* pq = (bf16_t*)(ws + WS_PQ);
        f32x4 bv[2][2];
#pragma unroll
        for (int bj = 0; bj < 2; ++bj)
#pragma unroll
            for (int n = 0; n < 2; ++n) bv[bj][n] = *(const f32x4*)(bias + cb + 128 * bj + 16 * n);
#pragma unroll
        for (int ai = 0; ai < 2; ++ai)
#pragma unroll
            for (int m = 0; m < 4; ++m) { const int row = row0 + 128 * ai + 16 * m; const float rinv = __builtin_amdgcn_rsqf(ssq[row] * (1.f / DM) + EPS);
#pragma unroll
                for (int bj = 0; bj < 2; ++bj) st8(pq + (size_t)row * 2048 + (cb - 4 * fq) + 128 * bj, pk4(acc[ai][bj][m][0] * rinv + bv[bj][0]), pk4(acc[ai][bj][m][1] * rinv + bv[bj][1]), fq);
                asm volatile("" ::: "memory"); }
    }
};

#define XB_TMO      128
#define XB_XCNT(j)  (256  + 64 * (j))
#define XB_XSUB(j)  (1280 + 64 * (j))
#define XB_XGEN(j)  (2304 + 64 * (j))
#define XB_TOP      3328
#define XB_TOPGEN   3392
#define XB_SPIN_CAP (1u << 22)
__device__ __forceinline__ unsigned xb_ld(unsigned* p)              { return __hip_atomic_load(p, __ATOMIC_RELAXED, __HIP_MEMORY_SCOPE_AGENT); }
__device__ __forceinline__ unsigned xb_add(unsigned* p, unsigned v) { return __hip_atomic_fetch_add(p, v, __ATOMIC_RELAXED, __HIP_MEMORY_SCOPE_AGENT); }
__device__ __forceinline__ unsigned xb_xcc_id() { return (unsigned)__builtin_amdgcn_s_getreg((3 << 11) | 20) & 0xFu; }
#define XB_SPIN(cond, bar) do { unsigned _sp = 0; while (cond) { __builtin_amdgcn_s_sleep(1); \
    if ((++_sp & 255u) == 0u) { if (xb_ld(&(bar)[XB_TMO])) break; if (_sp > XB_SPIN_CAP) { atomicAdd(&(bar)[XB_TMO], 1u); break; } } } } while (0)
struct XcdBarrier { unsigned* bar; unsigned x; volatile LAS unsigned* st; };
__device__ __forceinline__ XcdBarrier xcd_barrier_post(unsigned* bar, volatile LAS unsigned* st) {
    XcdBarrier b; b.bar = bar; b.x = xb_xcc_id(); b.st = st;
    if (threadIdx.x == 0) (void)xb_add(&bar[XB_XCNT(b.x)], 1u);
    return b;
}
__device__ __forceinline__ void xcd_barrier_complete(unsigned* bar, unsigned x, unsigned& nloc, unsigned& nx) {
    const unsigned G = gridDim.x * gridDim.y * gridDim.z;
    unsigned sum, cnt, mine, sp = 0u;
    for (;;) {
        sum = 0u; cnt = 0u; mine = 0u;
#pragma unroll
        for (unsigned j = 0; j < 16; ++j) { const unsigned c = xb_ld(&bar[XB_XCNT(j)]); sum += c; cnt += (c > 0u) ? 1u : 0u; mine = (j == x) ? c : mine; }
        if (sum == G) break;
        __builtin_amdgcn_s_sleep(1);
        if ((++sp & 255u) == 0u) { if (xb_ld(&bar[XB_TMO])) break; if (sp > XB_SPIN_CAP) { atomicAdd(&bar[XB_TMO], 1u); break; } }
    }
    nloc = mine > 0u ? mine : 1u; nx = cnt > 0u ? cnt : 1u;
}
__device__ __forceinline__ void xcd_barrier(const XcdBarrier& b) {
    asm volatile("s_waitcnt vmcnt(0) lgkmcnt(0)" ::: "memory");
    __syncthreads();
    if (threadIdx.x == 0) {
        unsigned* bar = b.bar;
        __builtin_amdgcn_s_waitcnt(0);
        unsigned nloc = b.st[0], nx = b.st[1];
        if (nloc == 0u) { xcd_barrier_complete(bar, b.x, nloc, nx); b.st[0] = nloc; b.st[1] = nx; }
        const unsigned old = xb_add(&bar[XB_XSUB(b.x)], 1u);
        const unsigned gen = old / nloc;
        if (old + 1u == (gen + 1u) * nloc) {
            __builtin_amdgcn_fence(__ATOMIC_RELEASE, "agent");
            asm volatile("s_waitcnt vmcnt(0)" ::: "memory");
            const unsigned og = xb_add(&bar[XB_TOP], 1u);
            const unsigned tg = og / nx;
            if (og + 1u == (tg + 1u) * nx) xb_add(&bar[XB_TOPGEN], 1u);
            else XB_SPIN(xb_ld(&bar[XB_TOPGEN]) == tg, bar);
            __builtin_amdgcn_fence(__ATOMIC_ACQUIRE, "agent");
            xb_add(&bar[XB_XGEN(b.x)], 1u);
            asm volatile("s_waitcnt vmcnt(0)" ::: "memory");
        } else {
            XB_SPIN(xb_ld(&bar[XB_XGEN(b.x)]) == gen, bar);
            __builtin_amdgcn_fence(__ATOMIC_ACQUIRE, "agent");
            asm volatile("s_waitcnt vmcnt(0)" ::: "memory");
        }
    }
    __syncthreads();
}
#define grid_barrier(ctr, target) xcd_barrier(xbar)


namespace peer {
constexpr int TOK = 32;
constexpr int L_EXP = 0, L_GATE = L_EXP + TOK * 128 * 2, L_TOPI = L_GATE + TOK * 128 * 4, L_TOPV = L_TOPI + NWAVES * TOK * 32, L_CNT = L_TOPV + NWAVES * TOK * 32 * 4, L_SU = L_CNT + NWAVES * 64 * 4, L_BYTES = L_SU + TOK * 128 * 4;
static_assert(L_BYTES <= LDS_BYTES, "peer LDS");
__device__ __forceinline__ unsigned sortable(float v) { const unsigned u = __float_as_uint(v); return (u & 0x80000000u) ? ~u : (u | 0x80000000u); }
__device__ __forceinline__ float unsortable(unsigned k) { return __uint_as_float((k & 0x80000000u) ? (k & 0x7fffffffu) : ~k); }
__device__ __forceinline__ unsigned pair_max(unsigned m) { auto rr = __builtin_amdgcn_permlane32_swap(m, m, false, false); return rr[0] > rr[1] ? rr[0] : rr[1]; }
__device__ __forceinline__ float gelu_tanh(float x) { const float y = 0.7978845608028654f * (x + 0.044715f * x * x * x); const float e = __builtin_amdgcn_exp2f(y * (2.f * LOG2E)); return 0.5f * x * (2.f - 2.f * __builtin_amdgcn_rcpf(e + 1.f)); }

template <int CTRL> __device__ __forceinline__ float dppf(float v) { return __int_as_float(__builtin_amdgcn_update_dpp(0, __float_as_int(v), CTRL, 0xf, 0xf, true)); }
__device__ __forceinline__ float wsum_dpp(float v) {
    v += dppf<0xB1>(v); v += dppf<0x4E>(v); v += dppf<0x141>(v); v += dppf<0x140>(v);
    { auto r = __builtin_amdgcn_permlane16_swap(__float_as_uint(v), __float_as_uint(v), false, false); v = __uint_as_float(r[0]) + __uint_as_float(r[1]); }
    { auto r = __builtin_amdgcn_permlane32_swap(__float_as_uint(v), __float_as_uint(v), false, false); v = __uint_as_float(r[0]) + __uint_as_float(r[1]); }
    return v;
}
__device__ __forceinline__ void route_head(Frame& F, int tok0) {
    int lane = F.lane; asm volatile("" : "+v"(lane));
    const int h = F.wave, r32 = lane & 31, hi = lane >> 5;
    const bf16_t* PQ = (const bf16_t*)(F.ws + WS_PQ) + (size_t)(tok0 + r32) * 2048 + h * 256;
    const bf16_t* SK = (const bf16_t*)(F.ws + WS_SUBK) + (size_t)h * 2 * 128 * 128;
    LAS unsigned char* topi = (LAS unsigned char*)(F.lds + L_TOPI) + h * (TOK * 32) + r32 * 32;
    LAS float* topv = (LAS float*)(F.lds + L_TOPV) + h * (TOK * 32) + r32 * 32;
#pragma unroll 1
    for (int p = 0; p < 2; ++p) {
        f32x16 acc[4]; acc[0] = f32x16{}; acc[1] = f32x16{}; acc[2] = f32x16{}; acc[3] = f32x16{};
#pragma unroll 2
        for (int ks = 0; ks < 8; ++ks) {
            const bf16x8 bq = *(const bf16x8*)(PQ + p * 128 + 16 * ks + 8 * hi);
#pragma unroll
            for (int kb = 0; kb < 4; ++kb) {
                const bf16x8 ak = *(const bf16x8*)(SK + ((size_t)p * 128 + 32 * kb + r32) * 128 + 16 * ks + 8 * hi);
                acc[kb] = __builtin_amdgcn_mfma_f32_32x32x16_bf16(ak, bq, acc[kb], 0, 0, 0);
            }
        }
        unsigned key[64];
#pragma unroll
        for (int kb = 0; kb < 4; ++kb)
#pragma unroll
            for (int r = 0; r < 16; ++r) { const int kidx = 32 * kb + (r & 3) + 8 * (r >> 2) + 4 * hi; key[kb * 16 + r] = (sortable(acc[kb][r]) & ~127u) | (unsigned)(127 - kidx); }
#pragma unroll 1
        for (int it = 0; it < 16; ++it) {
            unsigned m = key[0];
#pragma unroll
            for (int r = 1; r < 64; ++r) m = key[r] > m ? key[r] : m;
            m = pair_max(m);
#pragma unroll
            for (int r = 0; r < 64; ++r) key[r] = (key[r] == m) ? 0u : key[r];
            if (hi == 0) { topi[p * 16 + it] = (unsigned char)(127 - (m & 127u)); topv[p * 16 + it] = unsortable(m & ~127u); }
        }
    }
    LDS_WAIT();
    unsigned cand[25];
    { float av[16], bv[16];
#pragma unroll
      for (int i = 0; i < 16; ++i) { av[i] = topv[i]; bv[i] = topv[16 + i]; }
      int n = 0;
#pragma unroll
      for (int i = 0; i < 16; ++i)
#pragma unroll
          for (int j = 0; j < 16; ++j) if ((i + 1) * (j + 1) <= 16) { const unsigned k = (sortable(av[i] + bv[j]) & ~255u) | (unsigned)(255 - (i * 16 + j)); if ((n & 1) == 0) { cand[n >> 1] = hi ? 0u : k; } else { cand[n >> 1] = hi ? k : cand[n >> 1]; } ++n; } }
    LAS unsigned short* ex_o = (LAS unsigned short*)(F.lds + L_EXP) + r32 * 128 + h * 16;
    LAS float* g_o = (LAS float*)(F.lds + L_GATE) + r32 * 128 + h * 16;
    float den = 0.f, s0 = 0.f;
#pragma unroll 1
    for (int it = 0; it < 16; ++it) {
        unsigned m = cand[0];
#pragma unroll
        for (int r = 1; r < 25; ++r) m = cand[r] > m ? cand[r] : m;
        m = pair_max(m);
#pragma unroll
        for (int r = 0; r < 25; ++r) cand[r] = (cand[r] == m) ? 0u : cand[r];
        const float sv = unsortable(m & ~255u); const unsigned pos = 255u - (m & 255u), i = pos >> 4, j = pos & 15u;
        if (it == 0) s0 = sv;
        const float ex = __builtin_amdgcn_exp2f((sv - s0) * LOG2E); den += ex;
        if (hi == 0) { ex_o[it] = (unsigned short)((unsigned)topi[i] * 128u + (unsigned)topi[16 + j]); g_o[it] = ex; }
    }
    const float rden = __builtin_amdgcn_rcpf(den);
    LDS_WAIT();
    if (hi == 0) {
#pragma unroll
        for (int it = 0; it < 16; ++it) g_o[it] *= rden;
    }
}

__device__ __forceinline__ void expert_tokens(Frame& F, int tok0) {
    int lane = F.lane; const int wid = F.wave;
    asm volatile("" : "+v"(lane));
    const unsigned char* PU = F.ws + WS_PU; const unsigned char* PV = F.ws + WS_PV;
    const float* USC = (const float*)(F.ws + WS_USC); const float* VSC = (const float*)(F.ws + WS_VSC);
    const float* ssq = (const float*)(F.ws + WS_SSQ_X1); const bf16_t* X1G = (const bf16_t*)(F.ws + WS_X1G);
    LAS unsigned* cnt = (LAS unsigned*)(F.lds + L_CNT) + wid * 64;
#pragma unroll 1
    for (int tt = 0; tt < 4; ++tt) {
        const int tl = 4 * wid + tt;
        LAS unsigned short* ex_l = (LAS unsigned short*)(F.lds + L_EXP) + tl * 128; LAS float* g_l = (LAS float*)(F.lds + L_GATE) + tl * 128; LAS float* su_l = (LAS float*)(F.lds + L_SU) + tl * 128;
        cnt[lane] = 0u;
        const unsigned e0 = ex_l[lane], e1 = ex_l[lane + 64]; const float g0 = g_l[lane] * VSC[e0], g1 = g_l[lane + 64] * VSC[e1]; const float s0 = USC[e0], s1 = USC[e1];
        const unsigned b0 = e0 >> 8, b1 = e1 >> 8;
        LDS_WAIT(); asm volatile("" ::: "memory");
        const unsigned r0 = __hip_atomic_fetch_add(cnt + b0, 1u, __ATOMIC_RELAXED, __HIP_MEMORY_SCOPE_WORKGROUP);
        const unsigned r1 = __hip_atomic_fetch_add(cnt + b1, 1u, __ATOMIC_RELAXED, __HIP_MEMORY_SCOPE_WORKGROUP);
        LDS_WAIT(); asm volatile("" ::: "memory");
        const int c = (int)cnt[lane]; int incl = c;
#pragma unroll
        for (int o = 1; o < 64; o <<= 1) { const int tv = __shfl_up(incl, o); incl += (lane >= o) ? tv : 0; }
        const int excl = incl - c;
        const int p0 = __shfl(excl, (int)b0) + (int)r0, p1 = __shfl(excl, (int)b1) + (int)r1;
        ex_l[p0] = (unsigned short)e0; ex_l[p1] = (unsigned short)e1; g_l[p0] = g0; g_l[p1] = g1; su_l[p0] = s0; su_l[p1] = s1;
        LDS_WAIT(); asm volatile("" ::: "memory");
    }
    {
        unsigned hA[4][2], hB[4][2]; float hinv[4]; f16x2 acc2[4][8]; u32x4 xg[4][2];
#pragma unroll
        for (int u = 0; u < 4; ++u) {
            const int t = tok0 + 4 * wid + u, b = t / SEQ;
            const float* mod = (const float*)(F.ws + WS_MOD) + (size_t)b * 6144;
            const float rinv = __builtin_amdgcn_rsqf(ssq[t] * (1.f / DM) + EPS);
            const u32x4 x0 = *(const u32x4*)(X1G + (size_t)t * DM + 16 * lane), x1 = *(const u32x4*)(X1G + (size_t)t * DM + 16 * lane + 8);
            float hv[16]; float amax = 1e-30f; xg[u][0] = x0; xg[u][1] = x1;
#pragma unroll
            for (int j = 0; j < 4; ++j) { const f32x4 sh = *(const f32x4*)(mod + 3072 + 16 * lane + 4 * j); const unsigned w0 = (j < 2) ? x0[2 * j] : x1[2 * j - 4], w1 = (j < 2) ? x0[2 * j + 1] : x1[2 * j - 3];
                hv[4 * j] = bflo(w0) * rinv + sh.x; hv[4 * j + 1] = bfhi(w0) * rinv + sh.y; hv[4 * j + 2] = bflo(w1) * rinv + sh.z; hv[4 * j + 3] = bfhi(w1) * rinv + sh.w; }
#pragma unroll
            for (int i = 0; i < 16; ++i) amax = fmaxf(amax, fabsf(hv[i]));
#pragma unroll
            for (int o = 32; o >= 1; o >>= 1) amax = fmaxf(amax, __shfl_xor(amax, o));
            const float hs = 119.f / amax; hinv[u] = amax * (1.f / 119.f);
            hA[u][0] = hA[u][1] = hB[u][0] = hB[u][1] = 0u;
#pragma unroll
            for (int i = 0; i < 16; ++i) { const int q = (int)__builtin_rintf(hv[i] * hs); const int lo = ((q + 8) & 15) - 8; const int hi = (q - lo) >> 4;
                hA[u][i >> 3] |= ((unsigned)hi & 15u) << (4 * (i & 7)); hB[u][i >> 3] |= ((unsigned)lo & 15u) << (4 * (i & 7)); }
#pragma unroll
            for (int i = 0; i < 8; ++i) acc2[u][i] = (f16x2){(_Float16)0.f, (_Float16)0.f};
            asm volatile("" ::: "memory");
        }
        const LAS unsigned short* ex_w = (const LAS unsigned short*)(F.lds + L_EXP) + (4 * wid) * 128;
        const LAS float* g_w = (const LAS float*)(F.lds + L_GATE) + (4 * wid) * 128;
        const LAS float* su_w = (const LAS float*)(F.lds + L_SU) + (4 * wid) * 128;
        const int kl = ((lane >> 5) & 1) | (((lane >> 4) & 1) << 1);
        const unsigned voff = 8u * (unsigned)lane;
        const __amdgpu_buffer_rsrc_t rsU = __builtin_amdgcn_make_buffer_rsrc((void*)PU, (short)0, PNEXP * (DM / 2), 0x00020000), rsV = __builtin_amdgcn_make_buffer_rsrc((void*)PV, (short)0, PNEXP * (DM / 2), 0x00020000);
        u32x2 ua[4], va[4], ub[4], vb[4]; float ga, gb, sua, sub_;
#define PEER_LOAD(U, V, G, SU, u, e0) do { _Pragma("unroll") for (int k = 0; k < 4; ++k) { const int eid = __builtin_amdgcn_readfirstlane((int)ex_w[(u) * 128 + (e0) + k]); \
            U[k] = (u32x2)__builtin_amdgcn_raw_buffer_load_b64(rsU, (int)voff, eid * (DM / 2), 0); V[k] = (u32x2)__builtin_amdgcn_raw_buffer_load_b64(rsV, (int)voff, eid * (DM / 2), 0); } \
            { SU = su_w[(u) * 128 + (e0) + kl] * hinv[u]; G = g_w[(u) * 128 + (e0) + kl]; } } while (0)
#define VACC(j, b) acc2[u_][4 * (j) + (b)] = __builtin_elementwise_fma(c2, __builtin_bit_cast(f16x2, __builtin_amdgcn_cvt_scalef32_pk_f16_fp4(Vk[j], 1.0f, b)), acc2[u_][4 * (j) + (b)])
#define PEER_COMP(U, V, G, SU, u) do { constexpr int u_ = (u); float dd[4]; _Pragma("unroll") for (int k = 0; k < 4; ++k) { \
            const int da = __builtin_amdgcn_sdot8((int)U[k][1], (int)hA[u_][1], __builtin_amdgcn_sdot8((int)U[k][0], (int)hA[u_][0], 0, false), false); \
            const int db = __builtin_amdgcn_sdot8((int)U[k][1], (int)hB[u_][1], __builtin_amdgcn_sdot8((int)U[k][0], (int)hB[u_][0], 0, false), false); \
            dd[k] = (float)(16 * da + db); } \
            float z; { auto r0 = __builtin_amdgcn_permlane32_swap(__float_as_uint(dd[0]), __float_as_uint(dd[1]), false, false); const float s01 = __uint_as_float(r0[0]) + __uint_as_float(r0[1]); \
              auto r1 = __builtin_amdgcn_permlane32_swap(__float_as_uint(dd[2]), __float_as_uint(dd[3]), false, false); const float s23 = __uint_as_float(r1[0]) + __uint_as_float(r1[1]); \
              auto r2 = __builtin_amdgcn_permlane16_swap(__float_as_uint(s01), __float_as_uint(s23), false, false); z = __uint_as_float(r2[0]) + __uint_as_float(r2[1]); } \
            z += dppf<0xB1>(z); z += dppf<0x4E>(z); z += dppf<0x141>(z); z += dppf<0x140>(z); \
            const float cf_ = G * gelu_tanh(z * SU); const f16x2 ch_ = (f16x2){(_Float16)cf_, (_Float16)cf_}; const int ci = __builtin_bit_cast(int, ch_); \
            _Pragma("unroll") for (int k = 0; k < 4; ++k) { const f16x2 c2 = __builtin_bit_cast(f16x2, __builtin_amdgcn_readlane(ci, ((k & 1) << 5) | ((k >> 1) << 4))); const u32x2 Vk = V[k]; \
            VACC(0, 0); VACC(0, 1); VACC(0, 2); VACC(0, 3); VACC(1, 0); VACC(1, 1); VACC(1, 2); VACC(1, 3); } } while (0)
        PEER_LOAD(ua, va, ga, sua, 0, 0);
#pragma unroll 1
        for (int j = 0; j < 32; ++j) {
            const int jn = (j + 1 < 32) ? j + 1 : 31;
            PEER_LOAD(ub, vb, gb, sub_, 1, 4 * j);     PEER_COMP(ua, va, ga, sua, 0);
            PEER_LOAD(ua, va, ga, sua, 2, 4 * j);      PEER_COMP(ub, vb, gb, sub_, 1);
            PEER_LOAD(ub, vb, gb, sub_, 3, 4 * j);     PEER_COMP(ua, va, ga, sua, 2);
            PEER_LOAD(ua, va, ga, sua, 0, 4 * jn);     PEER_COMP(ub, vb, gb, sub_, 3);
        }
#undef PEER_LOAD
#undef PEER_COMP
#undef VACC
#pragma unroll
        for (int u = 0; u < 4; ++u) {
            const int t = tok0 + 4 * wid + u, b = t / SEQ; const float* mod = (const float*)(F.ws + WS_MOD) + (size_t)b * 6144;
            float* op = F.out + (size_t)t * DM + 16 * lane; const float* g2 = F.in[IN_G2] + 16 * lane;
            const u32x4 y0 = xg[u][0], y1 = xg[u][1];
#pragma unroll
            for (int j = 0; j < 4; ++j) { const f32x4 g = *(const f32x4*)(mod + 5120 + 16 * lane + 4 * j); const f32x4 gmv = *(const f32x4*)(g2 + 4 * j) * (*(const f32x4*)(mod + 4096 + 16 * lane + 4 * j) + 1.0f);
                const unsigned w0 = (j < 2) ? y0[2 * j] : y1[2 * j - 4], w1 = (j < 2) ? y0[2 * j + 1] : y1[2 * j - 3];
                const f32x4 x = (f32x4){bflo(w0), bfhi(w0), bflo(w1), bfhi(w1)} * (f32x4){__builtin_amdgcn_rcpf(gmv.x), __builtin_amdgcn_rcpf(gmv.y), __builtin_amdgcn_rcpf(gmv.z), __builtin_amdgcn_rcpf(gmv.w)};
                *(f32x4*)(op + 4 * j) = x + g * (f32x4){(float)acc2[u][2 * j].x, (float)acc2[u][2 * j].y, (float)acc2[u][2 * j + 1].x, (float)acc2[u][2 * j + 1].y}; }
        }
    }
}
__device__ __forceinline__ void peer_phase(Frame& F) {
    for (int u = F.bid; u < T / TOK; u += F.G) {
        const int tok0 = u * TOK;
        route_head(F, tok0);
        __syncthreads();
        expert_tokens(F, tok0);
        __syncthreads();
    }
}
}

__global__ void __launch_bounds__(NTHREADS, 2) hybrid_fwd(Args args) {
    extern __shared__ __attribute__((aligned(16))) unsigned char lds_raw[];
    cg::grid_group grid = cg::this_grid();
    Frame F;
    F.lds = (LAS unsigned char*)lds_raw; F.ws = args.ws;
    F.tid = threadIdx.x; F.lane = F.tid & 63; F.wave = __builtin_amdgcn_readfirstlane(F.tid >> 6);
    F.G = gridDim.x; F.bid = blockIdx.x;
#pragma unroll
    for (int i = 0; i < 24; ++i) F.in[i] = args.in[i];
    F.out = args.out;
    unsigned char* ws = args.ws;
    const int lo = args.ph_lo, hi = args.ph_hi;
#define IN(k) (lo <= (k) && (k) < hi)
    unsigned nbar = 0; unsigned* barctr = (unsigned*)(ws + WS_BAR);
    volatile LAS unsigned* xst = (volatile LAS unsigned*)(F.lds + LDS_BYTES - 64);
    if (F.tid < 2) xst[F.tid] = 0u;
    __syncthreads();
    XcdBarrier xbar; xbar.bar = barctr; xbar.x = 0; xbar.st = xst;
#define SEAM(k) do { if (IN(k) && IN((k) + 1)) { if ((k) == 0) { asm volatile("s_waitcnt vmcnt(0) lgkmcnt(0)" ::: "memory"); __syncthreads(); grid.sync(); \
        __builtin_amdgcn_fence(__ATOMIC_ACQUIRE, "agent"); asm volatile("s_waitcnt vmcnt(0)" ::: "memory"); __syncthreads(); xbar = xcd_barrier_post(barctr, xst); } \
        else { ++nbar; grid_barrier(barctr, nbar * (unsigned)F.G); } } } while (0)
    if (IN(0)) { phase0(F); __syncthreads(); }
    SEAM(0);
    if (IN(1)) { phase1(F); }
    SEAM(1);
    if (IN(2)) {
        pg8::StaticOrder S; S.init((const bf16_t*)(ws + WS_XN), (const bf16_t*)(ws + WS_WIN), T, IN_PAD, DM, F.G, F.bid);
        EpiIn E{ws, F.in[IN_GAQ], F.in[IN_GAK], F.in[IN_GIDXK], F.in[IN_GMK]};
        pg8::gemm_phase(F.lds, DM, S, E);
    }
    SEAM(2);
    if (IN(3)) {
        { pg8::StaticOrder S; S.init((const bf16_t*)(ws + WS_CQ), (const bf16_t*)(ws + WS_WQUP), T, 768, QRANK, F.G, F.bid);
          EpiQup E{ws, F.in[IN_GMQ]}; pg8::gemm_phase(F.lds, QRANK, S, E); }
        { pg8::StaticOrder S; S.init((const bf16_t*)(ws + WS_CKV), (const bf16_t*)(ws + WS_WKVUP), T, 1024, KVRANK, F.G, F.bid);
          EpiKVup E{ws, F.in[IN_GMK]}; pg8::gemm_phase(F.lds, KVRANK, S, E); }
        indexer_phase(F);
    }
    SEAM(3);
    if (IN(4)) { att::attn_phase(F); }
    SEAM(4);
    if (IN(5)) {
        cvt_i4_rows(F.in[IN_PU], ws + WS_PU, (float*)(ws + WS_USC), PNEXP, F.bid * NWAVES + F.wave, F.G * NWAVES, F.lane);
        cvt_fp4_rows(F.in[IN_PV], ws + WS_PV, (float*)(ws + WS_VSC), PNEXP, F.bid * NWAVES + F.wave, F.G * NWAVES, F.lane);
        pg8::DualOrder S; S.A0 = (const char*)(ws + WS_QA); S.B0 = (const char*)(ws + WS_WOA); S.A1 = (const char*)(ws + WS_QMN); S.B1 = (const char*)(ws + WS_WOM);
        S.nM = T / 256; S.nN = DM / 256; S.G = F.G; S.c = F.bid; S.tstep = (size_t)256 * AW * 2;
        EpiMerge E{ws}; pg8::gemm_phase<true>(F.lds, AW, S, E);
    }
    SEAM(5);
    if (IN(6)) {
        pg8::StaticOrder S; S.init((const bf16_t*)(ws + WS_MIXED), (const bf16_t*)(ws + WS_WOUT), T, DM, DM, F.G, F.bid);
        EpiOut E{ws, F.in[IN_X], F.out, F.in[IN_G2]}; pg8::gemm_phase(F.lds, DM, S, E);
    }
    SEAM(6);
    if (IN(7)) {
        pg8::StaticOrder S; S.init((const bf16_t*)(ws + WS_X1G), (const bf16_t*)(ws + WS_WPQ), T, 2048, DM, F.G, F.bid);
        EpiPQ E{ws}; pg8::gemm_phase(F.lds, DM, S, E);
    }
    SEAM(7);
    if (IN(8)) { peer::peer_phase(F); }
#undef IN
#undef SEAM
}

extern "C" void kernel_launch(void* const* d_in, const int* in_sizes, int n_in, void* d_out, int out_size, void* d_ws, size_t ws_size, hipStream_t stream) {
    static int grid = 0;
    if (grid == 0) {
        if (n_in != 24 || out_size != T * DM || ws_size < WS_END) { fprintf(stderr, "kernel_launch: unexpected shapes (n_in %d, out %d, ws %zu < %zu)\n", n_in, out_size, ws_size, (size_t)WS_END); grid = -1; return; }
        int dev = 0, cus = 0, per_cu = 0;
        (void)hipGetDevice(&dev); (void)hipDeviceGetAttribute(&cus, hipDeviceAttributeMultiprocessorCount, dev);
        if (hipFuncSetAttribute((const void*)hybrid_fwd, hipFuncAttributeMaxDynamicSharedMemorySize, LDS_BYTES) != hipSuccess) { fprintf(stderr, "kernel_launch: hipFuncSetAttribute failed\n"); grid = -1; return; }
        if (hipOccupancyMaxActiveBlocksPerMultiprocessor(&per_cu, (const void*)hybrid_fwd, NTHREADS, LDS_BYTES) != hipSuccess || per_cu < 1) { fprintf(stderr, "kernel_launch: occupancy query says %d blocks/CU\n", per_cu); (void)hipGetLastError(); per_cu = 1; }
        grid = cus * (per_cu < 1 ? 1 : 1);
        fprintf(stderr, "kernel_launch: grid %d (cus %d, occupancy %d/CU)\n", grid, cus, per_cu);
    }
    if (grid < 0) return;
    Args a{};
    for (int i = 0; i < 24; ++i) a.in[i] = (const float*)d_in[i];
    a.out = (float*)d_out; a.ws = (unsigned char*)d_ws;
    a.ph_lo = 0; a.ph_hi = 9;
    void* kargs[] = {&a};
    hipError_t e = hipLaunchCooperativeKernel((const void*)hybrid_fwd, dim3(grid), dim3(NTHREADS), kargs, LDS_BYTES, stream);
    if (e != hipSuccess) fprintf(stderr, "kernel_launch: cooperative launch failed: %s (grid %d)\n", hipGetErrorString(e), grid);
}
```

```cpp
#include <hip/hip_runtime.h>
#include <hip/hip_cooperative_groups.h>
#include <cstdio>
#include <cstdint>
namespace cg = cooperative_groups;

#define LAS __attribute__((address_space(3)))
typedef unsigned short bf16_t;
typedef short bf16x8 __attribute__((ext_vector_type(8)));
typedef short s16x4 __attribute__((ext_vector_type(4)));
typedef float f32x2 __attribute__((ext_vector_type(2)));
typedef float f32x4 __attribute__((ext_vector_type(4)));
typedef float f32x16 __attribute__((ext_vector_type(16)));
typedef unsigned u32x2 __attribute__((ext_vector_type(2)));
typedef unsigned u32x4 __attribute__((ext_vector_type(4)));
typedef __bf16 bf16x2_t __attribute__((ext_vector_type(2)));
typedef _Float16 f16x2 __attribute__((ext_vector_type(2)));

constexpr int NB = 8, SEQ = 4096, DM = 1024, T = NB * SEQ;
constexpr int AW = 512, NH = 8, HD = 64;
constexpr int QRANK = 384, KVRANK = 256, NOPE = 64, ROPED = 32, MQK = 96;
constexpr int IN_WIDTH = 4840, IN_PAD = 5120;
constexpr int PH = 8, PNK = 128, PNEXP = 16384, PDK = 256, PTOPK = 16;
constexpr int NSEL = 256;
constexpr float EPS = 1e-6f;
constexpr float LOG2E = 1.4426950408889634f;
constexpr float C2A = 0.125f * LOG2E;
constexpr float C2B = 0.10206207261596577f * LOG2E;

constexpr size_t MiB = 1u << 20;
constexpr size_t WS_ZERO = 0, ZERO_BYTES = 2 * MiB;
constexpr size_t WS_SSQ_CQ = 0;
constexpr size_t WS_SSQ_CKV = WS_SSQ_CQ + (size_t)T * 4;
constexpr size_t WS_SSQ_X1 = WS_SSQ_CKV + (size_t)T * 4;
constexpr size_t WS_SSQ_QM = WS_SSQ_X1 + (size_t)T * 4;
constexpr size_t WS_MOD = WS_SSQ_QM + (size_t)T * 8 * 4;
constexpr size_t WS_BIASQ = WS_MOD + (size_t)NB * 6144 * 4;
constexpr size_t WS_BAR = WS_BIASQ + (size_t)NB * 2048 * 4;
static_assert(WS_BAR + 3456 * 4 <= ZERO_BYTES, "zero region");
constexpr size_t WS_WIN = 3 * MiB;
constexpr size_t WS_WQUP = WS_WIN + (size_t)IN_PAD * DM * 2;
constexpr size_t WS_WKVUP = WS_WQUP + (size_t)768 * 384 * 2;
constexpr size_t WS_WOA = WS_WKVUP + (size_t)1024 * 256 * 2;
constexpr size_t WS_WOM = WS_WOA + (size_t)1024 * 512 * 2;
constexpr size_t WS_WOUT = WS_WOM + (size_t)1024 * 512 * 2;
constexpr size_t WS_WPQ = WS_WOUT + (size_t)1024 * 1024 * 2;
constexpr size_t WS_SUBK = WS_WPQ + (size_t)2048 * 1024 * 2;
constexpr size_t WS_ROPE32 = WS_SUBK + (size_t)16 * 128 * 128 * 2;
constexpr size_t WS_ROPE16 = WS_ROPE32 + (size_t)T * 64 * 4;
constexpr size_t WS_W_END = WS_ROPE16 + (size_t)T * 32 * 4;
static_assert(WS_W_END <= 36 * MiB, "weights region");
constexpr size_t R1 = 36 * MiB;
constexpr size_t WS_XN = R1, WS_QMN = R1, WS_QMR = R1 + 32 * MiB;
constexpr size_t R2 = 100 * MiB;
constexpr size_t WS_QA = R2, WS_KA = R2 + 32 * MiB, WS_VA = R2 + 64 * MiB, WS_QI = R2 + 96 * MiB, WS_PQ = R2;
constexpr size_t R3 = 228 * MiB;
constexpr size_t WS_GA = R3, WS_GM = R3 + 64 * MiB, WS_X1G = R3;
constexpr size_t R4 = 356 * MiB;
constexpr size_t WS_KMN = R4, WS_KMR = R4 + 32 * MiB, WS_VM = R4 + 48 * MiB, WS_PU = R4, WS_PV = R4 + 16 * MiB, WS_USC = R4 + 32 * MiB, WS_VSC = R4 + 33 * MiB;
constexpr size_t R5 = 436 * MiB;
constexpr size_t WS_CQ = R5, WS_CKV = R5 + 24 * MiB, WS_KI = R5 + 40 * MiB, WS_WI = R5 + 44 * MiB, WS_KPER = R5 + 45 * MiB,
                 WS_KPESSQ = R5 + 49 * MiB, WS_MASK = R5 + 50 * MiB, WS_MIXED = R5;
constexpr size_t WS_END = 502 * MiB;
static_assert(WS_MASK + (size_t)NB * 64 * SEQ * 8 <= WS_END, "ws map");

constexpr int LDS_BYTES = 155648;
constexpr int NWAVES = 8, NTHREADS = 512;

__device__ __forceinline__ unsigned cvt_pk_bf16(float lo, float hi) { unsigned r; asm volatile("v_cvt_pk_bf16_f32 %0, %1, %2" : "=v"(r) : "v"(lo), "v"(hi)); return r; }
__device__ __forceinline__ unsigned cvtpk_s(float lo, float hi) { f32x2 v = {lo, hi}; bf16x2_t b = __builtin_convertvector(v, bf16x2_t); return __builtin_bit_cast(unsigned, b); }
__device__ __forceinline__ float bf2f(unsigned short b) { return __uint_as_float((unsigned)b << 16); }
__device__ __forceinline__ float bflo(unsigned w) { return __uint_as_float(w << 16); }
__device__ __forceinline__ float bfhi(unsigned w) { return __uint_as_float(w & 0xffff0000u); }
__device__ __forceinline__ float rdlane_f(float v, int l) { return __int_as_float(__builtin_amdgcn_readlane(__float_as_int(v), l)); }
__device__ __forceinline__ float sigmoidf_(float v) { return __builtin_amdgcn_rcpf(1.0f + __builtin_amdgcn_exp2f(-v * LOG2E)); }
#define LDS_WAIT() asm volatile("s_waitcnt lgkmcnt(0)" ::: "memory")
#define VM_WAIT() asm volatile("s_waitcnt vmcnt(0)" ::: "memory")

namespace pg8 {
constexpr int BM = 256, BK = 64, HALF = 128, HTB = HALF * BK * 2, STAGE_BYTES = 8 * HTB, NXCD = 8, WGM = 8;
__host__ __device__ __forceinline__ int lds_byte(int r, int c) { const int st = (r >> 4) * 2 + (c >> 5), rr = r & 15, cc = c & 31, ob = rr * 64 + cc * 2; return st * 1024 + (ob ^ (((ob >> 9) & 1) << 5)); }
__host__ __device__ __forceinline__ void stage_rc(int b, int& R, int& C) { const int st = b / 1024, sb = b % 1024, swz = sb ^ (((sb >> 9) & 1) << 5); R = (st >> 1) * 16 + swz / 64; C = (st & 1) * 32 + (swz % 64) / 2; }

struct Unit { int pm, pn, tag; const char* A; const char* B; };

__device__ __forceinline__ bool tile_order(int L, int nM, int nN, int& pm, int& pn) {
    const int nwg = nM * nN; if (L >= nwg) return false;
    int wgid = L; { const int q = nwg / NXCD, r = nwg % NXCD, xcd = wgid % NXCD, off = wgid / NXCD; wgid = (xcd < r ? xcd * (q + 1) : r * (q + 1) + (xcd - r) * q) + off; }
    const int nig = WGM * nN, gid = wgid / nig, fm = gid * WGM, gsz = (nM - fm) < WGM ? (nM - fm) : WGM;
    pm = fm + ((wgid % nig) % gsz); pn = (wgid % nig) / gsz; return true;
}
struct StaticOrder {
    const char* A; const char* Bt; int nM, nN, G, c; size_t tstep;
    __device__ void init(const bf16_t* A_, const bf16_t* Bt_, int M, int N, int K, int G_, int c_) { A = (const char*)A_; Bt = (const char*)Bt_; nM = M / BM; nN = N / BM; G = G_; c = c_; tstep = (size_t)BM * K * 2; }
    __device__ __forceinline__ bool next(int i, Unit& u) const {
        int pm, pn; if (!tile_order(i * G + c, nM, nN, pm, pn)) return false;
        u.pm = pm; u.pn = pn; u.tag = 0; u.A = A + (size_t)pm * tstep; u.B = Bt + (size_t)pn * tstep; return true;
    }
};
struct DualOrder {
    const char* A0; const char* B0; const char* A1; const char* B1; int nM, nN, G, c; size_t tstep;
    __device__ __forceinline__ bool next(int i, Unit& u) const {
        int pm, pn; if (!tile_order((i >> 1) * G + c, nM, nN, pm, pn)) return false;
        u.pm = pm; u.pn = pn; u.tag = i & 1; u.A = ((i & 1) ? A1 : A0) + (size_t)pm * tstep; u.B = ((i & 1) ? B1 : B0) + (size_t)pn * tstep; return true;
    }
};

template <bool MERGE = false, class Epi, class Sched>
__device__ __forceinline__ void gemm_phase(LAS unsigned char* lds, const int K, const Sched& S, const Epi& E) {
    const int tid = threadIdx.x, wid = __builtin_amdgcn_readfirstlane(tid >> 6), lane = tid & 63, wr = wid >> 2, wc = wid & 3, fr = lane & 15, fq = lane >> 4;
    const int nt = K / BK;
    unsigned voffA[2];
#pragma unroll
    for (int i = 0; i < 2; ++i) { int R, C; stage_rc(tid * 16 + i * 8192, R, C); voffA[i] = (unsigned)(R * K + C) * 2u; }
    const size_t kstep = (size_t)(BK * 2);
    const size_t hstep = (size_t)HALF * K * 2;
    const unsigned ldsw = (unsigned)wid * 1024u;
    const int aoff = lds_byte(wr * 64 + fr, fq * 8), boff = lds_byte(wc * 32 + fr, fq * 8);
#define PG8_SA(b, h) (((b) * 2 + (h)) * HTB)
#define PG8_SB(b, h) ((4 + (b) * 2 + (h)) * HTB)
#define PG8_STAGE(bufoff, gbase) do { _Pragma("unroll") for (int _i = 0; _i < 2; ++_i) \
        __builtin_amdgcn_global_load_lds((const unsigned*)((const char*)(gbase) + voffA[_i]), (LAS unsigned*)(lds + (bufoff) + ldsw + _i * 8192), 16, 0, 0); } while (0)
#define PG8_LDA(dst, b, h) do { _Pragma("unroll") for (int m = 0; m < 4; ++m) _Pragma("unroll") for (int k = 0; k < 2; ++k) dst[m][k] = *(const LAS bf16x8*)(lds + PG8_SA(b, h) + aoff + m * 2048 + k * 1024); } while (0)
#define PG8_LDB(dst, b, h) do { _Pragma("unroll") for (int n = 0; n < 2; ++n) _Pragma("unroll") for (int k = 0; k < 2; ++k) dst[n][k] = *(const LAS bf16x8*)(lds + PG8_SB(b, h) + boff + n * 2048 + k * 1024); } while (0)
#define PG8_MMA(ai, bj, At, Bt) do { __builtin_amdgcn_s_setprio(1); _Pragma("unroll") for (int m = 0; m < 4; ++m) _Pragma("unroll") for (int n = 0; n < 2; ++n) _Pragma("unroll") for (int k = 0; k < 2; ++k) \
        acc[ai][bj][m][n] = __builtin_amdgcn_mfma_f32_16x16x32_bf16(Bt[n][k], At[m][k], acc[ai][bj][m][n], 0, 0, 0); __builtin_amdgcn_s_setprio(0); } while (0)
#define PG8_WAIT_V(n) asm volatile("s_waitcnt vmcnt(" #n ")" ::: "memory")
#define PG8_WAIT_L(n) asm volatile("s_waitcnt lgkmcnt(" #n ")" ::: "memory")
#define PG8_BAR __builtin_amdgcn_s_barrier()
#define PG8_SCHED __builtin_amdgcn_sched_barrier(0)
    Unit cur, nxt; int ui = 0;
    if (!S.next(0, cur)) return;
    f32x4 acc[2][2][4][2];
#pragma unroll
    for (int a = 0; a < 2; ++a)
#pragma unroll
        for (int b = 0; b < 2; ++b)
#pragma unroll
            for (int m = 0; m < 4; ++m)
#pragma unroll
                for (int n = 0; n < 2; ++n) acc[a][b][m][n] = (f32x4){0.f, 0.f, 0.f, 0.f};
    bf16x8 At[4][2], B0[2][2], B1[2][2];
    const char* cA = cur.A; const char* cB = cur.B;
    PG8_STAGE(PG8_SB(0, 0), cB); PG8_STAGE(PG8_SB(0, 1), cB + hstep); PG8_STAGE(PG8_SA(0, 0), cA); PG8_STAGE(PG8_SA(0, 1), cA + hstep);
    if (wr == 1) PG8_BAR;
    PG8_WAIT_V(2); PG8_BAR;
    PG8_STAGE(PG8_SB(1, 0), cB + kstep); PG8_STAGE(PG8_SA(1, 0), cA + kstep); PG8_STAGE(PG8_SB(1, 1), cB + hstep + kstep);
    PG8_WAIT_V(6); PG8_BAR;
    for (;;) {
        const bool has_next = S.next(ui + 1, nxt);
        const char* nA = has_next ? nxt.A : cA; const char* nB = has_next ? nxt.B : cB;
#pragma unroll 1
        for (int t = 0; t < nt; t += 2) {
            const bool last = (t == nt - 2);
            const char* a1 = cA + (size_t)(t + 1) * kstep;
            const char* a2 = last ? nA : cA + (size_t)(t + 2) * kstep; const char* b2 = last ? nB : cB + (size_t)(t + 2) * kstep;
            const char* a3 = a2 + kstep; const char* b3 = b2 + kstep;
            PG8_LDB(B0, 0, 0); PG8_LDB(B1, 0, 1); PG8_SCHED; PG8_LDA(At, 0, 0); PG8_STAGE(PG8_SA(1, 1), a1 + hstep);
            PG8_WAIT_V(8); PG8_WAIT_L(0); PG8_BAR; PG8_MMA(0, 0, At, B0); PG8_MMA(0, 1, At, B1); PG8_BAR; PG8_SCHED;
            PG8_LDA(At, 0, 1); PG8_STAGE(PG8_SB(0, 0), b2); PG8_STAGE(PG8_SB(0, 1), b2 + hstep); PG8_STAGE(PG8_SA(0, 0), a2);
            PG8_WAIT_V(8); PG8_WAIT_L(0); PG8_BAR; PG8_MMA(1, 0, At, B0); PG8_MMA(1, 1, At, B1); PG8_BAR; PG8_SCHED;
            PG8_LDB(B0, 1, 0); PG8_LDB(B1, 1, 1); PG8_SCHED; PG8_LDA(At, 1, 0); PG8_STAGE(PG8_SA(0, 1), a2 + hstep);
            PG8_WAIT_V(8); PG8_WAIT_L(0); PG8_BAR; PG8_MMA(0, 0, At, B0); PG8_MMA(0, 1, At, B1); PG8_BAR; PG8_SCHED;
            PG8_LDA(At, 1, 1); PG8_STAGE(PG8_SB(1, 0), b3); PG8_STAGE(PG8_SB(1, 1), b3 + hstep); PG8_STAGE(PG8_SA(1, 0), a3);
            PG8_WAIT_V(8); PG8_WAIT_L(0); PG8_BAR; PG8_MMA(1, 0, At, B0); PG8_MMA(1, 1, At, B1); PG8_BAR; PG8_SCHED;
        }
        if (wr == 0) PG8_BAR;
        bool keep = false;
        if constexpr (MERGE) { if (cur.tag == 0) { E.mid(acc, cur, wr, wc, fr, fq); keep = true; } else E(acc, cur, wr, wc, fr, fq); } else E(acc, cur, wr, wc, fr, fq);
        if (!has_next) break;
        if (!keep) {
#pragma unroll
        for (int a = 0; a < 2; ++a)
#pragma unroll
            for (int b = 0; b < 2; ++b)
#pragma unroll
                for (int m = 0; m < 4; ++m)
#pragma unroll
                    for (int n = 0; n < 2; ++n) acc[a][b][m][n] = (f32x4){0.f, 0.f, 0.f, 0.f};
        }
        cur = nxt; cA = nA; cB = nB; ++ui;
        if (wr == 1) PG8_BAR;
    }
    PG8_WAIT_V(0);
    PG8_BAR;
#undef PG8_SA
#undef PG8_SB
#undef PG8_STAGE
#undef PG8_LDA
#undef PG8_LDB
#undef PG8_MMA
#undef PG8_WAIT_V
#undef PG8_WAIT_L
#undef PG8_BAR
#undef PG8_SCHED
}
}

struct Args {
    const float* in[24]; float* out; unsigned char* ws; int ph_lo, ph_hi;
};
struct Frame {
    LAS unsigned char* lds; unsigned char* ws;
    int tid, lane, wave, G, bid;
    const float* in[24]; float* out;
};
#define IN_X 0
#define IN_C 1
#define IN_POS 2
#define IN_G1 3
#define IN_G2 4
#define IN_WADA 5
#define IN_BADA 6
#define IN_WIN 7
#define IN_GAQ 8
#define IN_GAK 9
#define IN_GIDXK 10
#define IN_GMQA 11
#define IN_WMQUP 12
#define IN_GMKVA 13
#define IN_WMKVUP 14
#define IN_GMQ 15
#define IN_GMK 16
#define IN_WOA 17
#define IN_WOM 18
#define IN_WOUT 19
#define IN_WPQ 20
#define IN_SUBK 21
#define IN_PU 22
#define IN_PV 23

__device__ __forceinline__ void gemv8_block(const float* vec, int vstride, bool silu, const float* W, int N, float* out, const float* bias, int cb, LAS float* red, int wave, int lane, int tid, int kbeg = 0, int nkc = 2, bool accumulate = false) {
    const int j = cb * 64 + lane;
    float acc[8];
#pragma unroll
    for (int b = 0; b < 8; ++b) acc[b] = 0.f;
#pragma unroll 1
    for (int kc = 0; kc < nkc; ++kc) {
        const int k0 = kbeg + wave * (64 * nkc) + kc * 64;
        float cv[8];
#pragma unroll
        for (int b = 0; b < 8; ++b) { float v = vec[(size_t)b * vstride + k0 + lane]; if (silu) v = v * sigmoidf_(v); cv[b] = v; }
#pragma unroll 8
        for (int kk = 0; kk < 64; ++kk) {
            const float w = W[(size_t)(k0 + kk) * N + j];
#pragma unroll
            for (int b = 0; b < 8; ++b) acc[b] += rdlane_f(cv[b], kk) * w;
        }
    }
#pragma unroll
    for (int b = 0; b < 8; ++b) red[(wave * 8 + b) * 64 + lane] = acc[b];
    __syncthreads();
    { const int b = tid >> 6, l = tid & 63; float s = bias ? bias[cb * 64 + l] : 0.f;
#pragma unroll
      for (int w = 0; w < 8; ++w) s += red[(w * 8 + b) * 64 + l];
      if (accumulate) atomicAdd(out + (size_t)b * N + cb * 64 + l, s); else out[(size_t)b * N + cb * 64 + l] = s; }
    __syncthreads();
}

__device__ __forceinline__ int headperm(int d, int wc) { return 128 * (d >> 5) + 32 * wc + (d & 31); }
__device__ __forceinline__ int dest_win(int c) {
    if (c < 2048) { const int seg = c >> 9, hc = c & 511, h = hc >> 6, d = hc & 63; return (2 * seg + (h >> 2)) * 256 + headperm(d, h & 3); }
    if (c < 2112) { const int d = c - 2048; return 8 * 256 + headperm(d, 0); }
    if (c < 2120) return 8 * 256 + 128 + 32 + (c - 2112);
    if (c < 2504) return 9 * 256 + (c - 2120);
    if (c < 2760) return 11 * 256 + (c - 2504);
    if (c < 2792) return 8 * 256 + 32 + (c - 2760);
    if (c < 3816) return 12 * 256 + (c - 2792);
    return 16 * 256 + (c - 3816);
}
__device__ __forceinline__ int dest_qup(int c) {
    const int h = c / 96, dd = c % 96;
    if (dd < 64) return (h >> 2) * 256 + headperm(dd, h & 3);
    return 512 + 128 * (h & 1) + 32 * (h >> 1) + (dd - 64);
}
__device__ __forceinline__ int dest_kvup(int c) {
    const int h = c >> 7, dd = c & 127;
    return ((dd >> 6) * 2 + (h >> 2)) * 256 + headperm(dd & 63, h & 3);
}
template <int MODE>
__device__ __forceinline__ void transpose_item(const float* W, int K, int N, bf16_t* WT, const float* kscale, LAS float* scr, int item, int lane) {
    const int nblk = (N + 31) / 32, kb = item / nblk, nb = item % nblk, k0 = 64 * kb, n0 = 32 * nb;
#pragma unroll 8
    for (int i = 0; i < 32; ++i) {
        const int kk = 2 * i + (lane >> 5), n = n0 + (lane & 31);
        float v = (n < N) ? W[(size_t)(k0 + kk) * N + n] : 0.f;
        if (kscale) v *= kscale[k0 + kk];
        scr[kk * 33 + (lane & 31)] = v;
    }
    LDS_WAIT(); asm volatile("" ::: "memory");
    const int c = lane & 7;
#pragma unroll
    for (int j = 0; j < 4; ++j) {
        const int nn = (lane >> 3) + 8 * j, n = n0 + nn;
        if (n < N) {
            const LAS float* s = scr + (8 * c) * 33 + nn;
            u32x4 o; o.x = cvtpk_s(s[0 * 33], s[1 * 33]); o.y = cvtpk_s(s[2 * 33], s[3 * 33]); o.z = cvtpk_s(s[4 * 33], s[5 * 33]); o.w = cvtpk_s(s[6 * 33], s[7 * 33]);
            const int d = (MODE == 0) ? n : (MODE == 1) ? dest_win(n) : (MODE == 2) ? dest_qup(n) : dest_kvup(n);
            *(u32x4*)(WT + (size_t)d * K + k0 + 8 * c) = o;
        }
    }
    LDS_WAIT(); asm volatile("" ::: "memory");
}
__device__ __forceinline__ void cvt_bf16_stream(const float* src, bf16_t* dst, size_t n, size_t gtid, size_t gthreads) {
    for (size_t i = gtid * 8; i < n; i += gthreads * 8) {
        const f32x4 a = *(const f32x4*)(src + i), b = *(const f32x4*)(src + i + 4);
        u32x4 o; o.x = cvtpk_s(a.x, a.y); o.y = cvtpk_s(a.z, a.w); o.z = cvtpk_s(b.x, b.y); o.w = cvtpk_s(b.z, b.w);
        *(u32x4*)(dst + i) = o;
    }
}
__device__ __forceinline__ void cvt_fp4_rows(const float* src, unsigned char* dst, float* inv, int nrows, int gw, int NGW, int lane) {
    for (int row = gw; row < nrows; row += NGW) {
        const f32x4* p = (const f32x4*)(src + (size_t)row * DM) + 4 * lane;
        f32x4 v[4]; float am = 0.f;
#pragma unroll
        for (int j = 0; j < 4; ++j) { v[j] = p[j]; am = __builtin_fmaxf(am, __builtin_fmaxf(__builtin_fmaxf(fabsf(v[j].x), fabsf(v[j].y)), __builtin_fmaxf(fabsf(v[j].z), fabsf(v[j].w)))); }
#pragma unroll
        for (int o = 1; o < 64; o <<= 1) am = __builtin_fmaxf(am, __shfl_xor(am, o));
        am = __builtin_fmaxf(am, 1e-30f);
        const float sc = 6.f / am;
        if (lane == 0) inv[row] = am * (1.f / 6.f);
        unsigned w0 = 0u, w1 = 0u;
        w0 = __builtin_amdgcn_cvt_scalef32_pk_fp4_f32(w0, v[0].x * sc, v[0].y * sc, 1.0f, 0); w0 = __builtin_amdgcn_cvt_scalef32_pk_fp4_f32(w0, v[0].z * sc, v[0].w * sc, 1.0f, 1);
        w0 = __builtin_amdgcn_cvt_scalef32_pk_fp4_f32(w0, v[1].x * sc, v[1].y * sc, 1.0f, 2); w0 = __builtin_amdgcn_cvt_scalef32_pk_fp4_f32(w0, v[1].z * sc, v[1].w * sc, 1.0f, 3);
        w1 = __builtin_amdgcn_cvt_scalef32_pk_fp4_f32(w1, v[2].x * sc, v[2].y * sc, 1.0f, 0); w1 = __builtin_amdgcn_cvt_scalef32_pk_fp4_f32(w1, v[2].z * sc, v[2].w * sc, 1.0f, 1);
        w1 = __builtin_amdgcn_cvt_scalef32_pk_fp4_f32(w1, v[3].x * sc, v[3].y * sc, 1.0f, 2); w1 = __builtin_amdgcn_cvt_scalef32_pk_fp4_f32(w1, v[3].z * sc, v[3].w * sc, 1.0f, 3);
        *((u32x2*)(dst + (size_t)row * (DM / 2)) + lane) = (u32x2){w0, w1};
    }
}
__device__ __forceinline__ void cvt_i4_rows(const float* src, unsigned char* dst, float* inv, int nrows, int gw, int NGW, int lane) {
    for (int row = gw; row < nrows; row += NGW) {
        const f32x4* p = (const f32x4*)(src + (size_t)row * DM) + 4 * lane;
        f32x4 v[4]; float am = 0.f;
#pragma unroll
        for (int j = 0; j < 4; ++j) { v[j] = p[j]; am = __builtin_fmaxf(am, __builtin_fmaxf(__builtin_fmaxf(fabsf(v[j].x), fabsf(v[j].y)), __builtin_fmaxf(fabsf(v[j].z), fabsf(v[j].w)))); }
#pragma unroll
        for (int o = 1; o < 64; o <<= 1) am = __builtin_fmaxf(am, __shfl_xor(am, o));
        am = __builtin_fmaxf(am, 1e-30f);
        const float sc = 9.5f / am;
        if (lane == 0) inv[row] = am * (1.f / 9.5f);
        unsigned w[2] = {0u, 0u};
#pragma unroll
        for (int j = 0; j < 4; ++j) {
#pragma unroll
            for (int e = 0; e < 4; ++e) { const float x = __builtin_amdgcn_fmed3f(__builtin_rintf(v[j][e] * sc), -7.f, 7.f); w[j >> 1] |= ((unsigned)(int)x & 15u) << (4 * (4 * (j & 1) + e)); }
        }
        *((u32x2*)(dst + (size_t)row * (DM / 2)) + lane) = (u32x2){w[0], w[1]};
    }
}
__device__ __forceinline__ void rope_cs(int pos, int i, int half, float& c, float& s) {
    const float inv = (float)exp(-9.210340371976184 * (double)i / (double)half);
    const float ang = (float)pos * inv;
    double x = (double)ang * 0.15915494309189535;
    x -= rint(x);
    const float xf = (float)x;
    c = __builtin_amdgcn_cosf(xf); s = __builtin_amdgcn_sinf(xf);
}

__device__ __forceinline__ void phase0(Frame& F) {
    const int gw = F.bid * NWAVES + F.wave, NGW = F.G * NWAVES;
    unsigned char* ws = F.ws;
    for (int cb = F.G - 1 - F.bid; cb < 96; cb += F.G) gemv8_block(F.in[IN_C], DM, true, F.in[IN_WADA], 6144, (float*)(ws + WS_MOD), F.in[IN_BADA], cb, (LAS float*)(F.lds + 8 * 16384), F.wave, F.lane, F.tid);
    { const size_t gt = (size_t)F.bid * NTHREADS + F.tid, gn = (size_t)F.G * NTHREADS; u32x4* z = (u32x4*)(ws + WS_SSQ_CQ);
      for (size_t i = gt; i < (WS_MOD - WS_SSQ_CQ) / 16; i += gn) z[i] = (u32x4){0u, 0u, 0u, 0u};
      for (size_t i = gt; i < (size_t)NB * 2048 / 4; i += gn) ((u32x4*)(ws + WS_BIASQ))[i] = (u32x4){0u, 0u, 0u, 0u};
      for (size_t i = gt; i < 3456; i += gn) ((unsigned*)(ws + WS_BAR))[i] = 0u;
    }
}
__device__ __forceinline__ void phase0b(Frame& F) {
    const int gw = F.bid * NWAVES + F.wave, NGW = F.G * NWAVES; (void)gw; (void)NGW;
    unsigned char* ws = F.ws;
    LAS float* scr = (LAS float*)(F.lds + F.wave * 16384);
    constexpr int I_WIN = 16 * 152, I_QUP = 6 * 24, I_KVUP = 4 * 32, I_OA = 8 * 32, I_OUT = 16 * 32, I_PQ = 16 * 64;
    constexpr int NITEMS = I_WIN + I_QUP + I_KVUP + 2 * I_OA + I_OUT + I_PQ;
    const int ntw_ = F.G; const bool tr_wg = true;
    for (int it = F.bid * NWAVES + F.wave; tr_wg && it < NITEMS; it += ntw_ * NWAVES) {
        int r = it;
        if (r < I_WIN) { transpose_item<1>(F.in[IN_WIN], DM, IN_WIDTH, (bf16_t*)(ws + WS_WIN), nullptr, scr, r, F.lane); continue; } r -= I_WIN;
        if (r < I_QUP) { transpose_item<2>(F.in[IN_WMQUP], QRANK, 768, (bf16_t*)(ws + WS_WQUP), F.in[IN_GMQA], scr, r, F.lane); continue; } r -= I_QUP;
        if (r < I_KVUP) { transpose_item<3>(F.in[IN_WMKVUP], KVRANK, 1024, (bf16_t*)(ws + WS_WKVUP), F.in[IN_GMKVA], scr, r, F.lane); continue; } r -= I_KVUP;
        if (r < I_OA) { transpose_item<0>(F.in[IN_WOA], AW, DM, (bf16_t*)(ws + WS_WOA), nullptr, scr, r, F.lane); continue; } r -= I_OA;
        if (r < I_OA) { transpose_item<0>(F.in[IN_WOM], AW, DM, (bf16_t*)(ws + WS_WOM), nullptr, scr, r, F.lane); continue; } r -= I_OA;
        if (r < I_OUT) { transpose_item<0>(F.in[IN_WOUT], DM, DM, (bf16_t*)(ws + WS_WOUT), nullptr, scr, r, F.lane); continue; } r -= I_OUT;
        transpose_item<0>(F.in[IN_WPQ], DM, 2048, (bf16_t*)(ws + WS_WPQ), nullptr, scr, r, F.lane);
    }
    const size_t gtid = (size_t)F.bid * NTHREADS + F.tid, gth = (size_t)F.G * NTHREADS;
    cvt_bf16_stream(F.in[IN_SUBK], (bf16_t*)(ws + WS_SUBK), (size_t)16 * 128 * 128, gtid, gth);
    const int* pos = (const int*)F.in[IN_POS];
    float* r32 = (float*)(ws + WS_ROPE32); float* r16 = (float*)(ws + WS_ROPE16);
    for (size_t e = gtid; e < (size_t)T * 48; e += gth) {
        const int t = (int)(e / 48), i = (int)(e % 48); const int p = pos[t]; float c, s;
        if (i < 32) { rope_cs(p, i, 32, c, s); r32[(size_t)t * 64 + i] = c; r32[(size_t)t * 64 + 32 + i] = s; }
        else { rope_cs(p, i - 32, 16, c, s); r16[(size_t)t * 32 + (i - 32)] = c; r16[(size_t)t * 32 + 16 + (i - 32)] = s; }
    }
}

__device__ __forceinline__ float wave_sum(float v) {
#pragma unroll
    for (int o = 1; o < 64; o <<= 1) v += __shfl_xor(v, o);
    return v;
}
__device__ __forceinline__ void phase1(Frame& F) {
    phase0b(F);
    __syncthreads();
    const int gw = F.bid * NWAVES + F.wave, NGW = F.G * NWAVES;
    const float* mod = (const float*)(F.ws + WS_MOD);
    for (int tk = F.G - 1 - F.bid; tk < 64; tk += F.G) gemv8_block(mod + 3072, 6144, false, F.in[IN_WPQ], 2048, (float*)(F.ws + WS_BIASQ), nullptr, tk & 31, (LAS float*)F.lds, F.wave, F.lane, F.tid, (tk >> 5) * 512, 1, true);
    const float* g1 = F.in[IN_G1];
    bf16_t* XN = (bf16_t*)(F.ws + WS_XN);
    for (int m0 = 2 * gw; m0 < T; m0 += 2 * NGW) {
        f32x4 v[2][4]; float s[2] = {0.f, 0.f};
#pragma unroll
        for (int u = 0; u < 2; ++u) { const f32x4* xr = (const f32x4*)(F.in[IN_X] + (size_t)(m0 + u) * DM) + F.lane;
#pragma unroll
            for (int j = 0; j < 4; ++j) v[u][j] = xr[64 * j]; }
#pragma unroll
        for (int u = 0; u < 2; ++u)
#pragma unroll
            for (int j = 0; j < 4; ++j) s[u] += (v[u][j].x * v[u][j].x + v[u][j].y * v[u][j].y) + (v[u][j].z * v[u][j].z + v[u][j].w * v[u][j].w);
#pragma unroll
        for (int u = 0; u < 2; ++u) {
            const int m = m0 + u, b = m / SEQ;
            const float rinv = __builtin_amdgcn_rsqf(wave_sum(s[u]) * (1.f / DM) + EPS);
            unsigned long long* o8 = (unsigned long long*)(XN + (size_t)m * DM) + F.lane;
#pragma unroll
            for (int j = 0; j < 4; ++j) {
                const int col = 4 * F.lane + 256 * j;
                const f32x4 g = *(const f32x4*)(g1 + col), sh = *(const f32x4*)(mod + (size_t)b * 6144 + col), sc = *(const f32x4*)(mod + (size_t)b * 6144 + 1024 + col);
                const f32x4 h = v[u][j] * rinv * g * (sc + 1.0f) + sh;
                o8[64 * j] = (unsigned long long)cvtpk_s(h.x, h.y) | ((unsigned long long)cvtpk_s(h.z, h.w) << 32);
            }
        }
    }
}

__device__ __forceinline__ u32x2 pk4(const f32x4 v) { u32x2 o; o.x = cvtpk_s(v.x, v.y); o.y = cvtpk_s(v.z, v.w); return o; }
__device__ __forceinline__ void st8(bf16_t* grp, const u32x2 X, const u32x2 Y, int fq) {
    auto r0 = __builtin_amdgcn_permlane16_swap(X.x, Y.x, false, false); auto r1 = __builtin_amdgcn_permlane16_swap(X.y, Y.y, false, false);
    *(u32x4*)(grp + 8 * (fq >> 1) + 16 * (fq & 1)) = (u32x4){r0[0], r1[0], r0[1], r1[1]};
}
__device__ __forceinline__ void ld8(const bf16_t* grp, u32x2& X, u32x2& Y, int fq) {
    const u32x4 w = *(const u32x4*)(grp + 8 * (fq >> 1) + 16 * (fq & 1));
    auto r0 = __builtin_amdgcn_permlane16_swap(w[0], w[2], false, false); auto r1 = __builtin_amdgcn_permlane16_swap(w[1], w[3], false, false);
    X = (u32x2){r0[0], r1[0]}; Y = (u32x2){r0[1], r1[1]};
}
__device__ __forceinline__ float sum4sq(const f32x4 v) { return (v.x * v.x + v.y * v.y) + (v.z * v.z + v.w * v.w); }
__device__ __forceinline__ float fq_sum(float s) {
    { auto r = __builtin_amdgcn_permlane16_swap(__float_as_uint(s), __float_as_uint(s), false, false); s = __uint_as_float(r[0]) + __uint_as_float(r[1]); }
    { auto r = __builtin_amdgcn_permlane32_swap(__float_as_uint(s), __float_as_uint(s), false, false); s = __uint_as_float(r[0]) + __uint_as_float(r[1]); }
    return s;
}

struct EpiIn {
    unsigned char* ws; const float* gaq; const float* gak; const float* gidxk; const float* gmk;
    template <bool NORM>
    __device__ __forceinline__ void normrope64(const f32x4 (&acc)[2][2][4][2], int row0, int fq, const float* gain, float scale, bf16_t* dst, int pitch, int colbase) const {
        const float* rope = (const float*)(ws + WS_ROPE32);
        f32x4 gv[2][2];
#pragma unroll
        for (int bj = 0; bj < 2; ++bj)
#pragma unroll
            for (int n = 0; n < 2; ++n) gv[bj][n] = NORM ? *(const f32x4*)(gain + 32 * bj + 16 * n + 4 * fq) * scale : (f32x4){scale, scale, scale, scale};
#pragma unroll
        for (int ai = 0; ai < 2; ++ai)
#pragma unroll
            for (int m = 0; m < 4; ++m) {
                const int row = row0 + 128 * ai + 16 * m;
                float rinv = 1.f;
                if (NORM) {
                    float s = 0.f;
#pragma unroll
                    for (int bj = 0; bj < 2; ++bj)
#pragma unroll
                        for (int n = 0; n < 2; ++n) s += sum4sq(acc[ai][bj][m][n]);
                    rinv = __builtin_amdgcn_rsqf(fq_sum(s) * (1.f / 64.f) + EPS);
                }
                bf16_t* o = dst + (size_t)row * pitch + colbase; u32x2 lo[2], hi[2];
#pragma unroll
                for (int n = 0; n < 2; ++n) {
                    const f32x4 cs = *(const f32x4*)(rope + (size_t)row * 64 + 16 * n + 4 * fq), sn = *(const f32x4*)(rope + (size_t)row * 64 + 32 + 16 * n + 4 * fq);
                    const f32x4 x1 = acc[ai][0][m][n] * rinv * gv[0][n], x2 = acc[ai][1][m][n] * rinv * gv[1][n];
                    lo[n] = pk4(x1 * cs - x2 * sn); hi[n] = pk4(x2 * cs + x1 * sn);
                }
                st8(o, lo[0], lo[1], fq); st8(o + 32, hi[0], hi[1], fq);
                asm volatile("" ::: "memory");
            }
    }
    __device__ __forceinline__ void operator()(const f32x4 (&acc)[2][2][4][2], const pg8::Unit& u, int wr, int wc, int fr, int fq) const {
        const int pn = u.pn, row0 = u.pm * 256 + wr * 64 + fr;
        if (pn < 2) { normrope64<true>(acc, row0, fq, gaq, C2A, (bf16_t*)(ws + WS_QA), AW, ((pn & 1) * 4 + wc) * 64); return; }
        if (pn < 4) { normrope64<true>(acc, row0, fq, gak, 1.f, (bf16_t*)(ws + WS_KA), AW, ((pn & 1) * 4 + wc) * 64); return; }
        if (pn < 6) {
            bf16_t* dst = (bf16_t*)(ws + WS_VA);
#pragma unroll
            for (int ai = 0; ai < 2; ++ai)
#pragma unroll
                for (int m = 0; m < 4; ++m) { bf16_t* o = dst + (size_t)(row0 + 128 * ai + 16 * m) * AW + ((pn & 1) * 4 + wc) * 64;
#pragma unroll
                    for (int bj = 0; bj < 2; ++bj) st8(o + 32 * bj, pk4(acc[ai][bj][m][0]), pk4(acc[ai][bj][m][1]), fq); asm volatile("" ::: "memory"); }
            return;
        }
        if (pn < 8) { normrope64<false>(acc, row0, fq, nullptr, 1.f, (bf16_t*)(ws + WS_QI), AW, ((pn & 1) * 4 + wc) * 64); return; }
        if (pn == 8) {
            if (wc == 0) { normrope64<true>(acc, row0, fq, gidxk, 1.f, (bf16_t*)(ws + WS_KI), 64, 0); return; }
            if (wc == 1) {
                const float* rope = (const float*)(ws + WS_ROPE16);
                float* kper = (float*)(ws + WS_KPER); float* kss = (float*)(ws + WS_KPESSQ); float* wi = (float*)(ws + WS_WI);
                const f32x4 g1 = *(const f32x4*)(gmk + 64 + 4 * fq), g2 = *(const f32x4*)(gmk + 80 + 4 * fq);
#pragma unroll
                for (int ai = 0; ai < 2; ++ai)
#pragma unroll
                    for (int m = 0; m < 4; ++m) {
                        const int row = row0 + 128 * ai + 16 * m;
                        const f32x4 a = acc[ai][0][m][0], b = acc[ai][0][m][1];
                        const float s = fq_sum(sum4sq(a) + sum4sq(b));
                        if (fq == 0) kss[row] = s;
                        const f32x4 cs = *(const f32x4*)(rope + (size_t)row * 32 + 4 * fq), sn = *(const f32x4*)(rope + (size_t)row * 32 + 16 + 4 * fq);
                        const f32x4 x1 = a * g1, x2 = b * g2;
                        *(f32x4*)(kper + (size_t)row * 32 + 4 * fq) = x1 * cs - x2 * sn;
                        *(f32x4*)(kper + (size_t)row * 32 + 16 + 4 * fq) = x2 * cs + x1 * sn;
                        if (fq < 2) *(f32x4*)(wi + (size_t)row * 8 + 4 * fq) = acc[ai][1][m][0] * 0.044194173824159216f;
                        asm volatile("" ::: "memory");
                    }
            }
            return;
        }
        if (pn < 12) {
            const bool isq = pn < 11; const int cb = isq ? (pn - 9) * 256 : 0, width = isq ? QRANK : KVRANK;
            bf16_t* dst = (bf16_t*)(ws + (isq ? WS_CQ : WS_CKV)); float* ssq = (float*)(ws + (isq ? WS_SSQ_CQ : WS_SSQ_CKV));
#pragma unroll
            for (int ai = 0; ai < 2; ++ai)
#pragma unroll
                for (int m = 0; m < 4; ++m) {
                    const int row = row0 + 128 * ai + 16 * m; float s = 0.f;
#pragma unroll
                    for (int bj = 0; bj < 2; ++bj) { const int col = cb + 128 * bj + 32 * wc;
                        if (col < width) { st8(dst + (size_t)row * width + col, pk4(acc[ai][bj][m][0]), pk4(acc[ai][bj][m][1]), fq); s += sum4sq(acc[ai][bj][m][0]) + sum4sq(acc[ai][bj][m][1]); } }
                    s = fq_sum(s);
                    if (fq == 0) atomicAdd(ssq + row, s);
                    asm volatile("" ::: "memory");
                }
            return;
        }
        {
            bf16_t* dst = (bf16_t*)(ws + (pn < 16 ? WS_GA : WS_GM)); const int cb = ((pn - 12) & 3) * 256 + 32 * wc;
#pragma unroll
            for (int ai = 0; ai < 2; ++ai)
#pragma unroll
                for (int m = 0; m < 4; ++m) { bf16_t* o = dst + (size_t)(row0 + 128 * ai + 16 * m) * DM + cb;
#pragma unroll
                    for (int bj = 0; bj < 2; ++bj) { const f32x4 v = acc[ai][bj][m][0], w = acc[ai][bj][m][1];
                        st8(o + 128 * bj, pk4((f32x4){sigmoidf_(v.x), sigmoidf_(v.y), sigmoidf_(v.z), sigmoidf_(v.w)}), pk4((f32x4){sigmoidf_(w.x), sigmoidf_(w.y), sigmoidf_(w.z), sigmoidf_(w.w)}), fq); } asm volatile("" ::: "memory"); }
        }
    }
};

struct EpiQup {
    unsigned char* ws; const float* gmq;
    __device__ __forceinline__ void operator()(const f32x4 (&acc)[2][2][4][2], const pg8::Unit& u, int wr, int wc, int fr, int fq) const {
        const int pn = u.pn, row0 = u.pm * 256 + wr * 64 + fr;
        const float* ssqc = (const float*)(ws + WS_SSQ_CQ); float* ssqm = (float*)(ws + WS_SSQ_QM);
        if (pn < 2) {
            const int head = pn * 4 + wc; bf16_t* dst = (bf16_t*)(ws + WS_QMN);
            f32x4 gv[2][2];
#pragma unroll
            for (int bj = 0; bj < 2; ++bj)
#pragma unroll
                for (int n = 0; n < 2; ++n) gv[bj][n] = *(const f32x4*)(gmq + 32 * bj + 16 * n + 4 * fq) * C2B;
#pragma unroll
            for (int ai = 0; ai < 2; ++ai)
#pragma unroll
                for (int m = 0; m < 4; ++m) {
                    const int row = row0 + 128 * ai + 16 * m;
                    const float rc = __builtin_amdgcn_rsqf(ssqc[row] * (1.f / QRANK) + EPS);
                    float s = 0.f; bf16_t* o = dst + (size_t)row * 512 + head * 64;
#pragma unroll
                    for (int bj = 0; bj < 2; ++bj) { const f32x4 q0 = acc[ai][bj][m][0] * rc, q1 = acc[ai][bj][m][1] * rc; s += sum4sq(q0) + sum4sq(q1); st8(o + 32 * bj, pk4(q0 * gv[bj][0]), pk4(q1 * gv[bj][1]), fq); }
                    s = fq_sum(s);
                    if (fq == 0) atomicAdd(ssqm + (size_t)row * 8 + head, s);
                    asm volatile("" ::: "memory");
                }
            return;
        }
        {
            const float* rope = (const float*)(ws + WS_ROPE16); bf16_t* dst = (bf16_t*)(ws + WS_QMR);
            const f32x4 g1 = *(const f32x4*)(gmq + 64 + 4 * fq) * C2B, g2 = *(const f32x4*)(gmq + 80 + 4 * fq) * C2B;
#pragma unroll
            for (int ai = 0; ai < 2; ++ai)
#pragma unroll
                for (int m = 0; m < 4; ++m) {
                    const int row = row0 + 128 * ai + 16 * m;
                    const float rc = __builtin_amdgcn_rsqf(ssqc[row] * (1.f / QRANK) + EPS);
                    const f32x4 cs = *(const f32x4*)(rope + (size_t)row * 32 + 4 * fq), sn = *(const f32x4*)(rope + (size_t)row * 32 + 16 + 4 * fq);
#pragma unroll
                    for (int bj = 0; bj < 2; ++bj) {
                        const int head = 2 * wc + bj;
                        const f32x4 a = acc[ai][bj][m][0] * rc, b = acc[ai][bj][m][1] * rc;
                        const float s = fq_sum(sum4sq(a) + sum4sq(b));
                        if (fq == 0) atomicAdd(ssqm + (size_t)row * 8 + head, s);
                        const f32x4 x1 = a * g1, x2 = b * g2;
                        st8(dst + (size_t)row * 256 + head * 32, pk4(x1 * cs - x2 * sn), pk4(x2 * cs + x1 * sn), fq);
                    }
                    asm volatile("" ::: "memory");
                }
        }
    }
};
struct EpiKVup {
    unsigned char* ws; const float* gmk;
    __device__ __forceinline__ void operator()(const f32x4 (&acc)[2][2][4][2], const pg8::Unit& u, int wr, int wc, int fr, int fq) const {
        const int pn = u.pn, row0 = u.pm * 256 + wr * 64 + fr, head = (pn & 1) * 4 + wc;
        const float* ssqc = (const float*)(ws + WS_SSQ_CKV);
        if (pn < 2) {
            const float* kss = (const float*)(ws + WS_KPESSQ); const float* kper = (const float*)(ws + WS_KPER);
            bf16_t* dn = (bf16_t*)(ws + WS_KMN); bf16_t* dr = (bf16_t*)(ws + WS_KMR);
            f32x4 gv[2][2];
#pragma unroll
            for (int bj = 0; bj < 2; ++bj)
#pragma unroll
                for (int n = 0; n < 2; ++n) gv[bj][n] = *(const f32x4*)(gmk + 32 * bj + 16 * n + 4 * fq);
#pragma unroll
            for (int ai = 0; ai < 2; ++ai)
#pragma unroll
                for (int m = 0; m < 4; ++m) {
                    const int row = row0 + 128 * ai + 16 * m;
                    const float rc = __builtin_amdgcn_rsqf(ssqc[row] * (1.f / KVRANK) + EPS);
                    float s = 0.f; f32x4 kn[2][2];
#pragma unroll
                    for (int bj = 0; bj < 2; ++bj)
#pragma unroll
                        for (int n = 0; n < 2; ++n) { kn[bj][n] = acc[ai][bj][m][n] * rc; s += sum4sq(kn[bj][n]); }
                    s = fq_sum(s) + kss[row];
                    const float rinv = __builtin_amdgcn_rsqf(s * (1.f / MQK) + EPS);
                    bf16_t* o = dn + (size_t)row * 512 + head * 64;
#pragma unroll
                    for (int bj = 0; bj < 2; ++bj) st8(o + 32 * bj, pk4(kn[bj][0] * gv[bj][0] * rinv), pk4(kn[bj][1] * gv[bj][1] * rinv), fq);
                    const f32x4 ra = *(const f32x4*)(kper + (size_t)row * 32 + 8 * fq) * rinv, rb = *(const f32x4*)(kper + (size_t)row * 32 + 8 * fq + 4) * rinv;
                    u32x4 w; w.x = cvtpk_s(ra.x, ra.y); w.y = cvtpk_s(ra.z, ra.w); w.z = cvtpk_s(rb.x, rb.y); w.w = cvtpk_s(rb.z, rb.w);
                    *(u32x4*)(dr + (size_t)row * 256 + head * 32 + 8 * fq) = w;
                    asm volatile("" ::: "memory");
                }
            return;
        }
        {
            bf16_t* dst = (bf16_t*)(ws + WS_VM);
#pragma unroll
            for (int ai = 0; ai < 2; ++ai)
#pragma unroll
                for (int m = 0; m < 4; ++m) {
                    const int row = row0 + 128 * ai + 16 * m;
                    const float rc = __builtin_amdgcn_rsqf(ssqc[row] * (1.f / KVRANK) + EPS);
                    bf16_t* o = dst + (size_t)row * 512 + head * 64;
#pragma unroll
                    for (int bj = 0; bj < 2; ++bj) st8(o + 32 * bj, pk4(acc[ai][bj][m][0] * rc), pk4(acc[ai][bj][m][1] * rc), fq);
                    asm volatile("" ::: "memory");
                }
        }
    }
};

constexpr int SC_PITCH = 4104, IDX_SC_BYTES = 16 * SC_PITCH * 2, IDX_MW_OFF = IDX_SC_BYTES;
static_assert(IDX_MW_OFF % 16 == 0 && IDX_MW_OFF + 16 * 64 * 8 <= LDS_BYTES, "indexer LDS");
__device__ __forceinline__ int suffix_sum64(int v, int lane) {
#pragma unroll
    for (int o = 1; o < 64; o <<= 1) { const int t = __shfl_down(v, o); v += (lane + o < 64) ? t : 0; }
    return v;
}
__device__ __forceinline__ void radix_level(LAS unsigned* hist, int lane, int want, int& bsel, int& cabove) {
    u32x4 c = *(const LAS u32x4*)(hist + 4 * lane);
#pragma unroll
    for (int k = 1; k < 4; ++k) c += *(const LAS u32x4*)(hist + 256 * k + 4 * lane);
#pragma unroll
    for (int k = 0; k < 4; ++k) *(LAS u32x4*)(hist + 256 * k + 4 * lane) = (u32x4){0u, 0u, 0u, 0u};
    const int s = (int)(c.x + c.y + c.z + c.w), S = suffix_sum64(s, lane);
    int above = S - s, b = -1, ca = 0;
    if (above < want && S >= want) {
        if (above + (int)c.w >= want) { b = 4 * lane + 3; ca = above; }
        else if (above + (int)(c.w + c.z) >= want) { b = 4 * lane + 2; ca = above + (int)c.w; }
        else if (above + (int)(c.w + c.z + c.y) >= want) { b = 4 * lane + 1; ca = above + (int)(c.w + c.z); }
        else { b = 4 * lane; ca = above + (int)(c.w + c.z + c.y); }
    }
    const unsigned long long m = __builtin_amdgcn_ballot_w64(b >= 0);
    const int src = (int)__builtin_ctzll(m | (1ull << 63));
    bsel = __builtin_amdgcn_readlane(b, src); cabove = __builtin_amdgcn_readlane(ca, src);
}
__device__ __forceinline__ void indexer_phase(Frame& F) {
    const bf16_t* QI = (const bf16_t*)(F.ws + WS_QI); const bf16_t* KI = (const bf16_t*)(F.ws + WS_KI); const float* WI = (const float*)(F.ws + WS_WI);
    unsigned long long* MASK = (unsigned long long*)(F.ws + WS_MASK);
    LAS unsigned short* SC = (LAS unsigned short*)F.lds;
    LAS unsigned long long* MW = (LAS unsigned long long*)(F.lds + IDX_MW_OFF);
    const int lane = F.lane, wid = F.wave;
    for (int item = F.bid; item < NB * 256; item += F.G) {
        int lq = lane; asm volatile("" : "+v"(lq)); const int q = lq & 15, kq = lq >> 4;
        const int b = item >> 8, gi = item & 255, g = (b & 1) ? 255 - gi : gi, t0 = 16 * g, nkt = g + 1;
        const size_t rowq = (size_t)b * SEQ + t0 + q;
        bf16x8 bq[8][2]; float wv[8];
#pragma unroll
        for (int h = 0; h < 8; ++h) {
#pragma unroll
            for (int ks = 0; ks < 2; ++ks) bq[h][ks] = *(const bf16x8*)(QI + rowq * 512 + h * 64 + 32 * ks + 8 * kq);
            wv[h] = WI[rowq * 8 + h];
        }
        const bf16_t* kbase = KI + ((size_t)b * SEQ + q) * 64 + 8 * kq;
        const int ntw = (nkt - wid + NWAVES - 1) / NWAVES;
        bf16x8 ka[4][2], kn[4][2];
#define IDX_KLOAD(u, jj) do { int kt_ = wid + NWAVES * (jj); kt_ = kt_ < nkt ? kt_ : nkt - 1; const bf16_t* kp = kbase + (size_t)16 * kt_ * 64; kn[u][0] = *(const bf16x8*)kp; kn[u][1] = *(const bf16x8*)(kp + 32); } while (0)
#define IDX_TILE(u, jj) do { const int kt = wid + NWAVES * (jj); \
                f32x4 sc = (f32x4){0.f, 0.f, 0.f, 0.f}; \
                _Pragma("unroll") for (int h = 0; h < 8; ++h) { \
                    f32x4 c = __builtin_amdgcn_mfma_f32_16x16x32_bf16(ka[u][0], bq[h][0], (f32x4){0.f, 0.f, 0.f, 0.f}, 0, 0, 0); \
                    c = __builtin_amdgcn_mfma_f32_16x16x32_bf16(ka[u][1], bq[h][1], c, 0, 0, 0); \
                    _Pragma("unroll") for (int i = 0; i < 4; ++i) sc[i] += __builtin_amdgcn_fmed3f(c[i], 0.f, 3.0e38f) * wv[h]; } \
                unsigned short kk[4]; \
                _Pragma("unroll") for (int i = 0; i < 4; ++i) { const _Float16 hsc = (_Float16)(sc[i] + 0.0f); const unsigned short bits = __builtin_bit_cast(unsigned short, hsc); \
                    kk[i] = (bits & 0x8000u) ? (unsigned short)~bits : (unsigned short)(bits | 0x8000u); } \
                u32x2 w; w.x = (unsigned)kk[0] | ((unsigned)kk[1] << 16); w.y = (unsigned)kk[2] | ((unsigned)kk[3] << 16); \
                *(LAS u32x2*)(SC + q * SC_PITCH + 16 * kt + 4 * kq) = w; } while (0)
#pragma unroll
        for (int u = 0; u < 4; ++u) IDX_KLOAD(u, u);
        for (int j0 = 0; j0 < ntw; j0 += 4) {
#pragma unroll
            for (int u = 0; u < 4; ++u) { ka[u][0] = kn[u][0]; ka[u][1] = kn[u][1]; }
#pragma unroll
            for (int u = 0; u < 4; ++u) IDX_KLOAD(u, j0 + 4 + u);
            if (j0 + 4 <= ntw) { IDX_TILE(0, j0); IDX_TILE(1, j0 + 1); IDX_TILE(2, j0 + 2); IDX_TILE(3, j0 + 3); }
            else { IDX_TILE(0, j0); if (j0 + 1 < ntw) IDX_TILE(1, j0 + 1); if (j0 + 2 < ntw) IDX_TILE(2, j0 + 2); }
        }
#undef IDX_KLOAD
#undef IDX_TILE
        __syncthreads();
#pragma unroll 1
        for (int qi = 0; qi < 2; ++qi) {
            const int qq = 2 * wid + qi, t = t0 + qq, nr = (t >> 6) + 1;
            unsigned key[64];
#pragma unroll
            for (int r = 0; r < 64; ++r) { const int s = 64 * r + lane; key[r] = (r < nr && s <= t) ? (unsigned)SC[qq * SC_PITCH + s] : 0u; }
            unsigned thr = 0u; int need = 0;
            LAS unsigned* hist = (LAS unsigned*)(SC + qq * SC_PITCH);
            if (t + 1 > NSEL) {
                LDS_WAIT();
#pragma unroll
                for (int k = 0; k < 4; ++k) *(LAS u32x4*)(hist + 256 * k + 4 * lane) = (u32x4){0u, 0u, 0u, 0u};
                LAS unsigned* hmine = hist + 256 * (lane & 3);
#pragma unroll
                for (int r8 = 0; r8 < 8; ++r8) if (8 * r8 < nr) {
#pragma unroll
                    for (int r = 8 * r8; r < 8 * r8 + 8; ++r) if (key[r] != 0u) __hip_atomic_fetch_add(hmine + (key[r] >> 8), 1u, __ATOMIC_RELAXED, __HIP_MEMORY_SCOPE_WORKGROUP);
                }
                LDS_WAIT();
                int bh, ca_h; radix_level(hist, lane, NSEL, bh, ca_h);
                LDS_WAIT();
#pragma unroll
                for (int r8 = 0; r8 < 8; ++r8) if (8 * r8 < nr) {
#pragma unroll
                    for (int r = 8 * r8; r < 8 * r8 + 8; ++r) if ((int)(key[r] >> 8) == bh) __hip_atomic_fetch_add(hmine + (key[r] & 255u), 1u, __ATOMIC_RELAXED, __HIP_MEMORY_SCOPE_WORKGROUP);
                }
                LDS_WAIT();
                int bl, ca_l; radix_level(hist, lane, NSEL - ca_h, bl, ca_l);
                LDS_WAIT();
                thr = ((unsigned)bh << 8) | (unsigned)bl; need = NSEL - ca_h - ca_l;
            }
            unsigned wlo = 0u, whi = 0u;
#pragma unroll
            for (int r = 0; r < 64; ++r) {
                unsigned long long word = 0ull;
                if (r < nr) {
                    if (t + 1 > NSEL) {
                        const unsigned long long mg = __builtin_amdgcn_ballot_w64(key[r] > thr);
                        unsigned long long me = __builtin_amdgcn_ballot_w64(key[r] == thr);
                        if (me) { const int c = __builtin_popcountll(me);
                            if (c > need) { int drop = c - need; while (drop > 0) { me &= ~(1ull << (63 - __builtin_clzll(me))); --drop; } need = 0; } else need -= c; }
                        word = mg | me;
                    } else word = __builtin_amdgcn_ballot_w64(key[r] != 0u);
                }
                { const unsigned w0_ = (unsigned)word, w1_ = (unsigned)(word >> 32); asm volatile("s_nop 0\n\tv_writelane_b32 %0, %2, %4\n\tv_writelane_b32 %1, %3, %4" : "+v"(wlo), "+v"(whi) : "s"(w0_), "s"(w1_), "n"(r)); }
            }
            MW[qq * 64 + lane] = ((unsigned long long)whi << 32) | wlo;
        }
        __syncthreads();
        for (int i = F.tid; i < 1024; i += NTHREADS) { const int w = i >> 4, qq = i & 15; MASK[((size_t)b * 64 + w) * SEQ + t0 + qq] = MW[qq * 64 + w]; }
        __syncthreads();
    }
}

namespace att {
constexpr int KV = 64, QB = 256;
constexpr int KSLOT = 12288, VSLOT = 8192;
constexpr int NSLOT = 4;
constexpr int L_K = 0, L_V = NSLOT * KSLOT, L_WS = L_V + NSLOT * VSLOT, L_OST = L_WS + NWAVES * 64 * 4, L_BYTES = L_OST + NWAVES * 4096;
static_assert(L_BYTES <= LDS_BYTES, "attention LDS");
__device__ __forceinline__ int crow(int r, int hi) { return (r & 3) + 8 * (r >> 2) + 4 * hi; }
__device__ __forceinline__ float max3f(float a, float b, float c) { float r; asm("v_max3_f32 %0, %1, %2, %3" : "=v"(r) : "v"(a), "v"(b), "v"(c)); return r; }
__device__ __forceinline__ void glds(const void* g, LAS unsigned char* l) { __builtin_amdgcn_global_load_lds((const unsigned*)g, (LAS unsigned*)l, 16, 0, 0); }

template <int MODE>
__device__ __forceinline__ void attn_unit(Frame& F, int b, int h, int qb) {
    constexpr int NCH = MODE ? 12 : 8, ND = NCH / 2;
    const int lane = F.lane, wid = F.wave, r32 = lane & 31, hi = lane >> 5;
    unsigned char* ws = F.ws; LAS unsigned char* lds = F.lds;
    const size_t rowbase = (size_t)b * SEQ; const int q0 = qb * QB;
    const bf16_t* Kn = (const bf16_t*)(ws + (MODE ? WS_KMN : WS_KA)) + rowbase * 512 + h * 64;
    const bf16_t* Kr = (const bf16_t*)(ws + WS_KMR) + rowbase * 256 + h * 32;
    const bf16_t* Vh = (const bf16_t*)(ws + (MODE ? WS_VM : WS_VA)) + rowbase * 512 + h * 64;
    bf16_t* Qn = (bf16_t*)(ws + (MODE ? WS_QMN : WS_QA)) + (rowbase + q0 + wid * 32) * 512 + h * 64;
    const bf16_t* Qr = (const bf16_t*)(ws + WS_QMR) + (rowbase + q0 + wid * 32) * 256 + h * 32;
    LAS float* wsf = (LAS float*)(lds + L_WS) + wid * 64;
    const int NT = (q0 + QB) / KV;
    const bf16_t* ksrc0 = Kn + (size_t)lane * 512 + wid * 8;
    const bf16_t* ksrc1 = Kr + (size_t)lane * 256 + (wid & 3) * 8;
    const bf16_t* vsrc = Vh + (size_t)(16 * (wid & 3) + (lane >> 2)) * 512 + (wid >> 2) * 32 + (lane & 3) * 8;
#define ATT_DMA(t, slot) do { glds(ksrc0 + (size_t)(t) * KV * 512, lds + L_K + (slot) * KSLOT + wid * 1024); \
        if (MODE) glds(ksrc1 + (size_t)(t) * KV * 256, lds + L_K + (slot) * KSLOT + (8 + (wid & 3)) * 1024); \
        glds(vsrc + (size_t)(t) * KV * 512, lds + L_V + (slot) * VSLOT + wid * 1024); } while (0)
    ATT_DMA(0, 0); ATT_DMA(1, 1); ATT_DMA(2, 2);
    bf16x8 qr[ND];
#pragma unroll
    for (int d0 = 0; d0 < 4; ++d0) qr[d0] = *(const bf16x8*)(Qn + (size_t)r32 * 512 + d0 * 16 + hi * 8);
    if (MODE) {
#pragma unroll
        for (int d0 = 4; d0 < ND; ++d0) qr[d0] = *(const bf16x8*)(Qr + (size_t)r32 * 256 + (d0 - 4) * 16 + hi * 8);
        const float rq = __builtin_amdgcn_rsqf(((const float*)(ws + WS_SSQ_QM))[(rowbase + q0 + wid * 32 + r32) * 8 + h] * (1.f / MQK) + EPS);
#pragma unroll
        for (int d0 = 0; d0 < ND; ++d0) {
            u32x4 w = __builtin_bit_cast(u32x4, qr[d0]);
#pragma unroll
            for (int j = 0; j < 4; ++j) w[j] = cvtpk_s(bflo(w[j]) * rq, bfhi(w[j]) * rq);
            qr[d0] = __builtin_bit_cast(bf16x8, w);
        }
    }
    const unsigned long long* mrow = (const unsigned long long*)(ws + WS_MASK) + (size_t)b * 64 * SEQ + q0 + wid * 32 + r32;
    float mref = 0.f; f32x16 o[2]; o[0] = f32x16{}; o[1] = f32x16{};
    float lrun = 0.f;
    f32x16 negm = f32x16{};
    const int qrel = wid * 32 + r32;
    const unsigned vb0 = (unsigned)(uintptr_t)(lds + L_V) + ((lane >> 4) & 1) * 32 + (lane & 3) * 8 + (4 * hi + ((lane & 15) >> 2)) * 64;
    unsigned long long mw = 0ull, mwn = 0ull;
    if (MODE == 0) mwn = mrow[0];
#define ATT_QK(P0, P1, SL) do { const LAS unsigned char* kb = lds + L_K + (SL) * KSLOT + hi * 1024 + r32 * 16; \
        _Pragma("unroll") for (int d0 = 0; d0 < ND; ++d0) { \
            const bf16x8 k0 = *(const LAS bf16x8*)(kb + d0 * 2048), k1 = *(const LAS bf16x8*)(kb + d0 * 2048 + 512); \
            if (d0 == 0) { P0 = __builtin_amdgcn_mfma_f32_32x32x16_bf16(k0, qr[0], negm, 0, 0, 0); P1 = __builtin_amdgcn_mfma_f32_32x32x16_bf16(k1, qr[0], negm, 0, 0, 0); } \
            else { P0 = __builtin_amdgcn_mfma_f32_32x32x16_bf16(k0, qr[d0], P0, 0, 0, 0); P1 = __builtin_amdgcn_mfma_f32_32x32x16_bf16(k1, qr[d0], P1, 0, 0, 0); } } } while (0)
    if (MODE) asm volatile("s_waitcnt vmcnt(3)" ::: "memory"); else asm volatile("s_waitcnt vmcnt(2)" ::: "memory");
    __builtin_amdgcn_s_barrier(); asm volatile("" ::: "memory");
    f32x16 pn0, pn1;
    ATT_QK(pn0, pn1, 0);
    int slot = 0, slot1 = 1, slot3 = 3;
    for (int t = 0; t < NT; ++t) {
        if (t + 2 < NT) { if (MODE) asm volatile("s_waitcnt vmcnt(3)" ::: "memory"); else asm volatile("s_waitcnt vmcnt(2)" ::: "memory"); }
        else asm volatile("s_waitcnt vmcnt(0)" ::: "memory");
        __builtin_amdgcn_s_barrier(); asm volatile("" ::: "memory");
        mw = mwn;
        if (MODE == 0 && t + 1 < NT) mwn = mrow[(size_t)(t + 1) * SEQ];
        if (t + 3 < NT) ATT_DMA(t + 3, slot3);
        f32x16 p0 = pn0, p1 = pn1;
        if (MODE == 1) {
            const int jb = t - (NT - 4);
            if (jb >= 0) { const int kb = 64 * jb + 4 * hi;
#pragma unroll
                for (int r = 0; r < 16; ++r) { const int kv = kb + (r & 3) + 8 * (r >> 2); if (kv > qrel) p0[r] = -INFINITY; if (kv + 32 > qrel) p1[r] = -INFINITY; } }
        }
        asm volatile("s_nop 15\n\ts_nop 7" : "+v"(p0), "+v"(p1));
        float rm = max3f(p0[0], p1[0], p0[1]), rm2 = max3f(p1[1], p0[2], p1[2]);
#pragma unroll
        for (int r = 3; r < 15; r += 2) { rm = max3f(rm, p0[r], p1[r]); rm2 = max3f(rm2, p0[r + 1], p1[r + 1]); }
        rm = max3f(rm, rm2, p0[15]); rm = __builtin_fmaxf(rm, p1[15]);
        { auto rr = __builtin_amdgcn_permlane32_swap(__float_as_uint(rm), __float_as_uint(rm), false, false); rm = __builtin_fmaxf(__uint_as_float(rr[0]), __uint_as_float(rr[1])); }
        if (__any(rm > 0.f) || t == 0) {
            const float dl = (t == 0) ? rm : __builtin_fmaxf(rm, 0.f);
            mref += dl;
#pragma unroll
            for (int r = 0; r < 16; ++r) { p0[r] -= dl; p1[r] -= dl; }
#pragma unroll
            for (int r = 0; r < 16; ++r) negm[r] = -mref;
            const float f = __builtin_amdgcn_exp2f(-dl);
            if (hi == 0) wsf[r32] = f;
            LDS_WAIT();
#pragma unroll
            for (int r = 0; r < 16; ++r) { const float fr = wsf[crow(r, hi)]; o[0][r] *= fr; o[1][r] *= fr; }
            lrun *= f;
        }
        ATT_QK(pn0, pn1, slot1);
#pragma unroll
        for (int r = 0; r < 16; ++r) { p0[r] = __builtin_amdgcn_exp2f(p0[r]); p1[r] = __builtin_amdgcn_exp2f(p1[r]); }
        if (MODE == 0) {
            const unsigned lo = (unsigned)mw >> (4 * hi), hw = (unsigned)(mw >> 32) >> (4 * hi);
#pragma unroll
            for (int r = 0; r < 16; ++r) { const int c = (r & 3) + 8 * (r >> 2);
                p0[r] = __uint_as_float(__float_as_uint(p0[r]) & (unsigned)__builtin_amdgcn_sbfe(lo, c, 1));
                p1[r] = __uint_as_float(__float_as_uint(p1[r]) & (unsigned)__builtin_amdgcn_sbfe(hw, c, 1)); }
        }
        { float sacc = 0.f;
#pragma unroll
          for (int r = 0; r < 16; ++r) sacc += p0[r] + p1[r];
          lrun += sacc; }
        u32x4 pw0, pw1, pw2, pw3;
#pragma unroll
        for (int j = 0; j < 4; ++j) { pw0[j] = cvtpk_s(p0[2 * j], p0[2 * j + 1]); pw1[j] = cvtpk_s(p0[8 + 2 * j], p0[9 + 2 * j]); pw2[j] = cvtpk_s(p1[2 * j], p1[2 * j + 1]); pw3[j] = cvtpk_s(p1[8 + 2 * j], p1[9 + 2 * j]); }
        { const unsigned vb = vb0 + slot * VSLOT;
#pragma unroll
          for (int d0 = 0; d0 < 2; ++d0) { s16x4 lo[4], hh[4];
#pragma unroll
              for (int ks = 0; ks < 4; ++ks) {
                  asm volatile("ds_read_b64_tr_b16 %0,%1 offset:%c2" : "=&v"(lo[ks]) : "v"(vb), "i"(d0 * 4096 + ks * 1024) : "memory");
                  asm volatile("ds_read_b64_tr_b16 %0,%1 offset:%c2" : "=&v"(hh[ks]) : "v"(vb), "i"(d0 * 4096 + ks * 1024 + 512) : "memory"); }
              asm volatile("s_waitcnt lgkmcnt(0)" ::: "memory"); __builtin_amdgcn_sched_barrier(0);
#define ATT_PK(k) (bf16x8){lo[k][0], lo[k][1], lo[k][2], lo[k][3], hh[k][0], hh[k][1], hh[k][2], hh[k][3]}
              o[d0] = __builtin_amdgcn_mfma_f32_32x32x16_bf16(__builtin_bit_cast(bf16x8, pw0), ATT_PK(0), o[d0], 0, 0, 0);
              o[d0] = __builtin_amdgcn_mfma_f32_32x32x16_bf16(__builtin_bit_cast(bf16x8, pw1), ATT_PK(1), o[d0], 0, 0, 0);
              o[d0] = __builtin_amdgcn_mfma_f32_32x32x16_bf16(__builtin_bit_cast(bf16x8, pw2), ATT_PK(2), o[d0], 0, 0, 0);
              o[d0] = __builtin_amdgcn_mfma_f32_32x32x16_bf16(__builtin_bit_cast(bf16x8, pw3), ATT_PK(3), o[d0], 0, 0, 0);
#undef ATT_PK
          } }
        LDS_WAIT();
        slot = slot1; slot1 = (slot1 == NSLOT - 1) ? 0 : slot1 + 1; slot3 = (slot3 == NSLOT - 1) ? 0 : slot3 + 1;
    }
#undef ATT_QK
    __builtin_amdgcn_s_barrier(); asm volatile("" ::: "memory");
#undef ATT_DMA
    { auto rr = __builtin_amdgcn_permlane32_swap(__float_as_uint(lrun), __float_as_uint(lrun), false, false); lrun = __uint_as_float(rr[0]) + __uint_as_float(rr[1]); }
    if (hi == 0) wsf[32 + r32] = lrun;
    LDS_WAIT();
    float rli[16];
#pragma unroll
    for (int r = 0; r < 16; ++r) rli[r] = __builtin_amdgcn_rcpf(wsf[32 + crow(r, hi)]);
    LAS bf16_t* stg = (LAS bf16_t*)(lds + L_OST) + wid * 2048;
#pragma unroll
    for (int r = 0; r < 16; ++r) { const int orow = crow(r, hi);
#pragma unroll
        for (int d0 = 0; d0 < 2; ++d0) stg[orow * 64 + d0 * 32 + r32] = (bf16_t)(cvtpk_s(o[d0][r] * rli[r], 0.f) & 0xffffu); }
    LDS_WAIT();
#pragma unroll
    for (int i = 0; i < 4; ++i) { const int row = i * 8 + (lane >> 3), ch = lane & 7; const u32x4 v = *(const LAS u32x4*)(stg + row * 64 + ch * 8); *(u32x4*)(Qn + (size_t)row * 512 + ch * 8) = v; }
    LDS_WAIT(); __builtin_amdgcn_s_barrier(); asm volatile("" ::: "memory");
}

__device__ __forceinline__ void attn_phase(Frame& F) {
    const int vcu = (F.G % 8 == 0) ? (F.bid % 8) * (F.G / 8) + F.bid / 8 : F.bid;
    for (int v = vcu; v < 256; v += F.G) {
        const int bh = v >> 2, s = v & 3;
#pragma unroll 1
        for (int i = 0; i < 4; ++i) { const int qb = (i == 0) ? s : (i == 1) ? 7 - s : (i == 2) ? 8 + s : 15 - s; attn_unit<0>(F, bh >> 3, bh & 7, qb); }
#pragma unroll 1
        for (int i = 0; i < 4; ++i) { const int qb = (i == 0) ? s : (i == 1) ? 7 - s : (i == 2) ? 8 + s : 15 - s; attn_unit<1>(F, bh >> 3, bh & 7, qb); }
    }
}
}

struct EpiMerge {
    unsigned char* ws;
    __device__ __forceinline__ void mid(f32x4 (&acc)[2][2][4][2], const pg8::Unit& u, int wr, int wc, int fr, int fq) const {
        const int row0 = u.pm * 256 + wr * 64 + fr, cb = u.pn * 256 + 32 * wc + 4 * fq;
        const bf16_t* ga = (const bf16_t*)(ws + WS_GA); const bf16_t* gm = (const bf16_t*)(ws + WS_GM);
#pragma unroll
        for (int ai = 0; ai < 2; ++ai)
#pragma unroll
            for (int m = 0; m < 4; ++m) { const size_t off = (size_t)(row0 + 128 * ai + 16 * m) * DM + cb;
#pragma unroll
                for (int bj = 0; bj < 2; ++bj) { u32x2 av[2], gv[2]; ld8(ga + (off - 4 * fq) + 128 * bj, av[0], av[1], fq); ld8(gm + (off - 4 * fq) + 128 * bj, gv[0], gv[1], fq);
#pragma unroll
                    for (int n = 0; n < 2; ++n) { const u32x2 a = av[n], g = gv[n];
                        const f32x4 den = (f32x4){fmaxf(bflo(g.x), 1e-30f), fmaxf(bfhi(g.x), 1e-30f), fmaxf(bflo(g.y), 1e-30f), fmaxf(bfhi(g.y), 1e-30f)};
                        acc[ai][bj][m][n] = acc[ai][bj][m][n] * ((f32x4){bflo(a.x), bfhi(a.x), bflo(a.y), bfhi(a.y)} * (f32x4){__builtin_amdgcn_rcpf(den.x), __builtin_amdgcn_rcpf(den.y), __builtin_amdgcn_rcpf(den.z), __builtin_amdgcn_rcpf(den.w)});
                    } } asm volatile("" ::: "memory"); }
    }
    __device__ __forceinline__ void operator()(const f32x4 (&acc)[2][2][4][2], const pg8::Unit& u, int wr, int wc, int fr, int fq) const {
        const int row0 = u.pm * 256 + wr * 64 + fr, cb = u.pn * 256 + 32 * wc + 4 * fq;
        const bf16_t* gm = (const bf16_t*)(ws + WS_GM); bf16_t* mix = (bf16_t*)(ws + WS_MIXED);
#pragma unroll
        for (int ai = 0; ai < 2; ++ai)
#pragma unroll
            for (int m = 0; m < 4; ++m) { const size_t off = (size_t)(row0 + 128 * ai + 16 * m) * DM + cb;
#pragma unroll
                for (int bj = 0; bj < 2; ++bj) { u32x2 pk[2], gv[2]; ld8(gm + (off - 4 * fq) + 128 * bj, gv[0], gv[1], fq);
#pragma unroll
                    for (int n = 0; n < 2; ++n) {
                        const u32x2 g = gv[n];
                        pk[n] = pk4(acc[ai][bj][m][n] * (f32x4){fmaxf(bflo(g.x), 1e-30f), fmaxf(bfhi(g.x), 1e-30f), fmaxf(bflo(g.y), 1e-30f), fmaxf(bfhi(g.y), 1e-30f)});
                    }
                    st8(mix + (off - 4 * fq) + 128 * bj, pk[0], pk[1], fq); } asm volatile("" ::: "memory"); }
    }
};
struct EpiOut {
    unsigned char* ws; const float* x; float* out; const float* g2;
    __device__ __forceinline__ void operator()(const f32x4 (&acc)[2][2][4][2], const pg8::Unit& u, int wr, int wc, int fr, int fq) const {
        const int row0 = u.pm * 256 + wr * 64 + fr, cb = u.pn * 256 + 32 * wc + 4 * fq, b = (u.pm * 256) / SEQ;
        const float* mod = (const float*)(ws + WS_MOD) + (size_t)b * 6144; bf16_t* x1g = (bf16_t*)(ws + WS_X1G); float* ssq = (float*)(ws + WS_SSQ_X1);
        f32x4 gt[2][2], gm[2][2];
#pragma unroll
        for (int bj = 0; bj < 2; ++bj)
#pragma unroll
            for (int n = 0; n < 2; ++n) { const int c = cb + 128 * bj + 16 * n; gt[bj][n] = *(const f32x4*)(mod + 2048 + c); gm[bj][n] = *(const f32x4*)(g2 + c) * (*(const f32x4*)(mod + 4096 + c) + 1.0f); }
#pragma unroll
        for (int ai = 0; ai < 2; ++ai)
#pragma unroll
            for (int m = 0; m < 4; ++m) { const int row = row0 + 128 * ai + 16 * m; const size_t off = (size_t)row * DM + cb; float s = 0.f;
#pragma unroll
                for (int bj = 0; bj < 2; ++bj) { u32x2 pk[2];
#pragma unroll
                    for (int n = 0; n < 2; ++n) {
                        const f32x4 x1 = *(const f32x4*)(x + off + 128 * bj + 16 * n) + gt[bj][n] * acc[ai][bj][m][n];
                        s += sum4sq(x1);
                        pk[n] = pk4(x1 * gm[bj][n]);
                    }
                    st8(x1g + (off - 4 * fq) + 128 * bj, pk[0], pk[1], fq); }
                s = fq_sum(s);
                if (fq == 0) atomicAdd(ssq + row, s); asm volatile("" ::: "memory"); }
    }
};
struct EpiPQ {
    unsigned char* ws;
    __device__ __forceinline__ void operator()(const f32x4 (&acc)[2][2][4][2], const pg8::Unit& u, int wr, int wc, int fr, int fq) const {
        const int row0 = u.pm * 256 + wr * 64 + fr, cb = u.pn * 256 + 32 * wc + 4 * fq, b = (u.pm * 256) / SEQ;
        const float* bias = (const float*)(ws + WS_BIASQ) + (size_t)b * 2048; const float* ssq = (const float*)(ws + WS_SSQ_X1); bf16_t* pq = (bf16_t*)(ws + WS_PQ);
        f32x4 bv[2][2];
#pragma unroll
        for (int bj = 0; bj < 2; ++bj)
#pragma unroll
            for (int n = 0; n < 2; ++n) bv[bj][n] = *(const f32x4*)(bias + cb + 128 * bj + 16 * n);
#pragma unroll
        for (int ai = 0; ai < 2; ++ai)
#pragma unroll
            for (int m = 0; m < 4; ++m) { const int row = row0 + 128 * ai + 16 * m; const float rinv = __builtin_amdgcn_rsqf(ssq[row] * (1.f / DM) + EPS);
#pragma unroll
                for (int bj = 0; bj < 2; ++bj) st8(pq + (size_t)row * 2048 + (cb - 4 * fq) + 128 * bj, pk4(acc[ai][bj][m][0] * rinv + bv[bj][0]), pk4(acc[ai][bj][m][1] * rinv + bv[bj][1]), fq);
                asm volatile("" ::: "memory"); }
    }
};

#define XB_TMO      128
#define XB_XCNT(j)  (256  + 64 * (j))
#define XB_XSUB(j)  (1280 + 64 * (j))
#define XB_XGEN(j)  (2304 + 64 * (j))
#define XB_TOP      3328
#define XB_TOPGEN   3392
#define XB_SPIN_CAP (1u << 22)
__device__ __forceinline__ unsigned xb_ld(unsigned* p)              { return __hip_atomic_load(p, __ATOMIC_RELAXED, __HIP_MEMORY_SCOPE_AGENT); }
__device__ __forceinline__ unsigned xb_add(unsigned* p, unsigned v) { return __hip_atomic_fetch_add(p, v, __ATOMIC_RELAXED, __HIP_MEMORY_SCOPE_AGENT); }
__device__ __forceinline__ unsigned xb_xcc_id() { return (unsigned)__builtin_amdgcn_s_getreg((3 << 11) | 20) & 0xFu; }
#define XB_SPIN(cond, bar) do { unsigned _sp = 0; while (cond) { __builtin_amdgcn_s_sleep(1); \
    if ((++_sp & 255u) == 0u) { if (xb_ld(&(bar)[XB_TMO])) break; if (_sp > XB_SPIN_CAP) { atomicAdd(&(bar)[XB_TMO], 1u); break; } } } } while (0)
struct XcdBarrier { unsigned* bar; unsigned x; volatile LAS unsigned* st; };
__device__ __forceinline__ XcdBarrier xcd_barrier_post(unsigned* bar, volatile LAS unsigned* st) {
    XcdBarrier b; b.bar = bar; b.x = xb_xcc_id(); b.st = st;
    if (threadIdx.x == 0) (void)xb_add(&bar[XB_XCNT(b.x)], 1u);
    return b;
}
__device__ __forceinline__ void xcd_barrier_complete(unsigned* bar, unsigned x, unsigned& nloc, unsigned& nx) {
    const unsigned G = gridDim.x * gridDim.y * gridDim.z;
    unsigned sum, cnt, mine, sp = 0u;
    for (;;) {
        sum = 0u; cnt = 0u; mine = 0u;
#pragma unroll
        for (unsigned j = 0; j < 16; ++j) { const unsigned c = xb_ld(&bar[XB_XCNT(j)]); sum += c; cnt += (c > 0u) ? 1u : 0u; mine = (j == x) ? c : mine; }
        if (sum == G) break;
        __builtin_amdgcn_s_sleep(1);
        if ((++sp & 255u) == 0u) { if (xb_ld(&bar[XB_TMO])) break; if (sp > XB_SPIN_CAP) { atomicAdd(&bar[XB_TMO], 1u); break; } }
    }
    nloc = mine > 0u ? mine : 1u; nx = cnt > 0u ? cnt : 1u;
}
__device__ __forceinline__ void xcd_barrier(const XcdBarrier& b) {
    asm volatile("s_waitcnt vmcnt(0) lgkmcnt(0)" ::: "memory");
    __syncthreads();
    if (threadIdx.x == 0) {
        unsigned* bar = b.bar;
        __builtin_amdgcn_s_waitcnt(0);
        unsigned nloc = b.st[0], nx = b.st[1];
        if (nloc == 0u) { xcd_barrier_complete(bar, b.x, nloc, nx); b.st[0] = nloc; b.st[1] = nx; }
        const unsigned old = xb_add(&bar[XB_XSUB(b.x)], 1u);
        const unsigned gen = old / nloc;
        if (old + 1u == (gen + 1u) * nloc) {
            __builtin_amdgcn_fence(__ATOMIC_RELEASE, "agent");
            asm volatile("s_waitcnt vmcnt(0)" ::: "memory");
            const unsigned og = xb_add(&bar[XB_TOP], 1u);
            const unsigned tg = og / nx;
            if (og + 1u == (tg + 1u) * nx) xb_add(&bar[XB_TOPGEN], 1u);
            else XB_SPIN(xb_ld(&bar[XB_TOPGEN]) == tg, bar);
            __builtin_amdgcn_fence(__ATOMIC_ACQUIRE, "agent");
            xb_add(&bar[XB_XGEN(b.x)], 1u);
            asm volatile("s_waitcnt vmcnt(0)" ::: "memory");
        } else {
            XB_SPIN(xb_ld(&bar[XB_XGEN(b.x)]) == gen, bar);
            __builtin_amdgcn_fence(__ATOMIC_ACQUIRE, "agent");
            asm volatile("s_waitcnt vmcnt(0)" ::: "memory");
        }
    }
    __syncthreads();
}
#define grid_barrier(ctr, target) xcd_barrier(xbar)


namespace peer {
constexpr int TOK = 32;
constexpr int L_EXP = 0, L_GATE = L_EXP + TOK * 128 * 2, L_TOPI = L_GATE + TOK * 128 * 4, L_TOPV = L_TOPI + NWAVES * TOK * 32, L_CNT = L_TOPV + NWAVES * TOK * 32 * 4, L_SU = L_CNT + NWAVES * 64 * 4, L_BYTES = L_SU + TOK * 128 * 4;
static_assert(L_BYTES <= LDS_BYTES, "peer LDS");
__device__ __forceinline__ unsigned sortable(float v) { const unsigned u = __float_as_uint(v); return (u & 0x80000000u) ? ~u : (u | 0x80000000u); }
__device__ __forceinline__ float unsortable(unsigned k) { return __uint_as_float((k & 0x80000000u) ? (k & 0x7fffffffu) : ~k); }
__device__ __forceinline__ unsigned pair_max(unsigned m) { auto rr = __builtin_amdgcn_permlane32_swap(m, m, false, false); return rr[0] > rr[1] ? rr[0] : rr[1]; }
__device__ __forceinline__ float gelu_tanh(float x) { const float y = 0.7978845608028654f * (x + 0.044715f * x * x * x); const float e = __builtin_amdgcn_exp2f(y * (2.f * LOG2E)); return 0.5f * x * (2.f - 2.f * __builtin_amdgcn_rcpf(e + 1.f)); }

template <int CTRL> __device__ __forceinline__ float dppf(float v) { return __int_as_float(__builtin_amdgcn_update_dpp(0, __float_as_int(v), CTRL, 0xf, 0xf, true)); }
__device__ __forceinline__ float wsum_dpp(float v) {
    v += dppf<0xB1>(v); v += dppf<0x4E>(v); v += dppf<0x141>(v); v += dppf<0x140>(v);
    { auto r = __builtin_amdgcn_permlane16_swap(__float_as_uint(v), __float_as_uint(v), false, false); v = __uint_as_float(r[0]) + __uint_as_float(r[1]); }
    { auto r = __builtin_amdgcn_permlane32_swap(__float_as_uint(v), __float_as_uint(v), false, false); v = __uint_as_float(r[0]) + __uint_as_float(r[1]); }
    return v;
}
__device__ __forceinline__ void route_head(Frame& F, int tok0) {
    int lane = F.lane; asm volatile("" : "+v"(lane));
    const int h = F.wave, r32 = lane & 31, hi = lane >> 5;
    const bf16_t* PQ = (const bf16_t*)(F.ws + WS_PQ) + (size_t)(tok0 + r32) * 2048 + h * 256;
    const bf16_t* SK = (const bf16_t*)(F.ws + WS_SUBK) + (size_t)h * 2 * 128 * 128;
    LAS unsigned char* topi = (LAS unsigned char*)(F.lds + L_TOPI) + h * (TOK * 32) + r32 * 32;
    LAS float* topv = (LAS float*)(F.lds + L_TOPV) + h * (TOK * 32) + r32 * 32;
#pragma unroll 1
    for (int p = 0; p < 2; ++p) {
        f32x16 acc[4]; acc[0] = f32x16{}; acc[1] = f32x16{}; acc[2] = f32x16{}; acc[3] = f32x16{};
#pragma unroll 2
        for (int ks = 0; ks < 8; ++ks) {
            const bf16x8 bq = *(const bf16x8*)(PQ + p * 128 + 16 * ks + 8 * hi);
#pragma unroll
            for (int kb = 0; kb < 4; ++kb) {
                const bf16x8 ak = *(const bf16x8*)(SK + ((size_t)p * 128 + 32 * kb + r32) * 128 + 16 * ks + 8 * hi);
                acc[kb] = __builtin_amdgcn_mfma_f32_32x32x16_bf16(ak, bq, acc[kb], 0, 0, 0);
            }
        }
        unsigned key[64];
#pragma unroll
        for (int kb = 0; kb < 4; ++kb)
#pragma unroll
            for (int r = 0; r < 16; ++r) { const int kidx = 32 * kb + (r & 3) + 8 * (r >> 2) + 4 * hi; key[kb * 16 + r] = ((sortable(acc[kb][r]) >> 1) & ~127u) | (unsigned)(127 - kidx); }
        unsigned prev = 0x80000000u;
#pragma unroll 1
        for (int it = 0; it < 16; ++it) {
            unsigned mv = key[0] - prev;
#pragma unroll
            for (int r = 1; r < 64; ++r) { const unsigned d = key[r] - prev; mv = d > mv ? d : mv; }
            mv = pair_max(mv);
            const unsigned m = prev + mv; prev = m;
            if (hi == 0) { topi[p * 16 + it] = (unsigned char)(127 - (m & 127u)); topv[p * 16 + it] = unsortable((m & ~127u) << 1); }
        }
    }
    LDS_WAIT();
    unsigned cand[25];
    { float av[16], bv[16];
#pragma unroll
      for (int i = 0; i < 16; ++i) { av[i] = topv[i]; bv[i] = topv[16 + i]; }
      int n = 0;
#pragma unroll
      for (int i = 0; i < 16; ++i)
#pragma unroll
          for (int j = 0; j < 16; ++j) if ((i + 1) * (j + 1) <= 16) { const unsigned k = (sortable(av[i] + bv[j]) & ~255u) | (unsigned)(255 - (i * 16 + j)); if ((n & 1) == 0) { cand[n >> 1] = hi ? 0u : k; } else { cand[n >> 1] = hi ? k : cand[n >> 1]; } ++n; } }
    LAS unsigned short* ex_o = (LAS unsigned short*)(F.lds + L_EXP) + r32 * 128 + h * 16;
    LAS float* g_o = (LAS float*)(F.lds + L_GATE) + r32 * 128 + h * 16;
    float den = 0.f, s0 = 0.f;
#pragma unroll 1
    for (int it = 0; it < 16; ++it) {
        unsigned m = cand[0];
#pragma unroll
        for (int r = 1; r < 25; ++r) m = cand[r] > m ? cand[r] : m;
        m = pair_max(m);
#pragma unroll
        for (int r = 0; r < 25; ++r) cand[r] = (cand[r] == m) ? 0u : cand[r];
        const float sv = unsortable(m & ~255u); const unsigned pos = 255u - (m & 255u), i = pos >> 4, j = pos & 15u;
        if (it == 0) s0 = sv;
        const float ex = __builtin_amdgcn_exp2f((sv - s0) * LOG2E); den += ex;
        if (hi == 0) { ex_o[it] = (unsigned short)((unsigned)topi[i] * 128u + (unsigned)topi[16 + j]); g_o[it] = ex; }
    }
    const float rden = __builtin_amdgcn_rcpf(den);
    LDS_WAIT();
    if (hi == 0) {
#pragma unroll
        for (int it = 0; it < 16; ++it) g_o[it] *= rden;
    }
}

__device__ __forceinline__ void expert_tokens(Frame& F, int tok0) {
    int lane = F.lane; const int wid = F.wave;
    asm volatile("" : "+v"(lane));
    const unsigned char* PU = F.ws + WS_PU; const unsigned char* PV = F.ws + WS_PV;
    const float* USC = (const float*)(F.ws + WS_USC); const float* VSC = (const float*)(F.ws + WS_VSC);
    const float* ssq = (const float*)(F.ws + WS_SSQ_X1); const bf16_t* X1G = (const bf16_t*)(F.ws + WS_X1G);
    LAS unsigned* cnt = (LAS unsigned*)(F.lds + L_CNT) + wid * 64;
#pragma unroll 1
    for (int tt = 0; tt < 4; ++tt) {
        const int tl = 4 * wid + tt;
        LAS unsigned short* ex_l = (LAS unsigned short*)(F.lds + L_EXP) + tl * 128; LAS float* g_l = (LAS float*)(F.lds + L_GATE) + tl * 128; LAS float* su_l = (LAS float*)(F.lds + L_SU) + tl * 128;
        cnt[lane] = 0u;
        const unsigned e0 = ex_l[lane], e1 = ex_l[lane + 64]; const float g0 = g_l[lane] * VSC[e0], g1 = g_l[lane + 64] * VSC[e1]; const float s0 = USC[e0], s1 = USC[e1];
        const unsigned b0 = e0 >> 8, b1 = e1 >> 8;
        LDS_WAIT(); asm volatile("" ::: "memory");
        const unsigned r0 = __hip_atomic_fetch_add(cnt + b0, 1u, __ATOMIC_RELAXED, __HIP_MEMORY_SCOPE_WORKGROUP);
        const unsigned r1 = __hip_atomic_fetch_add(cnt + b1, 1u, __ATOMIC_RELAXED, __HIP_MEMORY_SCOPE_WORKGROUP);
        LDS_WAIT(); asm volatile("" ::: "memory");
        const int c = (int)cnt[lane]; int incl = c;
#pragma unroll
        for (int o = 1; o < 64; o <<= 1) { const int tv = __shfl_up(incl, o); incl += (lane >= o) ? tv : 0; }
        const int excl = incl - c;
        const int p0 = __shfl(excl, (int)b0) + (int)r0, p1 = __shfl(excl, (int)b1) + (int)r1;
        ex_l[p0] = (unsigned short)e0; ex_l[p1] = (unsigned short)e1; g_l[p0] = g0; g_l[p1] = g1; su_l[p0] = s0; su_l[p1] = s1;
        LDS_WAIT(); asm volatile("" ::: "memory");
    }
    {
        unsigned hA[4][2], hB[4][2]; float hinv[4]; f16x2 acc2[4][8]; u32x4 xg[4][2];
#pragma unroll
        for (int u = 0; u < 4; ++u) {
            const int t = tok0 + 4 * wid + u, b = t / SEQ;
            const float* mod = (const float*)(F.ws + WS_MOD) + (size_t)b * 6144;
            const float rinv = __builtin_amdgcn_rsqf(ssq[t] * (1.f / DM) + EPS);
            const u32x4 x0 = *(const u32x4*)(X1G + (size_t)t * DM + 16 * lane), x1 = *(const u32x4*)(X1G + (size_t)t * DM + 16 * lane + 8);
            float hv[16]; float amax = 1e-30f; xg[u][0] = x0; xg[u][1] = x1;
#pragma unroll
            for (int j = 0; j < 4; ++j) { const f32x4 sh = *(const f32x4*)(mod + 3072 + 16 * lane + 4 * j); const unsigned w0 = (j < 2) ? x0[2 * j] : x1[2 * j - 4], w1 = (j < 2) ? x0[2 * j + 1] : x1[2 * j - 3];
                hv[4 * j] = bflo(w0) * rinv + sh.x; hv[4 * j + 1] = bfhi(w0) * rinv + sh.y; hv[4 * j + 2] = bflo(w1) * rinv + sh.z; hv[4 * j + 3] = bfhi(w1) * rinv + sh.w; }
#pragma unroll
            for (int i = 0; i < 16; ++i) amax = fmaxf(amax, fabsf(hv[i]));
#pragma unroll
            for (int o = 32; o >= 1; o >>= 1) amax = fmaxf(amax, __shfl_xor(amax, o));
            const float hs = 119.f / amax; hinv[u] = amax * (1.f / 119.f);
            hA[u][0] = hA[u][1] = hB[u][0] = hB[u][1] = 0u;
#pragma unroll
            for (int i = 0; i < 16; ++i) { const int q = (int)__builtin_rintf(hv[i] * hs); const int lo = ((q + 8) & 15) - 8; const int hi = (q - lo) >> 4;
                hA[u][i >> 3] |= ((unsigned)hi & 15u) << (4 * (i & 7)); hB[u][i >> 3] |= ((unsigned)lo & 15u) << (4 * (i & 7)); }
#pragma unroll
            for (int i = 0; i < 8; ++i) acc2[u][i] = (f16x2){(_Float16)0.f, (_Float16)0.f};
            asm volatile("" ::: "memory");
        }
        const LAS unsigned short* ex_w = (const LAS unsigned short*)(F.lds + L_EXP) + (4 * wid) * 128;
        const LAS float* g_w = (const LAS float*)(F.lds + L_GATE) + (4 * wid) * 128;
        const LAS float* su_w = (const LAS float*)(F.lds + L_SU) + (4 * wid) * 128;
        const int kl = ((lane >> 5) & 1) | (((lane >> 4) & 1) << 1);
        const unsigned voff = 8u * (unsigned)lane;
        const __amdgpu_buffer_rsrc_t rsU = __builtin_amdgcn_make_buffer_rsrc((void*)PU, (short)0, PNEXP * (DM / 2), 0x00020000), rsV = __builtin_amdgcn_make_buffer_rsrc((void*)PV, (short)0, PNEXP * (DM / 2), 0x00020000);
        u32x2 ua[4], va[4], ub[4], vb[4]; float ga, gb, sua, sub_;
#define PEER_LOAD(U, V, G, SU, u, e0) do { _Pragma("unroll") for (int k = 0; k < 4; ++k) { const int eid = __builtin_amdgcn_readfirstlane((int)ex_w[(u) * 128 + (e0) + k]); \
            U[k] = (u32x2)__builtin_amdgcn_raw_buffer_load_b64(rsU, (int)voff, eid * (DM / 2), 0); V[k] = (u32x2)__builtin_amdgcn_raw_buffer_load_b64(rsV, (int)voff, eid * (DM / 2), 0); } \
            { SU = su_w[(u) * 128 + (e0) + kl] * hinv[u]; G = g_w[(u) * 128 + (e0) + kl]; } } while (0)
#define VACC(j, b) acc2[u_][4 * (j) + (b)] = __builtin_elementwise_fma(c2, __builtin_bit_cast(f16x2, __builtin_amdgcn_cvt_scalef32_pk_f16_fp4(Vk[j], 1.0f, b)), acc2[u_][4 * (j) + (b)])
#define PEER_COMP(U, V, G, SU, u) do { constexpr int u_ = (u); float dd[4]; _Pragma("unroll") for (int k = 0; k < 4; ++k) { \
            const int da = __builtin_amdgcn_sdot8((int)U[k][1], (int)hA[u_][1], __builtin_amdgcn_sdot8((int)U[k][0], (int)hA[u_][0], 0, false), false); \
            const int db = __builtin_amdgcn_sdot8((int)U[k][1], (int)hB[u_][1], __builtin_amdgcn_sdot8((int)U[k][0], (int)hB[u_][0], 0, false), false); \
            dd[k] = (float)(16 * da + db); } \
            float z; { auto r0 = __builtin_amdgcn_permlane32_swap(__float_as_uint(dd[0]), __float_as_uint(dd[1]), false, false); const float s01 = __uint_as_float(r0[0]) + __uint_as_float(r0[1]); \
              auto r1 = __builtin_amdgcn_permlane32_swap(__float_as_uint(dd[2]), __float_as_uint(dd[3]), false, false); const float s23 = __uint_as_float(r1[0]) + __uint_as_float(r1[1]); \
              auto r2 = __builtin_amdgcn_permlane16_swap(__float_as_uint(s01), __float_as_uint(s23), false, false); z = __uint_as_float(r2[0]) + __uint_as_float(r2[1]); } \
            z += dppf<0xB1>(z); z += dppf<0x4E>(z); z += dppf<0x141>(z); z += dppf<0x140>(z); \
            const float cf_ = G * gelu_tanh(z * SU); const f16x2 ch_ = (f16x2){(_Float16)cf_, (_Float16)cf_}; const int ci = __builtin_bit_cast(int, ch_); \
            _Pragma("unroll") for (int k = 0; k < 4; ++k) { const f16x2 c2 = __builtin_bit_cast(f16x2, __builtin_amdgcn_readlane(ci, ((k & 1) << 5) | ((k >> 1) << 4))); const u32x2 Vk = V[k]; \
            VACC(0, 0); VACC(0, 1); VACC(0, 2); VACC(0, 3); VACC(1, 0); VACC(1, 1); VACC(1, 2); VACC(1, 3); } } while (0)
        PEER_LOAD(ua, va, ga, sua, 0, 0);
#pragma unroll 1
        for (int j = 0; j < 32; ++j) {
            const int jn = (j + 1 < 32) ? j + 1 : 31;
            PEER_LOAD(ub, vb, gb, sub_, 1, 4 * j);     PEER_COMP(ua, va, ga, sua, 0);
            PEER_LOAD(ua, va, ga, sua, 2, 4 * j);      PEER_COMP(ub, vb, gb, sub_, 1);
            PEER_LOAD(ub, vb, gb, sub_, 3, 4 * j);     PEER_COMP(ua, va, ga, sua, 2);
            PEER_LOAD(ua, va, ga, sua, 0, 4 * jn);     PEER_COMP(ub, vb, gb, sub_, 3);
        }
#undef PEER_LOAD
#undef PEER_COMP
#undef VACC
#pragma unroll
        for (int u = 0; u < 4; ++u) {
            const int t = tok0 + 4 * wid + u, b = t / SEQ; const float* mod = (const float*)(F.ws + WS_MOD) + (size_t)b * 6144;
            float* op = F.out + (size_t)t * DM + 16 * lane; const float* g2 = F.in[IN_G2] + 16 * lane;
            const u32x4 y0 = xg[u][0], y1 = xg[u][1];
#pragma unroll
            for (int j = 0; j < 4; ++j) { const f32x4 g = *(const f32x4*)(mod + 5120 + 16 * lane + 4 * j); const f32x4 gmv = *(const f32x4*)(g2 + 4 * j) * (*(const f32x4*)(mod + 4096 + 16 * lane + 4 * j) + 1.0f);
                const unsigned w0 = (j < 2) ? y0[2 * j] : y1[2 * j - 4], w1 = (j < 2) ? y0[2 * j + 1] : y1[2 * j - 3];
                const f32x4 x = (f32x4){bflo(w0), bfhi(w0), bflo(w1), bfhi(w1)} * (f32x4){__builtin_amdgcn_rcpf(gmv.x), __builtin_amdgcn_rcpf(gmv.y), __builtin_amdgcn_rcpf(gmv.z), __builtin_amdgcn_rcpf(gmv.w)};
                *(f32x4*)(op + 4 * j) = x + g * (f32x4){(float)acc2[u][2 * j].x, (float)acc2[u][2 * j].y, (float)acc2[u][2 * j + 1].x, (float)acc2[u][2 * j + 1].y}; }
        }
    }
}
__device__ __forceinline__ void peer_phase(Frame& F) {
    for (int u = F.bid; u < T / TOK; u += F.G) {
        const int tok0 = u * TOK;
        route_head(F, tok0);
        __syncthreads();
        expert_tokens(F, tok0);
        __syncthreads();
    }
}
}

__global__ void __launch_bounds__(NTHREADS, 2) hybrid_fwd(Args args) {
    extern __shared__ __attribute__((aligned(16))) unsigned char lds_raw[];
    cg::grid_group grid = cg::this_grid();
    Frame F;
    F.lds = (LAS unsigned char*)lds_raw; F.ws = args.ws;
    F.tid = threadIdx.x; F.lane = F.tid & 63; F.wave = __builtin_amdgcn_readfirstlane(F.tid >> 6);
    F.G = gridDim.x; F.bid = blockIdx.x;
#pragma unroll
    for (int i = 0; i < 24; ++i) F.in[i] = args.in[i];
    F.out = args.out;
    unsigned char* ws = args.ws;
    const int lo = args.ph_lo, hi = args.ph_hi;
#define IN(k) (lo <= (k) && (k) < hi)
    unsigned nbar = 0; unsigned* barctr = (unsigned*)(ws + WS_BAR);
    volatile LAS unsigned* xst = (volatile LAS unsigned*)(F.lds + LDS_BYTES - 64);
    if (F.tid < 2) xst[F.tid] = 0u;
    __syncthreads();
    XcdBarrier xbar; xbar.bar = barctr; xbar.x = 0; xbar.st = xst;
#define SEAM(k) do { if (IN(k) && IN((k) + 1)) { if ((k) == 0) { asm volatile("s_waitcnt vmcnt(0) lgkmcnt(0)" ::: "memory"); __syncthreads(); grid.sync(); \
        __builtin_amdgcn_fence(__ATOMIC_ACQUIRE, "agent"); asm volatile("s_waitcnt vmcnt(0)" ::: "memory"); __syncthreads(); xbar = xcd_barrier_post(barctr, xst); } \
        else { ++nbar; grid_barrier(barctr, nbar * (unsigned)F.G); } } } while (0)
    if (IN(0)) { phase0(F); __syncthreads(); }
    SEAM(0);
    if (IN(1)) { phase1(F); }
    SEAM(1);
    if (IN(2)) {
        pg8::StaticOrder S; S.init((const bf16_t*)(ws + WS_XN), (const bf16_t*)(ws + WS_WIN), T, IN_PAD, DM, F.G, F.bid);
        EpiIn E{ws, F.in[IN_GAQ], F.in[IN_GAK], F.in[IN_GIDXK], F.in[IN_GMK]};
        pg8::gemm_phase(F.lds, DM, S, E);
    }
    SEAM(2);
    if (IN(3)) {
        { pg8::StaticOrder S; S.init((const bf16_t*)(ws + WS_CQ), (const bf16_t*)(ws + WS_WQUP), T, 768, QRANK, F.G, F.bid);
          EpiQup E{ws, F.in[IN_GMQ]}; pg8::gemm_phase(F.lds, QRANK, S, E); }
        { pg8::StaticOrder S; S.init((const bf16_t*)(ws + WS_CKV), (const bf16_t*)(ws + WS_WKVUP), T, 1024, KVRANK, F.G, F.bid);
          EpiKVup E{ws, F.in[IN_GMK]}; pg8::gemm_phase(F.lds, KVRANK, S, E); }
        indexer_phase(F);
    }
    SEAM(3);
    if (IN(4)) { att::attn_phase(F); }
    SEAM(4);
    if (IN(5)) {
        cvt_i4_rows(F.in[IN_PU], ws + WS_PU, (float*)(ws + WS_USC), PNEXP, F.bid * NWAVES + F.wave, F.G * NWAVES, F.lane);
        cvt_fp4_rows(F.in[IN_PV], ws + WS_PV, (float*)(ws + WS_VSC), PNEXP, F.bid * NWAVES + F.wave, F.G * NWAVES, F.lane);
        pg8::DualOrder S; S.A0 = (const char*)(ws + WS_QA); S.B0 = (const char*)(ws + WS_WOA); S.A1 = (const char*)(ws + WS_QMN); S.B1 = (const char*)(ws + WS_WOM);
        S.nM = T / 256; S.nN = DM / 256; S.G = F.G; S.c = F.bid; S.tstep = (size_t)256 * AW * 2;
        EpiMerge E{ws}; pg8::gemm_phase<true>(F.lds, AW, S, E);
    }
    SEAM(5);
    if (IN(6)) {
        pg8::StaticOrder S; S.init((const bf16_t*)(ws + WS_MIXED), (const bf16_t*)(ws + WS_WOUT), T, DM, DM, F.G, F.bid);
        EpiOut E{ws, F.in[IN_X], F.out, F.in[IN_G2]}; pg8::gemm_phase(F.lds, DM, S, E);
    }
    SEAM(6);
    if (IN(7)) {
        pg8::StaticOrder S; S.init((const bf16_t*)(ws + WS_X1G), (const bf16_t*)(ws + WS_WPQ), T, 2048, DM, F.G, F.bid);
        EpiPQ E{ws}; pg8::gemm_phase(F.lds, DM, S, E);
    }
    SEAM(7);
    if (IN(8)) { peer::peer_phase(F); }
#undef IN
#undef SEAM
}

extern "C" void kernel_launch(void* const* d_in, const int* in_sizes, int n_in, void* d_out, int out_size, void* d_ws, size_t ws_size, hipStream_t stream) {
    static int grid = 0;
    if (grid == 0) {
        if (n_in != 24 || out_size != T * DM || ws_size < WS_END) { fprintf(stderr, "kernel_launch: unexpected shapes (n_in %d, out %d, ws %zu < %zu)\n", n_in, out_size, ws_size, (size_t)WS_END); grid = -1; return; }
        int dev = 0, cus = 0, per_cu = 0;
        (void)hipGetDevice(&dev); (void)hipDeviceGetAttribute(&cus, hipDeviceAttributeMultiprocessorCount, dev);
        if (hipFuncSetAttribute((const void*)hybrid_fwd, hipFuncAttributeMaxDynamicSharedMemorySize, LDS_BYTES) != hipSuccess) { fprintf(stderr, "kernel_launch: hipFuncSetAttribute failed\n"); grid = -1; return; }
        if (hipOccupancyMaxActiveBlocksPerMultiprocessor(&per_cu, (const void*)hybrid_fwd, NTHREADS, LDS_BYTES) != hipSuccess || per_cu < 1) { fprintf(stderr, "kernel_launch: occupancy query says %d blocks/CU\n", per_cu); (void)hipGetLastError(); per_cu = 1; }
        grid = cus * (per_cu < 1 ? 1 : 1);
        fprintf(stderr, "kernel_launch: grid %d (cus %d, occupancy %d/CU)\n", grid, cus, per_cu);
    }
    if (grid < 0) return;
    Args a{};
    for (int i = 0; i < 24; ++i) a.in[i] = (const float*)d_in[i];
    a.out = (float*)d_out; a.ws = (unsigned char*)d_ws;
    a.ph_lo = 0; a.ph_hi = 9;
    void* kargs[] = {&a};
    hipError_t e = hipLaunchCooperativeKernel((const void*)hybrid_fwd, dim3(grid), dim3(NTHREADS), kargs, LDS_BYTES, stream);
    if (e != hipSuccess) fprintf(stderr, "kernel_launch: cooperative launch failed: %s (grid %d)\n", hipGetErrorString(e), grid);
}
```

```cpp
#include <hip/hip_runtime.h>
#include <hip/hip_cooperative_groups.h>
#include <cstdio>
#include <cstdint>
namespace cg = cooperative_groups;

#define LAS __attribute__((address_space(3)))
typedef unsigned short bf16_t;
typedef short bf16x8 __attribute__((ext_vector_type(8)));
typedef short s16x4 __attribute__((ext_vector_type(4)));
typedef float f32x2 __attribute__((ext_vector_type(2)));
typedef float f32x4 __attribute__((ext_vector_type(4)));
typedef float f32x16 __attribute__((ext_vector_type(16)));
typedef unsigned u32x2 __attribute__((ext_vector_type(2)));
typedef unsigned u32x4 __attribute__((ext_vector_type(4)));
typedef __bf16 bf16x2_t __attribute__((ext_vector_type(2)));
typedef _Float16 f16x2 __attribute__((ext_vector_type(2)));

constexpr int NB = 8, SEQ = 4096, DM = 1024, T = NB * SEQ;
constexpr int AW = 512, NH = 8, HD = 64;
constexpr int QRANK = 384, KVRANK = 256, NOPE = 64, ROPED = 32, MQK = 96;
constexpr int IN_WIDTH = 4840, IN_PAD = 5120;
constexpr int PH = 8, PNK = 128, PNEXP = 16384, PDK = 256, PTOPK = 16;
constexpr int NSEL = 256;
constexpr float EPS = 1e-6f;
constexpr float LOG2E = 1.4426950408889634f;
constexpr float C2A = 0.125f * LOG2E;
constexpr float C2B = 0.10206207261596577f * LOG2E;

constexpr size_t MiB = 1u << 20;
constexpr size_t WS_ZERO = 0, ZERO_BYTES = 2 * MiB;
constexpr size_t WS_SSQ_CQ = 0;
constexpr size_t WS_SSQ_CKV = WS_SSQ_CQ + (size_t)T * 4;
constexpr size_t WS_SSQ_X1 = WS_SSQ_CKV + (size_t)T * 4;
constexpr size_t WS_SSQ_QM = WS_SSQ_X1 + (size_t)T * 4;
constexpr size_t WS_MOD = WS_SSQ_QM + (size_t)T * 8 * 4;
constexpr size_t WS_BIASQ = WS_MOD + (size_t)NB * 6144 * 4;
constexpr size_t WS_BAR = WS_BIASQ + (size_t)NB * 2048 * 4;
static_assert(WS_BAR + 3456 * 4 <= ZERO_BYTES, "zero region");
constexpr size_t WS_WIN = 3 * MiB;
constexpr size_t WS_WQUP = WS_WIN + (size_t)IN_PAD * DM * 2;
constexpr size_t WS_WKVUP = WS_WQUP + (size_t)768 * 384 * 2;
constexpr size_t WS_WOA = WS_WKVUP + (size_t)1024 * 256 * 2;
constexpr size_t WS_WOM = WS_WOA + (size_t)1024 * 512 * 2;
constexpr size_t WS_WOUT = WS_WOM + (size_t)1024 * 512 * 2;
constexpr size_t WS_WPQ = WS_WOUT + (size_t)1024 * 1024 * 2;
constexpr size_t WS_SUBK = WS_WPQ + (size_t)2048 * 1024 * 2;
constexpr size_t WS_ROPE32 = WS_SUBK + (size_t)16 * 128 * 128 * 2;
constexpr size_t WS_ROPE16 = WS_ROPE32 + (size_t)T * 64 * 4;
constexpr size_t WS_W_END = WS_ROPE16 + (size_t)T * 32 * 4;
static_assert(WS_W_END <= 36 * MiB, "weights region");
constexpr size_t R1 = 36 * MiB;
constexpr size_t WS_XN = R1, WS_QMN = R1, WS_QMR = R1 + 32 * MiB;
constexpr size_t R2 = 100 * MiB;
constexpr size_t WS_QA = R2, WS_KA = R2 + 32 * MiB, WS_VA = R2 + 64 * MiB, WS_QI = R2 + 96 * MiB, WS_PQ = R2;
constexpr size_t R3 = 228 * MiB;
constexpr size_t WS_GA = R3, WS_GM = R3 + 64 * MiB, WS_X1G = R3;
constexpr size_t R4 = 356 * MiB;
constexpr size_t WS_KMN = R4, WS_KMR = R4 + 32 * MiB, WS_VM = R4 + 48 * MiB, WS_PU = R4, WS_PV = R4 + 16 * MiB, WS_USC = R4 + 32 * MiB, WS_VSC = R4 + 33 * MiB;
constexpr size_t R5 = 436 * MiB;
constexpr size_t WS_CQ = R5, WS_CKV = R5 + 24 * MiB, WS_KI = R5 + 40 * MiB, WS_WI = R5 + 44 * MiB, WS_KPER = R5 + 45 * MiB,
                 WS_KPESSQ = R5 + 49 * MiB, WS_MASK = R5 + 50 * MiB, WS_MIXED = R5;
constexpr size_t WS_END = 502 * MiB;
static_assert(WS_MASK + (size_t)NB * 64 * SEQ * 8 <= WS_END, "ws map");

constexpr int LDS_BYTES = 155648;
constexpr int NWAVES = 8, NTHREADS = 512;

__device__ __forceinline__ unsigned cvt_pk_bf16(float lo, float hi) { unsigned r; asm volatile("v_cvt_pk_bf16_f32 %0, %1, %2" : "=v"(r) : "v"(lo), "v"(hi)); return r; }
__device__ __forceinline__ unsigned cvtpk_s(float lo, float hi) { f32x2 v = {lo, hi}; bf16x2_t b = __builtin_convertvector(v, bf16x2_t); return __builtin_bit_cast(unsigned, b); }
__device__ __forceinline__ float bf2f(unsigned short b) { return __uint_as_float((unsigned)b << 16); }
__device__ __forceinline__ float bflo(unsigned w) { return __uint_as_float(w << 16); }
__device__ __forceinline__ float bfhi(unsigned w) { return __uint_as_float(w & 0xffff0000u); }
__device__ __forceinline__ float rdlane_f(float v, int l) { return __int_as_float(__builtin_amdgcn_readlane(__float_as_int(v), l)); }
__device__ __forceinline__ float sigmoidf_(float v) { return __builtin_amdgcn_rcpf(1.0f + __builtin_amdgcn_exp2f(-v * LOG2E)); }
#define LDS_WAIT() asm volatile("s_waitcnt lgkmcnt(0)" ::: "memory")
#define VM_WAIT() asm volatile("s_waitcnt vmcnt(0)" ::: "memory")

namespace pg8 {
constexpr int BM = 256, BK = 64, HALF = 128, HTB = HALF * BK * 2, STAGE_BYTES = 8 * HTB, NXCD = 8, WGM = 8;
__host__ __device__ __forceinline__ int lds_byte(int r, int c) { const int st = (r >> 4) * 2 + (c >> 5), rr = r & 15, cc = c & 31, ob = rr * 64 + cc * 2; return st * 1024 + (ob ^ (((ob >> 9) & 1) << 5)); }
__host__ __device__ __forceinline__ void stage_rc(int b, int& R, int& C) { const int st = b / 1024, sb = b % 1024, swz = sb ^ (((sb >> 9) & 1) << 5); R = (st >> 1) * 16 + swz / 64; C = (st & 1) * 32 + (swz % 64) / 2; }

struct Unit { int pm, pn, tag; const char* A; const char* B; };

__device__ __forceinline__ bool tile_order(int L, int nM, int nN, int& pm, int& pn) {
    const int nwg = nM * nN; if (L >= nwg) return false;
    int wgid = L; { const int q = nwg / NXCD, r = nwg % NXCD, xcd = wgid % NXCD, off = wgid / NXCD; wgid = (xcd < r ? xcd * (q + 1) : r * (q + 1) + (xcd - r) * q) + off; }
    const int nig = WGM * nN, gid = wgid / nig, fm = gid * WGM, gsz = (nM - fm) < WGM ? (nM - fm) : WGM;
    pm = fm + ((wgid % nig) % gsz); pn = (wgid % nig) / gsz; return true;
}
struct StaticOrder {
    const char* A; const char* Bt; int nM, nN, G, c; size_t tstep;
    __device__ void init(const bf16_t* A_, const bf16_t* Bt_, int M, int N, int K, int G_, int c_) { A = (const char*)A_; Bt = (const char*)Bt_; nM = M / BM; nN = N / BM; G = G_; c = c_; tstep = (size_t)BM * K * 2; }
    __device__ __forceinline__ bool next(int i, Unit& u) const {
        int pm, pn; if (!tile_order(i * G + c, nM, nN, pm, pn)) return false;
        u.pm = pm; u.pn = pn; u.tag = 0; u.A = A + (size_t)pm * tstep; u.B = Bt + (size_t)pn * tstep; return true;
    }
};
struct DualOrder {
    const char* A0; const char* B0; const char* A1; const char* B1; int nM, nN, G, c; size_t tstep;
    __device__ __forceinline__ bool next(int i, Unit& u) const {
        int pm, pn; if (!tile_order((i >> 1) * G + c, nM, nN, pm, pn)) return false;
        u.pm = pm; u.pn = pn; u.tag = i & 1; u.A = ((i & 1) ? A1 : A0) + (size_t)pm * tstep; u.B = ((i & 1) ? B1 : B0) + (size_t)pn * tstep; return true;
    }
};

template <bool MERGE = false, class Epi, class Sched>
__device__ __forceinline__ void gemm_phase(LAS unsigned char* lds, const int K, const Sched& S, const Epi& E) {
    const int tid = threadIdx.x, wid = __builtin_amdgcn_readfirstlane(tid >> 6), lane = tid & 63, wr = wid >> 2, wc = wid & 3, fr = lane & 15, fq = lane >> 4;
    const int nt = K / BK;
    unsigned voffA[2];
#pragma unroll
    for (int i = 0; i < 2; ++i) { int R, C; stage_rc(tid * 16 + i * 8192, R, C); voffA[i] = (unsigned)(R * K + C) * 2u; }
    const size_t kstep = (size_t)(BK * 2);
    const size_t hstep = (size_t)HALF * K * 2;
    const unsigned ldsw = (unsigned)wid * 1024u;
    const int aoff = lds_byte(wr * 64 + fr, fq * 8), boff = lds_byte(wc * 32 + fr, fq * 8);
#define PG8_SA(b, h) (((b) * 2 + (h)) * HTB)
#define PG8_SB(b, h) ((4 + (b) * 2 + (h)) * HTB)
#define PG8_STAGE(bufoff, gbase) do { _Pragma("unroll") for (int _i = 0; _i < 2; ++_i) \
        __builtin_amdgcn_global_load_lds((const unsigned*)((const char*)(gbase) + voffA[_i]), (LAS unsigned*)(lds + (bufoff) + ldsw + _i * 8192), 16, 0, 0); } while (0)
#define PG8_LDA(dst, b, h) do { _Pragma("unroll") for (int m = 0; m < 4; ++m) _Pragma("unroll") for (int k = 0; k < 2; ++k) dst[m][k] = *(const LAS bf16x8*)(lds + PG8_SA(b, h) + aoff + m * 2048 + k * 1024); } while (0)
#define PG8_LDB(dst, b, h) do { _Pragma("unroll") for (int n = 0; n < 2; ++n) _Pragma("unroll") for (int k = 0; k < 2; ++k) dst[n][k] = *(const LAS bf16x8*)(lds + PG8_SB(b, h) + boff + n * 2048 + k * 1024); } while (0)
#define PG8_MMA(ai, bj, At, Bt) do { __builtin_amdgcn_s_setprio(1); _Pragma("unroll") for (int m = 0; m < 4; ++m) _Pragma("unroll") for (int n = 0; n < 2; ++n) _Pragma("unroll") for (int k = 0; k < 2; ++k) \
        acc[ai][bj][m][n] = __builtin_amdgcn_mfma_f32_16x16x32_bf16(Bt[n][k], At[m][k], acc[ai][bj][m][n], 0, 0, 0); __builtin_amdgcn_s_setprio(0); } while (0)
#define PG8_WAIT_V(n) asm volatile("s_waitcnt vmcnt(" #n ")" ::: "memory")
#define PG8_WAIT_L(n) asm volatile("s_waitcnt lgkmcnt(" #n ")" ::: "memory")
#define PG8_BAR __builtin_amdgcn_s_barrier()
#define PG8_SCHED __builtin_amdgcn_sched_barrier(0)
    Unit cur, nxt; int ui = 0;
    if (!S.next(0, cur)) return;
    f32x4 acc[2][2][4][2];
#pragma unroll
    for (int a = 0; a < 2; ++a)
#pragma unroll
        for (int b = 0; b < 2; ++b)
#pragma unroll
            for (int m = 0; m < 4; ++m)
#pragma unroll
                for (int n = 0; n < 2; ++n) acc[a][b][m][n] = (f32x4){0.f, 0.f, 0.f, 0.f};
    bf16x8 At[4][2], B0[2][2], B1[2][2];
    const char* cA = cur.A; const char* cB = cur.B;
    PG8_STAGE(PG8_SB(0, 0), cB); PG8_STAGE(PG8_SB(0, 1), cB + hstep); PG8_STAGE(PG8_SA(0, 0), cA); PG8_STAGE(PG8_SA(0, 1), cA + hstep);
    if (wr == 1) PG8_BAR;
    PG8_WAIT_V(2); PG8_BAR;
    PG8_STAGE(PG8_SB(1, 0), cB + kstep); PG8_STAGE(PG8_SA(1, 0), cA + kstep); PG8_STAGE(PG8_SB(1, 1), cB + hstep + kstep);
    PG8_WAIT_V(6); PG8_BAR;
    for (;;) {
        const bool has_next = S.next(ui + 1, nxt);
        const char* nA = has_next ? nxt.A : cA; const char* nB = has_next ? nxt.B : cB;
#pragma unroll 1
        for (int t = 0; t < nt; t += 2) {
            const bool last = (t == nt - 2);
            const char* a1 = cA + (size_t)(t + 1) * kstep;
            const char* a2 = last ? nA : cA + (size_t)(t + 2) * kstep; const char* b2 = last ? nB : cB + (size_t)(t + 2) * kstep;
            const char* a3 = a2 + kstep; const char* b3 = b2 + kstep;
            PG8_LDB(B0, 0, 0); PG8_LDB(B1, 0, 1); PG8_SCHED; PG8_LDA(At, 0, 0); PG8_STAGE(PG8_SA(1, 1), a1 + hstep);
            PG8_WAIT_V(8); PG8_WAIT_L(0); PG8_BAR; PG8_MMA(0, 0, At, B0); PG8_MMA(0, 1, At, B1); PG8_BAR; PG8_SCHED;
            PG8_LDA(At, 0, 1); PG8_STAGE(PG8_SB(0, 0), b2); PG8_STAGE(PG8_SB(0, 1), b2 + hstep); PG8_STAGE(PG8_SA(0, 0), a2);
            PG8_WAIT_V(8); PG8_WAIT_L(0); PG8_BAR; PG8_MMA(1, 0, At, B0); PG8_MMA(1, 1, At, B1); PG8_BAR; PG8_SCHED;
            PG8_LDB(B0, 1, 0); PG8_LDB(B1, 1, 1); PG8_SCHED; PG8_LDA(At, 1, 0); PG8_STAGE(PG8_SA(0, 1), a2 + hstep);
            PG8_WAIT_V(8); PG8_WAIT_L(0); PG8_BAR; PG8_MMA(0, 0, At, B0); PG8_MMA(0, 1, At, B1); PG8_BAR; PG8_SCHED;
            PG8_LDA(At, 1, 1); PG8_STAGE(PG8_SB(1, 0), b3); PG8_STAGE(PG8_SB(1, 1), b3 + hstep); PG8_STAGE(PG8_SA(1, 0), a3);
            PG8_WAIT_V(8); PG8_WAIT_L(0); PG8_BAR; PG8_MMA(1, 0, At, B0); PG8_MMA(1, 1, At, B1); PG8_BAR; PG8_SCHED;
        }
        if (wr == 0) PG8_BAR;
        bool keep = false;
        if constexpr (MERGE) { if (cur.tag == 0) { E.mid(acc, cur, wr, wc, fr, fq); keep = true; } else E(acc, cur, wr, wc, fr, fq); } else E(acc, cur, wr, wc, fr, fq);
        if (!has_next) break;
        if (!keep) {
#pragma unroll
        for (int a = 0; a < 2; ++a)
#pragma unroll
            for (int b = 0; b < 2; ++b)
#pragma unroll
                for (int m = 0; m < 4; ++m)
#pragma unroll
                    for (int n = 0; n < 2; ++n) acc[a][b][m][n] = (f32x4){0.f, 0.f, 0.f, 0.f};
        }
        cur = nxt; cA = nA; cB = nB; ++ui;
        if (wr == 1) PG8_BAR;
    }
    PG8_WAIT_V(0);
    PG8_BAR;
#undef PG8_SA
#undef PG8_SB
#undef PG8_STAGE
#undef PG8_LDA
#undef PG8_LDB
#undef PG8_MMA
#undef PG8_WAIT_V
#undef PG8_WAIT_L
#undef PG8_BAR
#undef PG8_SCHED
}
}

struct Args {
    const float* in[24]; float* out; unsigned char* ws; int ph_lo, ph_hi;
};
struct Frame {
    LAS unsigned char* lds; unsigned char* ws;
    int tid, lane, wave, G, bid;
    const float* in[24]; float* out;
};
#define IN_X 0
#define IN_C 1
#define IN_POS 2
#define IN_G1 3
#define IN_G2 4
#define IN_WADA 5
#define IN_BADA 6
#define IN_WIN 7
#define IN_GAQ 8
#define IN_GAK 9
#define IN_GIDXK 10
#define IN_GMQA 11
#define IN_WMQUP 12
#define IN_GMKVA 13
#define IN_WMKVUP 14
#define IN_GMQ 15
#define IN_GMK 16
#define IN_WOA 17
#define IN_WOM 18
#define IN_WOUT 19
#define IN_WPQ 20
#define IN_SUBK 21
#define IN_PU 22
#define IN_PV 23

__device__ __forceinline__ void gemv8_block(const float* vec, int vstride, bool silu, const float* W, int N, float* out, const float* bias, int cb, LAS float* red, int wave, int lane, int tid, int kbeg = 0, int nkc = 2, bool accumulate = false) {
    const int j = cb * 64 + lane;
    float acc[8];
#pragma unroll
    for (int b = 0; b < 8; ++b) acc[b] = 0.f;
#pragma unroll 1
    for (int kc = 0; kc < nkc; ++kc) {
        const int k0 = kbeg + wave * (64 * nkc) + kc * 64;
        float cv[8];
#pragma unroll
        for (int b = 0; b < 8; ++b) { float v = vec[(size_t)b * vstride + k0 + lane]; if (silu) v = v * sigmoidf_(v); cv[b] = v; }
#pragma unroll 8
        for (int kk = 0; kk < 64; ++kk) {
            const float w = W[(size_t)(k0 + kk) * N + j];
#pragma unroll
            for (int b = 0; b < 8; ++b) acc[b] += rdlane_f(cv[b], kk) * w;
        }
    }
#pragma unroll
    for (int b = 0; b < 8; ++b) red[(wave * 8 + b) * 64 + lane] = acc[b];
    __syncthreads();
    { const int b = tid >> 6, l = tid & 63; float s = bias ? bias[cb * 64 + l] : 0.f;
#pragma unroll
      for (int w = 0; w < 8; ++w) s += red[(w * 8 + b) * 64 + l];
      if (accumulate) atomicAdd(out + (size_t)b * N + cb * 64 + l, s); else out[(size_t)b * N + cb * 64 + l] = s; }
    __syncthreads();
}

__device__ __forceinline__ int headperm(int d, int wc) { return 128 * (d >> 5) + 32 * wc + (d & 31); }
__device__ __forceinline__ int dest_win(int c) {
    if (c < 2048) { const int seg = c >> 9, hc = c & 511, h = hc >> 6, d = hc & 63; return (2 * seg + (h >> 2)) * 256 + headperm(d, h & 3); }
    if (c < 2112) { const int d = c - 2048; return 8 * 256 + headperm(d, 0); }
    if (c < 2120) return 8 * 256 + 128 + 32 + (c - 2112);
    if (c < 2504) return 9 * 256 + (c - 2120);
    if (c < 2760) return 11 * 256 + (c - 2504);
    if (c < 2792) return 8 * 256 + 32 + (c - 2760);
    if (c < 3816) return 12 * 256 + (c - 2792);
    return 16 * 256 + (c - 3816);
}
__device__ __forceinline__ int dest_qup(int c) {
    const int h = c / 96, dd = c % 96;
    if (dd < 64) return (h >> 2) * 256 + headperm(dd, h & 3);
    return 512 + 128 * (h & 1) + 32 * (h >> 1) + (dd - 64);
}
__device__ __forceinline__ int dest_kvup(int c) {
    const int h = c >> 7, dd = c & 127;
    return ((dd >> 6) * 2 + (h >> 2)) * 256 + headperm(dd & 63, h & 3);
}
template <int MODE>
__device__ __forceinline__ void transpose_item(const float* W, int K, int N, bf16_t* WT, const float* kscale, LAS float* scr, int item, int lane) {
    const int nblk = (N + 31) / 32, kb = item / nblk, nb = item % nblk, k0 = 64 * kb, n0 = 32 * nb;
#pragma unroll 8
    for (int i = 0; i < 32; ++i) {
        const int kk = 2 * i + (lane >> 5), n = n0 + (lane & 31);
        float v = (n < N) ? W[(size_t)(k0 + kk) * N + n] : 0.f;
        if (kscale) v *= kscale[k0 + kk];
        scr[kk * 33 + (lane & 31)] = v;
    }
    LDS_WAIT(); asm volatile("" ::: "memory");
    const int c = lane & 7;
#pragma unroll
    for (int j = 0; j < 4; ++j) {
        const int nn = (lane >> 3) + 8 * j, n = n0 + nn;
        if (n < N) {
            const LAS float* s = scr + (8 * c) * 33 + nn;
            u32x4 o; o.x = cvtpk_s(s[0 * 33], s[1 * 33]); o.y = cvtpk_s(s[2 * 33], s[3 * 33]); o.z = cvtpk_s(s[4 * 33], s[5 * 33]); o.w = cvtpk_s(s[6 * 33], s[7 * 33]);
            const int d = (MODE == 0) ? n : (MODE == 1) ? dest_win(n) : (MODE == 2) ? dest_qup(n) : dest_kvup(n);
            *(u32x4*)(WT + (size_t)d * K + k0 + 8 * c) = o;
        }
    }
    LDS_WAIT(); asm volatile("" ::: "memory");
}
__device__ __forceinline__ void cvt_bf16_stream(const float* src, bf16_t* dst, size_t n, size_t gtid, size_t gthreads) {
    for (size_t i = gtid * 8; i < n; i += gthreads * 8) {
        const f32x4 a = *(const f32x4*)(src + i), b = *(const f32x4*)(src + i + 4);
        u32x4 o; o.x = cvtpk_s(a.x, a.y); o.y = cvtpk_s(a.z, a.w); o.z = cvtpk_s(b.x, b.y); o.w = cvtpk_s(b.z, b.w);
        *(u32x4*)(dst + i) = o;
    }
}
__device__ __forceinline__ void cvt_fp4_rows(const float* src, unsigned char* dst, float* inv, int nrows, int gw, int NGW, int lane) {
    for (int row = gw; row < nrows; row += NGW) {
        const f32x4* p = (const f32x4*)(src + (size_t)row * DM) + 4 * lane;
        f32x4 v[4]; float am = 0.f;
#pragma unroll
        for (int j = 0; j < 4; ++j) { v[j] = p[j]; am = __builtin_fmaxf(am, __builtin_fmaxf(__builtin_fmaxf(fabsf(v[j].x), fabsf(v[j].y)), __builtin_fmaxf(fabsf(v[j].z), fabsf(v[j].w)))); }
#pragma unroll
        for (int o = 1; o < 64; o <<= 1) am = __builtin_fmaxf(am, __shfl_xor(am, o));
        am = __builtin_fmaxf(am, 1e-30f);
        const float sc = 6.f / am;
        if (lane == 0) inv[row] = am * (1.f / 6.f);
        unsigned w0 = 0u, w1 = 0u;
        w0 = __builtin_amdgcn_cvt_scalef32_pk_fp4_f32(w0, v[0].x * sc, v[0].y * sc, 1.0f, 0); w0 = __builtin_amdgcn_cvt_scalef32_pk_fp4_f32(w0, v[0].z * sc, v[0].w * sc, 1.0f, 1);
        w0 = __builtin_amdgcn_cvt_scalef32_pk_fp4_f32(w0, v[1].x * sc, v[1].y * sc, 1.0f, 2); w0 = __builtin_amdgcn_cvt_scalef32_pk_fp4_f32(w0, v[1].z * sc, v[1].w * sc, 1.0f, 3);
        w1 = __builtin_amdgcn_cvt_scalef32_pk_fp4_f32(w1, v[2].x * sc, v[2].y * sc, 1.0f, 0); w1 = __builtin_amdgcn_cvt_scalef32_pk_fp4_f32(w1, v[2].z * sc, v[2].w * sc, 1.0f, 1);
        w1 = __builtin_amdgcn_cvt_scalef32_pk_fp4_f32(w1, v[3].x * sc, v[3].y * sc, 1.0f, 2); w1 = __builtin_amdgcn_cvt_scalef32_pk_fp4_f32(w1, v[3].z * sc, v[3].w * sc, 1.0f, 3);
        *((u32x2*)(dst + (size_t)row * (DM / 2)) + lane) = (u32x2){w0, w1};
    }
}
__device__ __forceinline__ void cvt_i4_rows(const float* src, unsigned char* dst, float* inv, int nrows, int gw, int NGW, int lane) {
    for (int row = gw; row < nrows; row += NGW) {
        const f32x4* p = (const f32x4*)(src + (size_t)row * DM) + 4 * lane;
        f32x4 v[4]; float am = 0.f;
#pragma unroll
        for (int j = 0; j < 4; ++j) { v[j] = p[j]; am = __builtin_fmaxf(am, __builtin_fmaxf(__builtin_fmaxf(fabsf(v[j].x), fabsf(v[j].y)), __builtin_fmaxf(fabsf(v[j].z), fabsf(v[j].w)))); }
#pragma unroll
        for (int o = 1; o < 64; o <<= 1) am = __builtin_fmaxf(am, __shfl_xor(am, o));
        am = __builtin_fmaxf(am, 1e-30f);
        const float sc = 9.5f / am;
        if (lane == 0) inv[row] = am * (1.f / 9.5f);
        unsigned w[2] = {0u, 0u};
#pragma unroll
        for (int j = 0; j < 4; ++j) {
#pragma unroll
            for (int e = 0; e < 4; ++e) { const float x = __builtin_amdgcn_fmed3f(__builtin_rintf(v[j][e] * sc), -7.f, 7.f); w[j >> 1] |= ((unsigned)(int)x & 15u) << (4 * (4 * (j & 1) + e)); }
        }
        *((u32x2*)(dst + (size_t)row * (DM / 2)) + lane) = (u32x2){w[0], w[1]};
    }
}
__device__ __forceinline__ void rope_cs(int pos, int i, int half, float& c, float& s) {
    const float inv = (float)exp(-9.210340371976184 * (double)i / (double)half);
    const float ang = (float)pos * inv;
    double x = (double)ang * 0.15915494309189535;
    x -= rint(x);
    const float xf = (float)x;
    c = __builtin_amdgcn_cosf(xf); s = __builtin_amdgcn_sinf(xf);
}

__device__ __forceinline__ void phase0(Frame& F) {
    const int gw = F.bid * NWAVES + F.wave, NGW = F.G * NWAVES;
    unsigned char* ws = F.ws;
    for (int cb = F.G - 1 - F.bid; cb < 96; cb += F.G) gemv8_block(F.in[IN_C], DM, true, F.in[IN_WADA], 6144, (float*)(ws + WS_MOD), F.in[IN_BADA], cb, (LAS float*)(F.lds + 8 * 16384), F.wave, F.lane, F.tid);
    { const size_t gt = (size_t)F.bid * NTHREADS + F.tid, gn = (size_t)F.G * NTHREADS; u32x4* z = (u32x4*)(ws + WS_SSQ_CQ);
      for (size_t i = gt; i < (WS_MOD - WS_SSQ_CQ) / 16; i += gn) z[i] = (u32x4){0u, 0u, 0u, 0u};
      for (size_t i = gt; i < (size_t)NB * 2048 / 4; i += gn) ((u32x4*)(ws + WS_BIASQ))[i] = (u32x4){0u, 0u, 0u, 0u};
      for (size_t i = gt; i < 3456; i += gn) ((unsigned*)(ws + WS_BAR))[i] = 0u;
    }
}
__device__ __forceinline__ void phase0b(Frame& F) {
    const int gw = F.bid * NWAVES + F.wave, NGW = F.G * NWAVES; (void)gw; (void)NGW;
    unsigned char* ws = F.ws;
    LAS float* scr = (LAS float*)(F.lds + F.wave * 16384);
    constexpr int I_WIN = 16 * 152, I_QUP = 6 * 24, I_KVUP = 4 * 32, I_OA = 8 * 32, I_OUT = 16 * 32, I_PQ = 16 * 64;
    constexpr int NITEMS = I_WIN + I_QUP + I_KVUP + 2 * I_OA + I_OUT + I_PQ;
    const int ntw_ = F.G; const bool tr_wg = true;
    for (int it = F.bid * NWAVES + F.wave; tr_wg && it < NITEMS; it += ntw_ * NWAVES) {
        int r = it;
        if (r < I_WIN) { transpose_item<1>(F.in[IN_WIN], DM, IN_WIDTH, (bf16_t*)(ws + WS_WIN), nullptr, scr, r, F.lane); continue; } r -= I_WIN;
        if (r < I_QUP) { transpose_item<2>(F.in[IN_WMQUP], QRANK, 768, (bf16_t*)(ws + WS_WQUP), F.in[IN_GMQA], scr, r, F.lane); continue; } r -= I_QUP;
        if (r < I_KVUP) { transpose_item<3>(F.in[IN_WMKVUP], KVRANK, 1024, (bf16_t*)(ws + WS_WKVUP), F.in[IN_GMKVA], scr, r, F.lane); continue; } r -= I_KVUP;
        if (r < I_OA) { transpose_item<0>(F.in[IN_WOA], AW, DM, (bf16_t*)(ws + WS_WOA), nullptr, scr, r, F.lane); continue; } r -= I_OA;
        if (r < I_OA) { transpose_item<0>(F.in[IN_WOM], AW, DM, (bf16_t*)(ws + WS_WOM), nullptr, scr, r, F.lane); continue; } r -= I_OA;
        if (r < I_OUT) { transpose_item<0>(F.in[IN_WOUT], DM, DM, (bf16_t*)(ws + WS_WOUT), nullptr, scr, r, F.lane); continue; } r -= I_OUT;
        transpose_item<0>(F.in[IN_WPQ], DM, 2048, (bf16_t*)(ws + WS_WPQ), nullptr, scr, r, F.lane);
    }
    const size_t gtid = (size_t)F.bid * NTHREADS + F.tid, gth = (size_t)F.G * NTHREADS;
    cvt_bf16_stream(F.in[IN_SUBK], (bf16_t*)(ws + WS_SUBK), (size_t)16 * 128 * 128, gtid, gth);
    const int* pos = (const int*)F.in[IN_POS];
    float* r32 = (float*)(ws + WS_ROPE32); float* r16 = (float*)(ws + WS_ROPE16);
    for (size_t e = gtid; e < (size_t)T * 48; e += gth) {
        const int t = (int)(e / 48), i = (int)(e % 48); const int p = pos[t]; float c, s;
        if (i < 32) { rope_cs(p, i, 32, c, s); r32[(size_t)t * 64 + i] = c; r32[(size_t)t * 64 + 32 + i] = s; }
        else { rope_cs(p, i - 32, 16, c, s); r16[(size_t)t * 32 + (i - 32)] = c; r16[(size_t)t * 32 + 16 + (i - 32)] = s; }
    }
}

__device__ __forceinline__ float wave_sum(float v) {
#pragma unroll
    for (int o = 1; o < 64; o <<= 1) v += __shfl_xor(v, o);
    return v;
}
__device__ __forceinline__ void phase1(Frame& F) {
    phase0b(F);
    __syncthreads();
    const int gw = F.bid * NWAVES + F.wave, NGW = F.G * NWAVES;
    const float* mod = (const float*)(F.ws + WS_MOD);
    for (int tk = F.G - 1 - F.bid; tk < 64; tk += F.G) gemv8_block(mod + 3072, 6144, false, F.in[IN_WPQ], 2048, (float*)(F.ws + WS_BIASQ), nullptr, tk & 31, (LAS float*)F.lds, F.wave, F.lane, F.tid, (tk >> 5) * 512, 1, true);
    const float* g1 = F.in[IN_G1];
    bf16_t* XN = (bf16_t*)(F.ws + WS_XN);
    for (int m0 = 2 * gw; m0 < T; m0 += 2 * NGW) {
        f32x4 v[2][4]; float s[2] = {0.f, 0.f};
#pragma unroll
        for (int u = 0; u < 2; ++u) { const f32x4* xr = (const f32x4*)(F.in[IN_X] + (size_t)(m0 + u) * DM) + F.lane;
#pragma unroll
            for (int j = 0; j < 4; ++j) v[u][j] = xr[64 * j]; }
#pragma unroll
        for (int u = 0; u < 2; ++u)
#pragma unroll
            for (int j = 0; j < 4; ++j) s[u] += (v[u][j].x * v[u][j].x + v[u][j].y * v[u][j].y) + (v[u][j].z * v[u][j].z + v[u][j].w * v[u][j].w);
#pragma unroll
        for (int u = 0; u < 2; ++u) {
            const int m = m0 + u, b = m / SEQ;
            const float rinv = __builtin_amdgcn_rsqf(wave_sum(s[u]) * (1.f / DM) + EPS);
            unsigned long long* o8 = (unsigned long long*)(XN + (size_t)m * DM) + F.lane;
#pragma unroll
            for (int j = 0; j < 4; ++j) {
                const int col = 4 * F.lane + 256 * j;
                const f32x4 g = *(const f32x4*)(g1 + col), sh = *(const f32x4*)(mod + (size_t)b * 6144 + col), sc = *(const f32x4*)(mod + (size_t)b * 6144 + 1024 + col);
                const f32x4 h = v[u][j] * rinv * g * (sc + 1.0f) + sh;
                o8[64 * j] = (unsigned long long)cvtpk_s(h.x, h.y) | ((unsigned long long)cvtpk_s(h.z, h.w) << 32);
            }
        }
    }
}

__device__ __forceinline__ u32x2 pk4(const f32x4 v) { u32x2 o; o.x = cvtpk_s(v.x, v.y); o.y = cvtpk_s(v.z, v.w); return o; }
__device__ __forceinline__ void st8(bf16_t* grp, const u32x2 X, const u32x2 Y, int fq) {
    auto r0 = __builtin_amdgcn_permlane16_swap(X.x, Y.x, false, false); auto r1 = __builtin_amdgcn_permlane16_swap(X.y, Y.y, false, false);
    *(u32x4*)(grp + 8 * (fq >> 1) + 16 * (fq & 1)) = (u32x4){r0[0], r1[0], r0[1], r1[1]};
}
__device__ __forceinline__ void ld8(const bf16_t* grp, u32x2& X, u32x2& Y, int fq) {
    const u32x4 w = *(const u32x4*)(grp + 8 * (fq >> 1) + 16 * (fq & 1));
    auto r0 = __builtin_amdgcn_permlane16_swap(w[0], w[2], false, false); auto r1 = __builtin_amdgcn_permlane16_swap(w[1], w[3], false, false);
    X = (u32x2){r0[0], r1[0]}; Y = (u32x2){r0[1], r1[1]};
}
__device__ __forceinline__ float sum4sq(const f32x4 v) { return (v.x * v.x + v.y * v.y) + (v.z * v.z + v.w * v.w); }
__device__ __forceinline__ float fq_sum(float s) {
    { auto r = __builtin_amdgcn_permlane16_swap(__float_as_uint(s), __float_as_uint(s), false, false); s = __uint_as_float(r[0]) + __uint_as_float(r[1]); }
    { auto r = __builtin_amdgcn_permlane32_swap(__float_as_uint(s), __float_as_uint(s), false, false); s = __uint_as_float(r[0]) + __uint_as_float(r[1]); }
    return s;
}

struct EpiIn {
    unsigned char* ws; const float* gaq; const float* gak; const float* gidxk; const float* gmk;
    template <bool NORM>
    __device__ __forceinline__ void normrope64(const f32x4 (&acc)[2][2][4][2], int row0, int fq, const float* gain, float scale, bf16_t* dst, int pitch, int colbase) const {
        const float* rope = (const float*)(ws + WS_ROPE32);
        f32x4 gv[2][2];
#pragma unroll
        for (int bj = 0; bj < 2; ++bj)
#pragma unroll
            for (int n = 0; n < 2; ++n) gv[bj][n] = NORM ? *(const f32x4*)(gain + 32 * bj + 16 * n + 4 * fq) * scale : (f32x4){scale, scale, scale, scale};
#pragma unroll
        for (int ai = 0; ai < 2; ++ai)
#pragma unroll
            for (int m = 0; m < 4; ++m) {
                const int row = row0 + 128 * ai + 16 * m;
                float rinv = 1.f;
                if (NORM) {
                    float s = 0.f;
#pragma unroll
                    for (int bj = 0; bj < 2; ++bj)
#pragma unroll
                        for (int n = 0; n < 2; ++n) s += sum4sq(acc[ai][bj][m][n]);
                    rinv = __builtin_amdgcn_rsqf(fq_sum(s) * (1.f / 64.f) + EPS);
                }
                bf16_t* o = dst + (size_t)row * pitch + colbase; u32x2 lo[2], hi[2];
#pragma unroll
                for (int n = 0; n < 2; ++n) {
                    const f32x4 cs = *(const f32x4*)(rope + (size_t)row * 64 + 16 * n + 4 * fq), sn = *(const f32x4*)(rope + (size_t)row * 64 + 32 + 16 * n + 4 * fq);
                    const f32x4 x1 = acc[ai][0][m][n] * rinv * gv[0][n], x2 = acc[ai][1][m][n] * rinv * gv[1][n];
                    lo[n] = pk4(x1 * cs - x2 * sn); hi[n] = pk4(x2 * cs + x1 * sn);
                }
                st8(o, lo[0], lo[1], fq); st8(o + 32, hi[0], hi[1], fq);
                asm volatile("" ::: "memory");
            }
    }
    __device__ __forceinline__ void operator()(const f32x4 (&acc)[2][2][4][2], const pg8::Unit& u, int wr, int wc, int fr, int fq) const {
        const int pn = u.pn, row0 = u.pm * 256 + wr * 64 + fr;
        if (pn < 2) { normrope64<true>(acc, row0, fq, gaq, C2A, (bf16_t*)(ws + WS_QA), AW, ((pn & 1) * 4 + wc) * 64); return; }
        if (pn < 4) { normrope64<true>(acc, row0, fq, gak, 1.f, (bf16_t*)(ws + WS_KA), AW, ((pn & 1) * 4 + wc) * 64); return; }
        if (pn < 6) {
            bf16_t* dst = (bf16_t*)(ws + WS_VA);
#pragma unroll
            for (int ai = 0; ai < 2; ++ai)
#pragma unroll
                for (int m = 0; m < 4; ++m) { bf16_t* o = dst + (size_t)(row0 + 128 * ai + 16 * m) * AW + ((pn & 1) * 4 + wc) * 64;
#pragma unroll
                    for (int bj = 0; bj < 2; ++bj) st8(o + 32 * bj, pk4(acc[ai][bj][m][0]), pk4(acc[ai][bj][m][1]), fq); asm volatile("" ::: "memory"); }
            return;
        }
        if (pn < 8) { normrope64<false>(acc, row0, fq, nullptr, 1.f, (bf16_t*)(ws + WS_QI), AW, ((pn & 1) * 4 + wc) * 64); return; }
        if (pn == 8) {
            if (wc == 0) { normrope64<true>(acc, row0, fq, gidxk, 1.f, (bf16_t*)(ws + WS_KI), 64, 0); return; }
            if (wc == 1) {
                const float* rope = (const float*)(ws + WS_ROPE16);
                float* kper = (float*)(ws + WS_KPER); float* kss = (float*)(ws + WS_KPESSQ); float* wi = (float*)(ws + WS_WI);
                const f32x4 g1 = *(const f32x4*)(gmk + 64 + 4 * fq), g2 = *(const f32x4*)(gmk + 80 + 4 * fq);
#pragma unroll
                for (int ai = 0; ai < 2; ++ai)
#pragma unroll
                    for (int m = 0; m < 4; ++m) {
                        const int row = row0 + 128 * ai + 16 * m;
                        const f32x4 a = acc[ai][0][m][0], b = acc[ai][0][m][1];
                        const float s = fq_sum(sum4sq(a) + sum4sq(b));
                        if (fq == 0) kss[row] = s;
                        const f32x4 cs = *(const f32x4*)(rope + (size_t)row * 32 + 4 * fq), sn = *(const f32x4*)(rope + (size_t)row * 32 + 16 + 4 * fq);
                        const f32x4 x1 = a * g1, x2 = b * g2;
                        *(f32x4*)(kper + (size_t)row * 32 + 4 * fq) = x1 * cs - x2 * sn;
                        *(f32x4*)(kper + (size_t)row * 32 + 16 + 4 * fq) = x2 * cs + x1 * sn;
                        if (fq < 2) *(f32x4*)(wi + (size_t)row * 8 + 4 * fq) = acc[ai][1][m][0] * 0.044194173824159216f;
                        asm volatile("" ::: "memory");
                    }
            }
            return;
        }
        if (pn < 12) {
            const bool isq = pn < 11; const int cb = isq ? (pn - 9) * 256 : 0, width = isq ? QRANK : KVRANK;
            bf16_t* dst = (bf16_t*)(ws + (isq ? WS_CQ : WS_CKV)); float* ssq = (float*)(ws + (isq ? WS_SSQ_CQ : WS_SSQ_CKV));
#pragma unroll
            for (int ai = 0; ai < 2; ++ai)
#pragma unroll
                for (int m = 0; m < 4; ++m) {
                    const int row = row0 + 128 * ai + 16 * m; float s = 0.f;
#pragma unroll
                    for (int bj = 0; bj < 2; ++bj) { const int col = cb + 128 * bj + 32 * wc;
                        if (col < width) { st8(dst + (size_t)row * width + col, pk4(acc[ai][bj][m][0]), pk4(acc[ai][bj][m][1]), fq); s += sum4sq(acc[ai][bj][m][0]) + sum4sq(acc[ai][bj][m][1]); } }
                    s = fq_sum(s);
                    if (fq == 0) atomicAdd(ssq + row, s);
                    asm volatile("" ::: "memory");
                }
            return;
        }
        {
            bf16_t* dst = (bf16_t*)(ws + (pn < 16 ? WS_GA : WS_GM)); const int cb = ((pn - 12) & 3) * 256 + 32 * wc;
#pragma unroll
            for (int ai = 0; ai < 2; ++ai)
#pragma unroll
                for (int m = 0; m < 4; ++m) { bf16_t* o = dst + (size_t)(row0 + 128 * ai + 16 * m) * DM + cb;
#pragma unroll
                    for (int bj = 0; bj < 2; ++bj) { const f32x4 v = acc[ai][bj][m][0], w = acc[ai][bj][m][1];
                        st8(o + 128 * bj, pk4((f32x4){sigmoidf_(v.x), sigmoidf_(v.y), sigmoidf_(v.z), sigmoidf_(v.w)}), pk4((f32x4){sigmoidf_(w.x), sigmoidf_(w.y), sigmoidf_(w.z), sigmoidf_(w.w)}), fq); } asm volatile("" ::: "memory"); }
        }
    }
};

struct EpiQup {
    unsigned char* ws; const float* gmq;
    __device__ __forceinline__ void operator()(const f32x4 (&acc)[2][2][4][2], const pg8::Unit& u, int wr, int wc, int fr, int fq) const {
        const int pn = u.pn, row0 = u.pm * 256 + wr * 64 + fr;
        const float* ssqc = (const float*)(ws + WS_SSQ_CQ); float* ssqm = (float*)(ws + WS_SSQ_QM);
        if (pn < 2) {
            const int head = pn * 4 + wc; bf16_t* dst = (bf16_t*)(ws + WS_QMN);
            f32x4 gv[2][2];
#pragma unroll
            for (int bj = 0; bj < 2; ++bj)
#pragma unroll
                for (int n = 0; n < 2; ++n) gv[bj][n] = *(const f32x4*)(gmq + 32 * bj + 16 * n + 4 * fq) * C2B;
#pragma unroll
            for (int ai = 0; ai < 2; ++ai)
#pragma unroll
                for (int m = 0; m < 4; ++m) {
                    const int row = row0 + 128 * ai + 16 * m;
                    const float rc = __builtin_amdgcn_rsqf(ssqc[row] * (1.f / QRANK) + EPS);
                    float s = 0.f; bf16_t* o = dst + (size_t)row * 512 + head * 64;
#pragma unroll
                    for (int bj = 0; bj < 2; ++bj) { const f32x4 q0 = acc[ai][bj][m][0] * rc, q1 = acc[ai][bj][m][1] * rc; s += sum4sq(q0) + sum4sq(q1); st8(o + 32 * bj, pk4(q0 * gv[bj][0]), pk4(q1 * gv[bj][1]), fq); }
                    s = fq_sum(s);
                    if (fq == 0) atomicAdd(ssqm + (size_t)row * 8 + head, s);
                    asm volatile("" ::: "memory");
                }
            return;
        }
        {
            const float* rope = (const float*)(ws + WS_ROPE16); bf16_t* dst = (bf16_t*)(ws + WS_QMR);
            const f32x4 g1 = *(const f32x4*)(gmq + 64 + 4 * fq) * C2B, g2 = *(const f32x4*)(gmq + 80 + 4 * fq) * C2B;
#pragma unroll
            for (int ai = 0; ai < 2; ++ai)
#pragma unroll
                for (int m = 0; m < 4; ++m) {
                    const int row = row0 + 128 * ai + 16 * m;
                    const float rc = __builtin_amdgcn_rsqf(ssqc[row] * (1.f / QRANK) + EPS);
                    const f32x4 cs = *(const f32x4*)(rope + (size_t)row * 32 + 4 * fq), sn = *(const f32x4*)(rope + (size_t)row * 32 + 16 + 4 * fq);
#pragma unroll
                    for (int bj = 0; bj < 2; ++bj) {
                        const int head = 2 * wc + bj;
                        const f32x4 a = acc[ai][bj][m][0] * rc, b = acc[ai][bj][m][1] * rc;
                        const float s = fq_sum(sum4sq(a) + sum4sq(b));
                        if (fq == 0) atomicAdd(ssqm + (size_t)row * 8 + head, s);
                        const f32x4 x1 = a * g1, x2 = b * g2;
                        st8(dst + (size_t)row * 256 + head * 32, pk4(x1 * cs - x2 * sn), pk4(x2 * cs + x1 * sn), fq);
                    }
                    asm volatile("" ::: "memory");
                }
        }
    }
};
struct EpiKVup {
    unsigned char* ws; const float* gmk;
    __device__ __forceinline__ void operator()(const f32x4 (&acc)[2][2][4][2], const pg8::Unit& u, int wr, int wc, int fr, int fq) const {
        const int pn = u.pn, row0 = u.pm * 256 + wr * 64 + fr, head = (pn & 1) * 4 + wc;
        const float* ssqc = (const float*)(ws + WS_SSQ_CKV);
        if (pn < 2) {
            const float* kss = (const float*)(ws + WS_KPESSQ); const float* kper = (const float*)(ws + WS_KPER);
            bf16_t* dn = (bf16_t*)(ws + WS_KMN); bf16_t* dr = (bf16_t*)(ws + WS_KMR);
            f32x4 gv[2][2];
#pragma unroll
            for (int bj = 0; bj < 2; ++bj)
#pragma unroll
                for (int n = 0; n < 2; ++n) gv[bj][n] = *(const f32x4*)(gmk + 32 * bj + 16 * n + 4 * fq);
#pragma unroll
            for (int ai = 0; ai < 2; ++ai)
#pragma unroll
                for (int m = 0; m < 4; ++m) {
                    const int row = row0 + 128 * ai + 16 * m;
                    const float rc = __builtin_amdgcn_rsqf(ssqc[row] * (1.f / KVRANK) + EPS);
                    float s = 0.f; f32x4 kn[2][2];
#pragma unroll
                    for (int bj = 0; bj < 2; ++bj)
#pragma unroll
                        for (int n = 0; n < 2; ++n) { kn[bj][n] = acc[ai][bj][m][n] * rc; s += sum4sq(kn[bj][n]); }
                    s = fq_sum(s) + kss[row];
                    const float rinv = __builtin_amdgcn_rsqf(s * (1.f / MQK) + EPS);
                    bf16_t* o = dn + (size_t)row * 512 + head * 64;
#pragma unroll
                    for (int bj = 0; bj < 2; ++bj) st8(o + 32 * bj, pk4(kn[bj][0] * gv[bj][0] * rinv), pk4(kn[bj][1] * gv[bj][1] * rinv), fq);
                    const f32x4 ra = *(const f32x4*)(kper + (size_t)row * 32 + 8 * fq) * rinv, rb = *(const f32x4*)(kper + (size_t)row * 32 + 8 * fq + 4) * rinv;
                    u32x4 w; w.x = cvtpk_s(ra.x, ra.y); w.y = cvtpk_s(ra.z, ra.w); w.z = cvtpk_s(rb.x, rb.y); w.w = cvtpk_s(rb.z, rb.w);
                    *(u32x4*)(dr + (size_t)row * 256 + head * 32 + 8 * fq) = w;
                    asm volatile("" ::: "memory");
                }
            return;
        }
        {
            bf16_t* dst = (bf16_t*)(ws + WS_VM);
#pragma unroll
            for (int ai = 0; ai < 2; ++ai)
#pragma unroll
                for (int m = 0; m < 4; ++m) {
                    const int row = row0 + 128 * ai + 16 * m;
                    const float rc = __builtin_amdgcn_rsqf(ssqc[row] * (1.f / KVRANK) + EPS);
                    bf16_t* o = dst + (size_t)row * 512 + head * 64;
#pragma unroll
                    for (int bj = 0; bj < 2; ++bj) st8(o + 32 * bj, pk4(acc[ai][bj][m][0] * rc), pk4(acc[ai][bj][m][1] * rc), fq);
                    asm volatile("" ::: "memory");
                }
        }
    }
};

constexpr int SC_PITCH = 4104, IDX_SC_BYTES = 16 * SC_PITCH * 2, IDX_MW_OFF = IDX_SC_BYTES;
static_assert(IDX_MW_OFF % 16 == 0 && IDX_MW_OFF + 16 * 64 * 8 <= LDS_BYTES, "indexer LDS");
__device__ __forceinline__ int suffix_sum64(int v, int lane) {
#pragma unroll
    for (int o = 1; o < 64; o <<= 1) { const int t = __shfl_down(v, o); v += (lane + o < 64) ? t : 0; }
    return v;
}
__device__ __forceinline__ void radix_level(LAS unsigned* hist, int lane, int want, int& bsel, int& cabove) {
    u32x4 c = *(const LAS u32x4*)(hist + 4 * lane);
#pragma unroll
    for (int k = 1; k < 4; ++k) c += *(const LAS u32x4*)(hist + 256 * k + 4 * lane);
#pragma unroll
    for (int k = 0; k < 4; ++k) *(LAS u32x4*)(hist + 256 * k + 4 * lane) = (u32x4){0u, 0u, 0u, 0u};
    const int s = (int)(c.x + c.y + c.z + c.w), S = suffix_sum64(s, lane);
    int above = S - s, b = -1, ca = 0;
    if (above < want && S >= want) {
        if (above + (int)c.w >= want) { b = 4 * lane + 3; ca = above; }
        else if (above + (int)(c.w + c.z) >= want) { b = 4 * lane + 2; ca = above + (int)c.w; }
        else if (above + (int)(c.w + c.z + c.y) >= want) { b = 4 * lane + 1; ca = above + (int)(c.w + c.z); }
        else { b = 4 * lane; ca = above + (int)(c.w + c.z + c.y); }
    }
    const unsigned long long m = __builtin_amdgcn_ballot_w64(b >= 0);
    const int src = (int)__builtin_ctzll(m | (1ull << 63));
    bsel = __builtin_amdgcn_readlane(b, src); cabove = __builtin_amdgcn_readlane(ca, src);
}
__device__ __forceinline__ void indexer_phase(Frame& F) {
    const bf16_t* QI = (const bf16_t*)(F.ws + WS_QI); const bf16_t* KI = (const bf16_t*)(F.ws + WS_KI); const float* WI = (const float*)(F.ws + WS_WI);
    unsigned long long* MASK = (unsigned long long*)(F.ws + WS_MASK);
    LAS unsigned short* SC = (LAS unsigned short*)F.lds;
    LAS unsigned long long* MW = (LAS unsigned long long*)(F.lds + IDX_MW_OFF);
    const int lane = F.lane, wid = F.wave;
    for (int item = F.bid; item < NB * 256; item += F.G) {
        int lq = lane; asm volatile("" : "+v"(lq)); const int q = lq & 15, kq = lq >> 4;
        const int b = item >> 8, gi = item & 255, g = (b & 1) ? 255 - gi : gi, t0 = 16 * g, nkt = g + 1;
        const size_t rowq = (size_t)b * SEQ + t0 + q;
        bf16x8 bq[8][2]; float wv[8];
#pragma unroll
        for (int h = 0; h < 8; ++h) {
#pragma unroll
            for (int ks = 0; ks < 2; ++ks) bq[h][ks] = *(const bf16x8*)(QI + rowq * 512 + h * 64 + 32 * ks + 8 * kq);
            wv[h] = WI[rowq * 8 + h];
        }
        const bf16_t* kbase = KI + ((size_t)b * SEQ + q) * 64 + 8 * kq;
        const int ntw = (nkt - wid + NWAVES - 1) / NWAVES;
        bf16x8 ka[4][2], kn[4][2];
#define IDX_KLOAD(u, jj) do { int kt_ = wid + NWAVES * (jj); kt_ = kt_ < nkt ? kt_ : nkt - 1; const bf16_t* kp = kbase + (size_t)16 * kt_ * 64; kn[u][0] = *(const bf16x8*)kp; kn[u][1] = *(const bf16x8*)(kp + 32); } while (0)
#define IDX_TILE(u, jj) do { const int kt = wid + NWAVES * (jj); \
                f32x4 sc = (f32x4){0.f, 0.f, 0.f, 0.f}; \
                _Pragma("unroll") for (int h = 0; h < 8; ++h) { \
                    f32x4 c = __builtin_amdgcn_mfma_f32_16x16x32_bf16(ka[u][0], bq[h][0], (f32x4){0.f, 0.f, 0.f, 0.f}, 0, 0, 0); \
                    c = __builtin_amdgcn_mfma_f32_16x16x32_bf16(ka[u][1], bq[h][1], c, 0, 0, 0); \
                    _Pragma("unroll") for (int i = 0; i < 4; ++i) sc[i] += __builtin_amdgcn_fmed3f(c[i], 0.f, 3.0e38f) * wv[h]; } \
                unsigned short kk[4]; \
                _Pragma("unroll") for (int i = 0; i < 4; ++i) { const _Float16 hsc = (_Float16)(sc[i] + 0.0f); const unsigned short bits = __builtin_bit_cast(unsigned short, hsc); \
                    kk[i] = (bits & 0x8000u) ? (unsigned short)~bits : (unsigned short)(bits | 0x8000u); } \
                u32x2 w; w.x = (unsigned)kk[0] | ((unsigned)kk[1] << 16); w.y = (unsigned)kk[2] | ((unsigned)kk[3] << 16); \
                *(LAS u32x2*)(SC + q * SC_PITCH + 16 * kt + 4 * kq) = w; } while (0)
#pragma unroll
        for (int u = 0; u < 4; ++u) IDX_KLOAD(u, u);
        for (int j0 = 0; j0 < ntw; j0 += 4) {
#pragma unroll
            for (int u = 0; u < 4; ++u) { ka[u][0] = kn[u][0]; ka[u][1] = kn[u][1]; }
#pragma unroll
            for (int u = 0; u < 4; ++u) IDX_KLOAD(u, j0 + 4 + u);
            if (j0 + 4 <= ntw) { IDX_TILE(0, j0); IDX_TILE(1, j0 + 1); IDX_TILE(2, j0 + 2); IDX_TILE(3, j0 + 3); }
            else { IDX_TILE(0, j0); if (j0 + 1 < ntw) IDX_TILE(1, j0 + 1); if (j0 + 2 < ntw) IDX_TILE(2, j0 + 2); }
        }
#undef IDX_KLOAD
#undef IDX_TILE
        __syncthreads();
#pragma unroll 1
        for (int qi = 0; qi < 2; ++qi) {
            const int qq = 2 * wid + qi, t = t0 + qq, nr = (t >> 6) + 1;
            unsigned key[64];
#pragma unroll
            for (int r = 0; r < 64; ++r) { const int s = 64 * r + lane; key[r] = (r < nr && s <= t) ? (unsigned)SC[qq * SC_PITCH + s] : 0u; }
            unsigned thr = 0u; int need = 0;
            LAS unsigned* hist = (LAS unsigned*)(SC + qq * SC_PITCH);
            if (t + 1 > NSEL) {
                LDS_WAIT();
#pragma unroll
                for (int k = 0; k < 4; ++k) *(LAS u32x4*)(hist + 256 * k + 4 * lane) = (u32x4){0u, 0u, 0u, 0u};
                LAS unsigned* hmine = hist + 256 * (lane & 3);
#pragma unroll
                for (int r8 = 0; r8 < 8; ++r8) if (8 * r8 < nr) {
#pragma unroll
                    for (int r = 8 * r8; r < 8 * r8 + 8; ++r) if (key[r] != 0u) __hip_atomic_fetch_add(hmine + (key[r] >> 8), 1u, __ATOMIC_RELAXED, __HIP_MEMORY_SCOPE_WORKGROUP);
                }
                LDS_WAIT();
                int bh, ca_h; radix_level(hist, lane, NSEL, bh, ca_h);
                LDS_WAIT();
#pragma unroll
                for (int r8 = 0; r8 < 8; ++r8) if (8 * r8 < nr) {
#pragma unroll
                    for (int r = 8 * r8; r < 8 * r8 + 8; ++r) if ((int)(key[r] >> 8) == bh) __hip_atomic_fetch_add(hmine + (key[r] & 255u), 1u, __ATOMIC_RELAXED, __HIP_MEMORY_SCOPE_WORKGROUP);
                }
                LDS_WAIT();
                int bl, ca_l; radix_level(hist, lane, NSEL - ca_h, bl, ca_l);
                LDS_WAIT();
                thr = ((unsigned)bh << 8) | (unsigned)bl; need = NSEL - ca_h - ca_l;
            }
            unsigned wlo = 0u, whi = 0u;
#pragma unroll
            for (int r = 0; r < 64; ++r) {
                unsigned long long word = 0ull;
                if (r < nr) {
                    if (t + 1 > NSEL) {
                        const unsigned long long mg = __builtin_amdgcn_ballot_w64(key[r] > thr);
                        unsigned long long me = __builtin_amdgcn_ballot_w64(key[r] == thr);
                        if (me) { const int c = __builtin_popcountll(me);
                            if (c > need) { int drop = c - need; while (drop > 0) { me &= ~(1ull << (63 - __builtin_clzll(me))); --drop; } need = 0; } else need -= c; }
                        word = mg | me;
                    } else word = __builtin_amdgcn_ballot_w64(key[r] != 0u);
                }
                { const unsigned w0_ = (unsigned)word, w1_ = (unsigned)(word >> 32); asm volatile("s_nop 0\n\tv_writelane_b32 %0, %2, %4\n\tv_writelane_b32 %1, %3, %4" : "+v"(wlo), "+v"(whi) : "s"(w0_), "s"(w1_), "n"(r)); }
            }
            MW[qq * 64 + lane] = ((unsigned long long)whi << 32) | wlo;
        }
        __syncthreads();
        for (int i = F.tid; i < 1024; i += NTHREADS) { const int w = i >> 4, qq = i & 15; MASK[((size_t)b * 64 + w) * SEQ + t0 + qq] = MW[qq * 64 + w]; }
        __syncthreads();
    }
}

namespace att {
constexpr int KV = 64, QB = 256;
constexpr int KSLOT = 12288, VSLOT = 8192;
constexpr int NSLOT = 4;
constexpr int L_K = 0, L_V = NSLOT * KSLOT, L_WS = L_V + NSLOT * VSLOT, L_OST = L_WS + NWAVES * 64 * 4, L_BYTES = L_OST + NWAVES * 4096;
static_assert(L_BYTES <= LDS_BYTES, "attention LDS");
__device__ __forceinline__ int crow(int r, int hi) { return (r & 3) + 8 * (r >> 2) + 4 * hi; }
__device__ __forceinline__ float max3f(float a, float b, float c) { float r; asm("v_max3_f32 %0, %1, %2, %3" : "=v"(r) : "v"(a), "v"(b), "v"(c)); return r; }
__device__ __forceinline__ void glds(const void* g, LAS unsigned char* l) { __builtin_amdgcn_global_load_lds((const unsigned*)g, (LAS unsigned*)l, 16, 0, 0); }

template <int MODE>
__device__ __forceinline__ void attn_unit(Frame& F, int b, int h, int qb) {
    constexpr int NCH = MODE ? 12 : 8, ND = NCH / 2;
    const int lane = F.lane, wid = F.wave, r32 = lane & 31, hi = lane >> 5;
    unsigned char* ws = F.ws; LAS unsigned char* lds = F.lds;
    const size_t rowbase = (size_t)b * SEQ; const int q0 = qb * QB;
    const bf16_t* Kn = (const bf16_t*)(ws + (MODE ? WS_KMN : WS_KA)) + rowbase * 512 + h * 64;
    const bf16_t* Kr = (const bf16_t*)(ws + WS_KMR) + rowbase * 256 + h * 32;
    const bf16_t* Vh = (const bf16_t*)(ws + (MODE ? WS_VM : WS_VA)) + rowbase * 512 + h * 64;
    bf16_t* Qn = (bf16_t*)(ws + (MODE ? WS_QMN : WS_QA)) + (rowbase + q0 + wid * 32) * 512 + h * 64;
    const bf16_t* Qr = (const bf16_t*)(ws + WS_QMR) + (rowbase + q0 + wid * 32) * 256 + h * 32;
    LAS float* wsf = (LAS float*)(lds + L_WS) + wid * 64;
    const int NT = (q0 + QB) / KV;
    const bf16_t* ksrc0 = Kn + (size_t)lane * 512 + wid * 8;
    const bf16_t* ksrc1 = Kr + (size_t)lane * 256 + (wid & 3) * 8;
    const bf16_t* vsrc = Vh + (size_t)(16 * (wid & 3) + (lane >> 2)) * 512 + (wid >> 2) * 32 + (lane & 3) * 8;
#define ATT_DMA(t, slot) do { glds(ksrc0 + (size_t)(t) * KV * 512, lds + L_K + (slot) * KSLOT + wid * 1024); \
        if (MODE) glds(ksrc1 + (size_t)(t) * KV * 256, lds + L_K + (slot) * KSLOT + (8 + (wid & 3)) * 1024); \
        glds(vsrc + (size_t)(t) * KV * 512, lds + L_V + (slot) * VSLOT + wid * 1024); } while (0)
    ATT_DMA(0, 0); ATT_DMA(1, 1); ATT_DMA(2, 2);
    bf16x8 qr[ND];
#pragma unroll
    for (int d0 = 0; d0 < 4; ++d0) qr[d0] = *(const bf16x8*)(Qn + (size_t)r32 * 512 + d0 * 16 + hi * 8);
    if (MODE) {
#pragma unroll
        for (int d0 = 4; d0 < ND; ++d0) qr[d0] = *(const bf16x8*)(Qr + (size_t)r32 * 256 + (d0 - 4) * 16 + hi * 8);
        const float rq = __builtin_amdgcn_rsqf(((const float*)(ws + WS_SSQ_QM))[(rowbase + q0 + wid * 32 + r32) * 8 + h] * (1.f / MQK) + EPS);
#pragma unroll
        for (int d0 = 0; d0 < ND; ++d0) {
            u32x4 w = __builtin_bit_cast(u32x4, qr[d0]);
#pragma unroll
            for (int j = 0; j < 4; ++j) w[j] = cvtpk_s(bflo(w[j]) * rq, bfhi(w[j]) * rq);
            qr[d0] = __builtin_bit_cast(bf16x8, w);
        }
    }
    const unsigned long long* mrow = (const unsigned long long*)(ws + WS_MASK) + (size_t)b * 64 * SEQ + q0 + wid * 32 + r32;
    float mref = 0.f; f32x16 o[2]; o[0] = f32x16{}; o[1] = f32x16{};
    float lrun = 0.f;
    f32x16 negm = f32x16{};
    const int qrel = wid * 32 + r32;
    const unsigned vb0 = (unsigned)(uintptr_t)(lds + L_V) + ((lane >> 4) & 1) * 32 + (lane & 3) * 8 + (4 * hi + ((lane & 15) >> 2)) * 64;
    unsigned long long mw = 0ull, mwn = 0ull;
    if (MODE == 0) mwn = mrow[0];
#define ATT_QK(P0, P1, SL) do { const LAS unsigned char* kb = lds + L_K + (SL) * KSLOT + hi * 1024 + r32 * 16; \
        _Pragma("unroll") for (int d0 = 0; d0 < ND; ++d0) { \
            const bf16x8 k0 = *(const LAS bf16x8*)(kb + d0 * 2048), k1 = *(const LAS bf16x8*)(kb + d0 * 2048 + 512); \
            if (d0 == 0) { P0 = __builtin_amdgcn_mfma_f32_32x32x16_bf16(k0, qr[0], negm, 0, 0, 0); P1 = __builtin_amdgcn_mfma_f32_32x32x16_bf16(k1, qr[0], negm, 0, 0, 0); } \
            else { P0 = __builtin_amdgcn_mfma_f32_32x32x16_bf16(k0, qr[d0], P0, 0, 0, 0); P1 = __builtin_amdgcn_mfma_f32_32x32x16_bf16(k1, qr[d0], P1, 0, 0, 0); } } } while (0)
    if (MODE) asm volatile("s_waitcnt vmcnt(3)" ::: "memory"); else asm volatile("s_waitcnt vmcnt(2)" ::: "memory");
    __builtin_amdgcn_s_barrier(); asm volatile("" ::: "memory");
    f32x16 pn0, pn1;
    ATT_QK(pn0, pn1, 0);
    int slot = 0, slot1 = 1, slot3 = 3;
    for (int t = 0; t < NT; ++t) {
        if (t + 2 < NT) { if (MODE) asm volatile("s_waitcnt vmcnt(3)" ::: "memory"); else asm volatile("s_waitcnt vmcnt(2)" ::: "memory"); }
        else asm volatile("s_waitcnt vmcnt(0)" ::: "memory");
        __builtin_amdgcn_s_barrier(); asm volatile("" ::: "memory");
        mw = mwn;
        if (MODE == 0 && t + 1 < NT) mwn = mrow[(size_t)(t + 1) * SEQ];
        if (t + 3 < NT) ATT_DMA(t + 3, slot3);
        f32x16 p0 = pn0, p1 = pn1;
        if (MODE == 1) {
            const int jb = t - (NT - 4);
            if (jb >= 0) { const int kb = 64 * jb + 4 * hi;
#pragma unroll
                for (int r = 0; r < 16; ++r) { const int kv = kb + (r & 3) + 8 * (r >> 2); if (kv > qrel) p0[r] = -INFINITY; if (kv + 32 > qrel) p1[r] = -INFINITY; } }
        }
        asm volatile("s_nop 15\n\ts_nop 7" : "+v"(p0), "+v"(p1));
        float rm = max3f(p0[0], p1[0], p0[1]), rm2 = max3f(p1[1], p0[2], p1[2]);
#pragma unroll
        for (int r = 3; r < 15; r += 2) { rm = max3f(rm, p0[r], p1[r]); rm2 = max3f(rm2, p0[r + 1], p1[r + 1]); }
        rm = max3f(rm, rm2, p0[15]); rm = __builtin_fmaxf(rm, p1[15]);
        { auto rr = __builtin_amdgcn_permlane32_swap(__float_as_uint(rm), __float_as_uint(rm), false, false); rm = __builtin_fmaxf(__uint_as_float(rr[0]), __uint_as_float(rr[1])); }
        if (__any(rm > 0.f) || t == 0) {
            const float dl = (t == 0) ? rm : __builtin_fmaxf(rm, 0.f);
            mref += dl;
#pragma unroll
            for (int r = 0; r < 16; ++r) { p0[r] -= dl; p1[r] -= dl; }
#pragma unroll
            for (int r = 0; r < 16; ++r) negm[r] = -mref;
            const float f = __builtin_amdgcn_exp2f(-dl);
            if (hi == 0) wsf[r32] = f;
            LDS_WAIT();
#pragma unroll
            for (int r = 0; r < 16; ++r) { const float fr = wsf[crow(r, hi)]; o[0][r] *= fr; o[1][r] *= fr; }
            lrun *= f;
        }
        ATT_QK(pn0, pn1, slot1);
#pragma unroll
        for (int r = 0; r < 16; ++r) { p0[r] = __builtin_amdgcn_exp2f(p0[r]); p1[r] = __builtin_amdgcn_exp2f(p1[r]); }
        if (MODE == 0) {
            const unsigned lo = (unsigned)mw >> (4 * hi), hw = (unsigned)(mw >> 32) >> (4 * hi);
#pragma unroll
            for (int r = 0; r < 16; ++r) { const int c = (r & 3) + 8 * (r >> 2);
                p0[r] = __uint_as_float(__float_as_uint(p0[r]) & (unsigned)__builtin_amdgcn_sbfe(lo, c, 1));
                p1[r] = __uint_as_float(__float_as_uint(p1[r]) & (unsigned)__builtin_amdgcn_sbfe(hw, c, 1)); }
        }
        { float sacc = 0.f;
#pragma unroll
          for (int r = 0; r < 16; ++r) sacc += p0[r] + p1[r];
          lrun += sacc; }
        u32x4 pw0, pw1, pw2, pw3;
#pragma unroll
        for (int j = 0; j < 4; ++j) { pw0[j] = cvtpk_s(p0[2 * j], p0[2 * j + 1]); pw1[j] = cvtpk_s(p0[8 + 2 * j], p0[9 + 2 * j]); pw2[j] = cvtpk_s(p1[2 * j], p1[2 * j + 1]); pw3[j] = cvtpk_s(p1[8 + 2 * j], p1[9 + 2 * j]); }
        { const unsigned vb = vb0 + slot * VSLOT;
#pragma unroll
          for (int d0 = 0; d0 < 2; ++d0) { s16x4 lo[4], hh[4];
#pragma unroll
              for (int ks = 0; ks < 4; ++ks) {
                  asm volatile("ds_read_b64_tr_b16 %0,%1 offset:%c2" : "=&v"(lo[ks]) : "v"(vb), "i"(d0 * 4096 + ks * 1024) : "memory");
                  asm volatile("ds_read_b64_tr_b16 %0,%1 offset:%c2" : "=&v"(hh[ks]) : "v"(vb), "i"(d0 * 4096 + ks * 1024 + 512) : "memory"); }
              asm volatile("s_waitcnt lgkmcnt(0)" ::: "memory"); __builtin_amdgcn_sched_barrier(0);
#define ATT_PK(k) (bf16x8){lo[k][0], lo[k][1], lo[k][2], lo[k][3], hh[k][0], hh[k][1], hh[k][2], hh[k][3]}
              o[d0] = __builtin_amdgcn_mfma_f32_32x32x16_bf16(__builtin_bit_cast(bf16x8, pw0), ATT_PK(0), o[d0], 0, 0, 0);
              o[d0] = __builtin_amdgcn_mfma_f32_32x32x16_bf16(__builtin_bit_cast(bf16x8, pw1), ATT_PK(1), o[d0], 0, 0, 0);
              o[d0] = __builtin_amdgcn_mfma_f32_32x32x16_bf16(__builtin_bit_cast(bf16x8, pw2), ATT_PK(2), o[d0], 0, 0, 0);
              o[d0] = __builtin_amdgcn_mfma_f32_32x32x16_bf16(__builtin_bit_cast(bf16x8, pw3), ATT_PK(3), o[d0], 0, 0, 0);
#undef ATT_PK
          } }
        LDS_WAIT();
        slot = slot1; slot1 = (slot1 == NSLOT - 1) ? 0 : slot1 + 1; slot3 = (slot3 == NSLOT - 1) ? 0 : slot3 + 1;
    }
#undef ATT_QK
    __builtin_amdgcn_s_barrier(); asm volatile("" ::: "memory");
#undef ATT_DMA
    { auto rr = __builtin_amdgcn_permlane32_swap(__float_as_uint(lrun), __float_as_uint(lrun), false, false); lrun = __uint_as_float(rr[0]) + __uint_as_float(rr[1]); }
    if (hi == 0) wsf[32 + r32] = lrun;
    LDS_WAIT();
    float rli[16];
#pragma unroll
    for (int r = 0; r < 16; ++r) rli[r] = __builtin_amdgcn_rcpf(wsf[32 + crow(r, hi)]);
    LAS bf16_t* stg = (LAS bf16_t*)(lds + L_OST) + wid * 2048;
#pragma unroll
    for (int r = 0; r < 16; ++r) { const int orow = crow(r, hi);
#pragma unroll
        for (int d0 = 0; d0 < 2; ++d0) stg[orow * 64 + d0 * 32 + r32] = (bf16_t)(cvtpk_s(o[d0][r] * rli[r], 0.f) & 0xffffu); }
    LDS_WAIT();
#pragma unroll
    for (int i = 0; i < 4; ++i) { const int row = i * 8 + (lane >> 3), ch = lane & 7; const u32x4 v = *(const LAS u32x4*)(stg + row * 64 + ch * 8); *(u32x4*)(Qn + (size_t)row * 512 + ch * 8) = v; }
    LDS_WAIT(); __builtin_amdgcn_s_barrier(); asm volatile("" ::: "memory");
}

__device__ __forceinline__ void attn_phase(Frame& F) {
    const int vcu = (F.G % 8 == 0) ? (F.bid % 8) * (F.G / 8) + F.bid / 8 : F.bid;
    for (int v = vcu; v < 256; v += F.G) {
        const int bh = v >> 2, s = v & 3;
#pragma unroll 1
        for (int i = 0; i < 4; ++i) { const int qb = (i == 0) ? s : (i == 1) ? 7 - s : (i == 2) ? 8 + s : 15 - s; attn_unit<0>(F, bh >> 3, bh & 7, qb); }
#pragma unroll 1
        for (int i = 0; i < 4; ++i) { const int qb = (i == 0) ? s : (i == 1) ? 7 - s : (i == 2) ? 8 + s : 15 - s; attn_unit<1>(F, bh >> 3, bh & 7, qb); }
    }
}
}

struct EpiMerge {
    unsigned char* ws;
    __device__ __forceinline__ void mid(f32x4 (&acc)[2][2][4][2], const pg8::Unit& u, int wr, int wc, int fr, int fq) const {
        const int row0 = u.pm * 256 + wr * 64 + fr, cb = u.pn * 256 + 32 * wc + 4 * fq;
        const bf16_t* ga = (const bf16_t*)(ws + WS_GA); const bf16_t* gm = (const bf16_t*)(ws + WS_GM);
#pragma unroll
        for (int ai = 0; ai < 2; ++ai)
#pragma unroll
            for (int m = 0; m < 4; ++m) { const size_t off = (size_t)(row0 + 128 * ai + 16 * m) * DM + cb;
#pragma unroll
                for (int bj = 0; bj < 2; ++bj) { u32x2 av[2], gv[2]; ld8(ga + (off - 4 * fq) + 128 * bj, av[0], av[1], fq); ld8(gm + (off - 4 * fq) + 128 * bj, gv[0], gv[1], fq);
#pragma unroll
                    for (int n = 0; n < 2; ++n) { const u32x2 a = av[n], g = gv[n];
                        const f32x4 den = (f32x4){fmaxf(bflo(g.x), 1e-30f), fmaxf(bfhi(g.x), 1e-30f), fmaxf(bflo(g.y), 1e-30f), fmaxf(bfhi(g.y), 1e-30f)};
                        acc[ai][bj][m][n] = acc[ai][bj][m][n] * ((f32x4){bflo(a.x), bfhi(a.x), bflo(a.y), bfhi(a.y)} * (f32x4){__builtin_amdgcn_rcpf(den.x), __builtin_amdgcn_rcpf(den.y), __builtin_amdgcn_rcpf(den.z), __builtin_amdgcn_rcpf(den.w)});
                    } } asm volatile("" ::: "memory"); }
    }
    __device__ __forceinline__ void operator()(const f32x4 (&acc)[2][2][4][2], const pg8::Unit& u, int wr, int wc, int fr, int fq) const {
        const int row0 = u.pm * 256 + wr * 64 + fr, cb = u.pn * 256 + 32 * wc + 4 * fq;
        const bf16_t* gm = (const bf16_t*)(ws + WS_GM); bf16_t* mix = (bf16_t*)(ws + WS_MIXED);
#pragma unroll
        for (int ai = 0; ai < 2; ++ai)
#pragma unroll
            for (int m = 0; m < 4; ++m) { const size_t off = (size_t)(row0 + 128 * ai + 16 * m) * DM + cb;
#pragma unroll
                for (int bj = 0; bj < 2; ++bj) { u32x2 pk[2], gv[2]; ld8(gm + (off - 4 * fq) + 128 * bj, gv[0], gv[1], fq);
#pragma unroll
                    for (int n = 0; n < 2; ++n) {
                        const u32x2 g = gv[n];
                        pk[n] = pk4(acc[ai][bj][m][n] * (f32x4){fmaxf(bflo(g.x), 1e-30f), fmaxf(bfhi(g.x), 1e-30f), fmaxf(bflo(g.y), 1e-30f), fmaxf(bfhi(g.y), 1e-30f)});
                    }
                    st8(mix + (off - 4 * fq) + 128 * bj, pk[0], pk[1], fq); } asm volatile("" ::: "memory"); }
    }
};
struct EpiOut {
    unsigned char* ws; const float* x; float* out; const float* g2;
    __device__ __forceinline__ void operator()(const f32x4 (&acc)[2][2][4][2], const pg8::Unit& u, int wr, int wc, int fr, int fq) const {
        const int row0 = u.pm * 256 + wr * 64 + fr, cb = u.pn * 256 + 32 * wc + 4 * fq, b = (u.pm * 256) / SEQ;
        const float* mod = (const float*)(ws + WS_MOD) + (size_t)b * 6144; bf16_t* x1g = (bf16_t*)(ws + WS_X1G); float* ssq = (float*)(ws + WS_SSQ_X1);
        f32x4 gt[2][2], gm[2][2];
#pragma unroll
        for (int bj = 0; bj < 2; ++bj)
#pragma unroll
            for (int n = 0; n < 2; ++n) { const int c = cb + 128 * bj + 16 * n; gt[bj][n] = *(const f32x4*)(mod + 2048 + c); gm[bj][n] = *(const f32x4*)(g2 + c) * (*(const f32x4*)(mod + 4096 + c) + 1.0f); }
#pragma unroll
        for (int ai = 0; ai < 2; ++ai)
#pragma unroll
            for (int m = 0; m < 4; ++m) { const int row = row0 + 128 * ai + 16 * m; const size_t off = (size_t)row * DM + cb; float s = 0.f;
#pragma unroll
                for (int bj = 0; bj < 2; ++bj) { u32x2 pk[2];
#pragma unroll
                    for (int n = 0; n < 2; ++n) {
                        const f32x4 x1 = *(const f32x4*)(x + off + 128 * bj + 16 * n) + gt[bj][n] * acc[ai][bj][m][n];
                        s += sum4sq(x1);
                        pk[n] = pk4(x1 * gm[bj][n]);
                    }
                    st8(x1g + (off - 4 * fq) + 128 * bj, pk[0], pk[1], fq); }
                s = fq_sum(s);
                if (fq == 0) atomicAdd(ssq + row, s); asm volatile("" ::: "memory"); }
    }
};
struct EpiPQ {
    unsigned char* ws;
    __device__ __forceinline__ void operator()(const f32x4 (&acc)[2][2][4][2], const pg8::Unit& u, int wr, int wc, int fr, int fq) const {
        const int row0 = u.pm * 256 + wr * 64 + fr, cb = u.pn * 256 + 32 * wc + 4 * fq, b = (u.pm * 256) / SEQ;
        const float* bias = (const float*)(ws + WS_BIASQ) + (size_t)b * 2048; const float* ssq = (const float*)(ws + WS_SSQ_X1); bf16_t* pq = (bf16_t*)(ws + WS_PQ);
        f32x4 bv[2][2];
#pragma unroll
        for (int bj = 0; bj < 2; ++bj)
#pragma unroll
            for (int n = 0; n < 2; ++n) bv[bj][n] = *(const f32x4*)(bias + cb + 128 * bj + 16 * n);
#pragma unroll
        for (int ai = 0; ai < 2; ++ai)
#pragma unroll
            for (int m = 0; m < 4; ++m) { const int row = row0 + 128 * ai + 16 * m; const float rinv = __builtin_amdgcn_rsqf(ssq[row] * (1.f / DM) + EPS);
#pragma unroll
                for (int bj = 0; bj < 2; ++bj) st8(pq + (size_t)row * 2048 + (cb - 4 * fq) + 128 * bj, pk4(acc[ai][bj][m][0] * rinv + bv[bj][0]), pk4(acc[ai][bj][m][1] * rinv + bv[bj][1]), fq);
                asm volatile("" ::: "memory"); }
    }
};

#define XB_TMO      128
#define XB_XCNT(j)  (256  + 64 * (j))
#define XB_XSUB(j)  (1280 + 64 * (j))
#define XB_XGEN(j)  (2304 + 64 * (j))
#define XB_TOP      3328
#define XB_TOPGEN   3392
#define XB_SPIN_CAP (1u << 22)
__device__ __forceinline__ unsigned xb_ld(unsigned* p)              { return __hip_atomic_load(p, __ATOMIC_RELAXED, __HIP_MEMORY_SCOPE_AGENT); }
__device__ __forceinline__ unsigned xb_add(unsigned* p, unsigned v) { return __hip_atomic_fetch_add(p, v, __ATOMIC_RELAXED, __HIP_MEMORY_SCOPE_AGENT); }
__device__ __forceinline__ unsigned xb_xcc_id() { return (unsigned)__builtin_amdgcn_s_getreg((3 << 11) | 20) & 0xFu; }
#define XB_SPIN(cond, bar) do { unsigned _sp = 0; while (cond) { __builtin_amdgcn_s_sleep(1); \
    if ((++_sp & 255u) == 0u) { if (xb_ld(&(bar)[XB_TMO])) break; if (_sp > XB_SPIN_CAP) { atomicAdd(&(bar)[XB_TMO], 1u); break; } } } } while (0)
struct XcdBarrier { unsigned* bar; unsigned x; volatile LAS unsigned* st; };
__device__ __forceinline__ XcdBarrier xcd_barrier_post(unsigned* bar, volatile LAS unsigned* st) {
    XcdBarrier b; b.bar = bar; b.x = xb_xcc_id(); b.st = st;
    if (threadIdx.x == 0) (void)xb_add(&bar[XB_XCNT(b.x)], 1u);
    return b;
}
__device__ __forceinline__ void xcd_barrier_complete(unsigned* bar, unsigned x, unsigned& nloc, unsigned& nx) {
    const unsigned G = gridDim.x * gridDim.y * gridDim.z;
    unsigned sum, cnt, mine, sp = 0u;
    for (;;) {
        sum = 0u; cnt = 0u; mine = 0u;
#pragma unroll
        for (unsigned j = 0; j < 16; ++j) { const unsigned c = xb_ld(&bar[XB_XCNT(j)]); sum += c; cnt += (c > 0u) ? 1u : 0u; mine = (j == x) ? c : mine; }
        if (sum == G) break;
        __builtin_amdgcn_s_sleep(1);
        if ((++sp & 255u) == 0u) { if (xb_ld(&bar[XB_TMO])) break; if (sp > XB_SPIN_CAP) { atomicAdd(&bar[XB_TMO], 1u); break; } }
    }
    nloc = mine > 0u ? mine : 1u; nx = cnt > 0u ? cnt : 1u;
}
__device__ __forceinline__ void xcd_barrier(const XcdBarrier& b) {
    asm volatile("s_waitcnt vmcnt(0) lgkmcnt(0)" ::: "memory");
    __syncthreads();
    if (threadIdx.x == 0) {
        unsigned* bar = b.bar;
        __builtin_amdgcn_s_waitcnt(0);
        unsigned nloc = b.st[0], nx = b.st[1];
        if (nloc == 0u) { xcd_barrier_complete(bar, b.x, nloc, nx); b.st[0] = nloc; b.st[1] = nx; }
        const unsigned old = xb_add(&bar[XB_XSUB(b.x)], 1u);
        const unsigned gen = old / nloc;
        if (old + 1u == (gen + 1u) * nloc) {
            __builtin_amdgcn_fence(__ATOMIC_RELEASE, "agent");
            asm volatile("s_waitcnt vmcnt(0)" ::: "memory");
            const unsigned og = xb_add(&bar[XB_TOP], 1u);
            const unsigned tg = og / nx;
            if (og + 1u == (tg + 1u) * nx) xb_add(&bar[XB_TOPGEN], 1u);
            else XB_SPIN(xb_ld(&bar[XB_TOPGEN]) == tg, bar);
            __builtin_amdgcn_fence(__ATOMIC_ACQUIRE, "agent");
            xb_add(&bar[XB_XGEN(b.x)], 1u);
            asm volatile("s_waitcnt vmcnt(0)" ::: "memory");
        } else {
            XB_SPIN(xb_ld(&bar[XB_XGEN(b.x)]) == gen, bar);
            __builtin_amdgcn_fence(__ATOMIC_ACQUIRE, "agent");
            asm volatile("s_waitcnt vmcnt(0)" ::: "memory");
        }
    }
    __syncthreads();
}
#define grid_barrier(ctr, target) xcd_barrier(xbar)


namespace peer {
constexpr int TOK = 32;
constexpr int L_EXP = 0, L_GATE = L_EXP + TOK * 128 * 2, L_TOPI = L_GATE + TOK * 128 * 4, L_TOPV = L_TOPI + NWAVES * TOK * 32, L_CNT = L_TOPV + NWAVES * TOK * 32 * 4, L_SU = L_CNT + NWAVES * 64 * 4, L_BYTES = L_SU + TOK * 128 * 4;
static_assert(L_BYTES <= LDS_BYTES, "peer LDS");
__device__ __forceinline__ unsigned sortable(float v) { const unsigned u = __float_as_uint(v); return (u & 0x80000000u) ? ~u : (u | 0x80000000u); }
__device__ __forceinline__ float unsortable(unsigned k) { return __uint_as_float((k & 0x80000000u) ? (k & 0x7fffffffu) : ~k); }
__device__ __forceinline__ unsigned pair_max(unsigned m) { auto rr = __builtin_amdgcn_permlane32_swap(m, m, false, false); return rr[0] > rr[1] ? rr[0] : rr[1]; }
__device__ __forceinline__ float gelu_tanh(float x) { const float y = 0.7978845608028654f * (x + 0.044715f * x * x * x); const float e = __builtin_amdgcn_exp2f(y * (2.f * LOG2E)); return 0.5f * x * (2.f - 2.f * __builtin_amdgcn_rcpf(e + 1.f)); }

template <int CTRL> __device__ __forceinline__ float dppf(float v) { return __int_as_float(__builtin_amdgcn_update_dpp(0, __float_as_int(v), CTRL, 0xf, 0xf, true)); }
__device__ __forceinline__ float wsum_dpp(float v) {
    v += dppf<0xB1>(v); v += dppf<0x4E>(v); v += dppf<0x141>(v); v += dppf<0x140>(v);
    { auto r = __builtin_amdgcn_permlane16_swap(__float_as_uint(v), __float_as_uint(v), false, false); v = __uint_as_float(r[0]) + __uint_as_float(r[1]); }
    { auto r = __builtin_amdgcn_permlane32_swap(__float_as_uint(v), __float_as_uint(v), false, false); v = __uint_as_float(r[0]) + __uint_as_float(r[1]); }
    return v;
}
__device__ __forceinline__ void route_head(Frame& F, int tok0) {
    int lane = F.lane; asm volatile("" : "+v"(lane));
    const int h = F.wave, r32 = lane & 31, hi = lane >> 5;
    const bf16_t* PQ = (const bf16_t*)(F.ws + WS_PQ) + (size_t)(tok0 + r32) * 2048 + h * 256;
    const bf16_t* SK = (const bf16_t*)(F.ws + WS_SUBK) + (size_t)h * 2 * 128 * 128;
    LAS unsigned char* topi = (LAS unsigned char*)(F.lds + L_TOPI) + h * (TOK * 32) + r32 * 32;
    LAS float* topv = (LAS float*)(F.lds + L_TOPV) + h * (TOK * 32) + r32 * 32;
#pragma unroll 1
    for (int p = 0; p < 2; ++p) {
        f32x16 acc[4]; acc[0] = f32x16{}; acc[1] = f32x16{}; acc[2] = f32x16{}; acc[3] = f32x16{};
#pragma unroll 2
        for (int ks = 0; ks < 8; ++ks) {
            const bf16x8 bq = *(const bf16x8*)(PQ + p * 128 + 16 * ks + 8 * hi);
#pragma unroll
            for (int kb = 0; kb < 4; ++kb) {
                const bf16x8 ak = *(const bf16x8*)(SK + ((size_t)p * 128 + 32 * kb + r32) * 128 + 16 * ks + 8 * hi);
                acc[kb] = __builtin_amdgcn_mfma_f32_32x32x16_bf16(ak, bq, acc[kb], 0, 0, 0);
            }
        }
        unsigned key[64];
#pragma unroll
        for (int kb = 0; kb < 4; ++kb)
#pragma unroll
            for (int r = 0; r < 16; ++r) { const int kidx = 32 * kb + (r & 3) + 8 * (r >> 2) + 4 * hi; key[kb * 16 + r] = ((sortable(acc[kb][r]) >> 1) & ~127u) | (unsigned)(127 - kidx); }
        unsigned prev = 0x80000000u;
#pragma unroll 1
        for (int it = 0; it < 16; ++it) {
            unsigned mv = key[0] - prev;
#pragma unroll
            for (int r = 1; r < 64; ++r) { const unsigned d = key[r] - prev; mv = d > mv ? d : mv; }
            mv = pair_max(mv);
            const unsigned m = prev + mv; prev = m;
            if (hi == 0) { topi[p * 16 + it] = (unsigned char)(127 - (m & 127u)); topv[p * 16 + it] = unsortable((m & ~127u) << 1); }
        }
    }
    LDS_WAIT();
    unsigned cand[25];
    { float av[16], bv[16];
#pragma unroll
      for (int i = 0; i < 16; ++i) { av[i] = topv[i]; bv[i] = topv[16 + i]; }
      int n = 0;
#pragma unroll
      for (int i = 0; i < 16; ++i)
#pragma unroll
          for (int j = 0; j < 16; ++j) if ((i + 1) * (j + 1) <= 16) { const unsigned k = ((sortable(av[i] + bv[j]) >> 1) & ~255u) | (unsigned)(255 - (i * 16 + j)); if ((n & 1) == 0) { cand[n >> 1] = hi ? 0u : k; } else { cand[n >> 1] = hi ? k : cand[n >> 1]; } ++n; } }
    LAS unsigned short* ex_o = (LAS unsigned short*)(F.lds + L_EXP) + r32 * 128 + h * 16;
    LAS float* g_o = (LAS float*)(F.lds + L_GATE) + r32 * 128 + h * 16;
    float den = 0.f, s0 = 0.f; unsigned prevc = 0x80000000u;
#pragma unroll 1
    for (int it = 0; it < 16; ++it) {
        unsigned mv = cand[0] - prevc;
#pragma unroll
        for (int r = 1; r < 25; ++r) { const unsigned d = cand[r] - prevc; mv = d > mv ? d : mv; }
        mv = pair_max(mv);
        const unsigned m = prevc + mv; prevc = m;
        const float sv = unsortable((m & ~255u) << 1); const unsigned pos = 255u - (m & 255u), i = pos >> 4, j = pos & 15u;
        if (it == 0) s0 = sv;
        const float ex = __builtin_amdgcn_exp2f((sv - s0) * LOG2E); den += ex;
        if (hi == 0) { ex_o[it] = (unsigned short)((unsigned)topi[i] * 128u + (unsigned)topi[16 + j]); g_o[it] = ex; }
    }
    const float rden = __builtin_amdgcn_rcpf(den);
    LDS_WAIT();
    if (hi == 0) {
#pragma unroll
        for (int it = 0; it < 16; ++it) g_o[it] *= rden;
    }
}

__device__ __forceinline__ void expert_tokens(Frame& F, int tok0) {
    int lane = F.lane; const int wid = F.wave;
    asm volatile("" : "+v"(lane));
    const unsigned char* PU = F.ws + WS_PU; const unsigned char* PV = F.ws + WS_PV;
    const float* USC = (const float*)(F.ws + WS_USC); const float* VSC = (const float*)(F.ws + WS_VSC);
    const float* ssq = (const float*)(F.ws + WS_SSQ_X1); const bf16_t* X1G = (const bf16_t*)(F.ws + WS_X1G);
    LAS unsigned* cnt = (LAS unsigned*)(F.lds + L_CNT) + wid * 64;
#pragma unroll 1
    for (int tt = 0; tt < 4; ++tt) {
        const int tl = 4 * wid + tt;
        LAS unsigned short* ex_l = (LAS unsigned short*)(F.lds + L_EXP) + tl * 128; LAS float* g_l = (LAS float*)(F.lds + L_GATE) + tl * 128; LAS float* su_l = (LAS float*)(F.lds + L_SU) + tl * 128;
        cnt[lane] = 0u;
        const unsigned e0 = ex_l[lane], e1 = ex_l[lane + 64]; const float g0 = g_l[lane] * VSC[e0], g1 = g_l[lane + 64] * VSC[e1]; const float s0 = USC[e0], s1 = USC[e1];
        const unsigned b0 = e0 >> 8, b1 = e1 >> 8;
        LDS_WAIT(); asm volatile("" ::: "memory");
        const unsigned r0 = __hip_atomic_fetch_add(cnt + b0, 1u, __ATOMIC_RELAXED, __HIP_MEMORY_SCOPE_WORKGROUP);
        const unsigned r1 = __hip_atomic_fetch_add(cnt + b1, 1u, __ATOMIC_RELAXED, __HIP_MEMORY_SCOPE_WORKGROUP);
        LDS_WAIT(); asm volatile("" ::: "memory");
        const int c = (int)cnt[lane]; int incl = c;
#pragma unroll
        for (int o = 1; o < 64; o <<= 1) { const int tv = __shfl_up(incl, o); incl += (lane >= o) ? tv : 0; }
        const int excl = incl - c;
        const int p0 = __shfl(excl, (int)b0) + (int)r0, p1 = __shfl(excl, (int)b1) + (int)r1;
        ex_l[p0] = (unsigned short)e0; ex_l[p1] = (unsigned short)e1; g_l[p0] = g0; g_l[p1] = g1; su_l[p0] = s0; su_l[p1] = s1;
        LDS_WAIT(); asm volatile("" ::: "memory");
    }
    {
        unsigned hA[4][2], hB[4][2]; float hinv[4]; f16x2 acc2[4][8]; u32x4 xg[4][2];
#pragma unroll
        for (int u = 0; u < 4; ++u) {
            const int t = tok0 + 4 * wid + u, b = t / SEQ;
            const float* mod = (const float*)(F.ws + WS_MOD) + (size_t)b * 6144;
            const float rinv = __builtin_amdgcn_rsqf(ssq[t] * (1.f / DM) + EPS);
            const u32x4 x0 = *(const u32x4*)(X1G + (size_t)t * DM + 16 * lane), x1 = *(const u32x4*)(X1G + (size_t)t * DM + 16 * lane + 8);
            float hv[16]; float amax = 1e-30f; xg[u][0] = x0; xg[u][1] = x1;
#pragma unroll
            for (int j = 0; j < 4; ++j) { const f32x4 sh = *(const f32x4*)(mod + 3072 + 16 * lane + 4 * j); const unsigned w0 = (j < 2) ? x0[2 * j] : x1[2 * j - 4], w1 = (j < 2) ? x0[2 * j + 1] : x1[2 * j - 3];
                hv[4 * j] = bflo(w0) * rinv + sh.x; hv[4 * j + 1] = bfhi(w0) * rinv + sh.y; hv[4 * j + 2] = bflo(w1) * rinv + sh.z; hv[4 * j + 3] = bfhi(w1) * rinv + sh.w; }
#pragma unroll
            for (int i = 0; i < 16; ++i) amax = fmaxf(amax, fabsf(hv[i]));
#pragma unroll
            for (int o = 32; o >= 1; o >>= 1) amax = fmaxf(amax, __shfl_xor(amax, o));
            const float hs = 119.f / amax; hinv[u] = amax * (1.f / 119.f);
            hA[u][0] = hA[u][1] = hB[u][0] = hB[u][1] = 0u;
#pragma unroll
            for (int i = 0; i < 16; ++i) { const int q = (int)__builtin_rintf(hv[i] * hs); const int lo = ((q + 8) & 15) - 8; const int hi = (q - lo) >> 4;
                hA[u][i >> 3] |= ((unsigned)hi & 15u) << (4 * (i & 7)); hB[u][i >> 3] |= ((unsigned)lo & 15u) << (4 * (i & 7)); }
#pragma unroll
            for (int i = 0; i < 8; ++i) acc2[u][i] = (f16x2){(_Float16)0.f, (_Float16)0.f};
            asm volatile("" ::: "memory");
        }
        const LAS unsigned short* ex_w = (const LAS unsigned short*)(F.lds + L_EXP) + (4 * wid) * 128;
        const LAS float* g_w = (const LAS float*)(F.lds + L_GATE) + (4 * wid) * 128;
        const LAS float* su_w = (const LAS float*)(F.lds + L_SU) + (4 * wid) * 128;
        const int kl = ((lane >> 5) & 1) | (((lane >> 4) & 1) << 1);
        const unsigned voff = 8u * (unsigned)lane;
        const __amdgpu_buffer_rsrc_t rsU = __builtin_amdgcn_make_buffer_rsrc((void*)PU, (short)0, PNEXP * (DM / 2), 0x00020000), rsV = __builtin_amdgcn_make_buffer_rsrc((void*)PV, (short)0, PNEXP * (DM / 2), 0x00020000);
        u32x2 ua[4], va[4], ub[4], vb[4]; float ga, gb, sua, sub_;
#define PEER_LOAD(U, V, G, SU, u, e0) do { _Pragma("unroll") for (int k = 0; k < 4; ++k) { const int eid = __builtin_amdgcn_readfirstlane((int)ex_w[(u) * 128 + (e0) + k]); \
            U[k] = (u32x2)__builtin_amdgcn_raw_buffer_load_b64(rsU, (int)voff, eid * (DM / 2), 0); V[k] = (u32x2)__builtin_amdgcn_raw_buffer_load_b64(rsV, (int)voff, eid * (DM / 2), 0); } \
            { SU = su_w[(u) * 128 + (e0) + kl] * hinv[u]; G = g_w[(u) * 128 + (e0) + kl]; } } while (0)
#define VACC(j, b) acc2[u_][4 * (j) + (b)] = __builtin_elementwise_fma(c2, __builtin_bit_cast(f16x2, __builtin_amdgcn_cvt_scalef32_pk_f16_fp4(Vk[j], 1.0f, b)), acc2[u_][4 * (j) + (b)])
#define PEER_COMP(U, V, G, SU, u) do { constexpr int u_ = (u); float dd[4]; _Pragma("unroll") for (int k = 0; k < 4; ++k) { \
            const int da = __builtin_amdgcn_sdot8((int)U[k][1], (int)hA[u_][1], __builtin_amdgcn_sdot8((int)U[k][0], (int)hA[u_][0], 0, false), false); \
            const int db = __builtin_amdgcn_sdot8((int)U[k][1], (int)hB[u_][1], __builtin_amdgcn_sdot8((int)U[k][0], (int)hB[u_][0], 0, false), false); \
            dd[k] = (float)(16 * da + db); } \
            float z; { auto r0 = __builtin_amdgcn_permlane32_swap(__float_as_uint(dd[0]), __float_as_uint(dd[1]), false, false); const float s01 = __uint_as_float(r0[0]) + __uint_as_float(r0[1]); \
              auto r1 = __builtin_amdgcn_permlane32_swap(__float_as_uint(dd[2]), __float_as_uint(dd[3]), false, false); const float s23 = __uint_as_float(r1[0]) + __uint_as_float(r1[1]); \
              auto r2 = __builtin_amdgcn_permlane16_swap(__float_as_uint(s01), __float_as_uint(s23), false, false); z = __uint_as_float(r2[0]) + __uint_as_float(r2[1]); } \
            z += dppf<0xB1>(z); z += dppf<0x4E>(z); z += dppf<0x141>(z); z += dppf<0x140>(z); \
            const float cf_ = G * gelu_tanh(z * SU); const f16x2 ch_ = (f16x2){(_Float16)cf_, (_Float16)cf_}; const int ci = __builtin_bit_cast(int, ch_); \
            _Pragma("unroll") for (int k = 0; k < 4; ++k) { const f16x2 c2 = __builtin_bit_cast(f16x2, __builtin_amdgcn_readlane(ci, ((k & 1) << 5) | ((k >> 1) << 4))); const u32x2 Vk = V[k]; \
            VACC(0, 0); VACC(0, 1); VACC(0, 2); VACC(0, 3); VACC(1, 0); VACC(1, 1); VACC(1, 2); VACC(1, 3); } } while (0)
        PEER_LOAD(ua, va, ga, sua, 0, 0);
#pragma unroll 1
        for (int j = 0; j < 32; ++j) {
            const int jn = (j + 1 < 32) ? j + 1 : 31;
            PEER_LOAD(ub, vb, gb, sub_, 1, 4 * j);     PEER_COMP(ua, va, ga, sua, 0);
            PEER_LOAD(ua, va, ga, sua, 2, 4 * j);      PEER_COMP(ub, vb, gb, sub_, 1);
            PEER_LOAD(ub, vb, gb, sub_, 3, 4 * j);     PEER_COMP(ua, va, ga, sua, 2);
            PEER_LOAD(ua, va, ga, sua, 0, 4 * jn);     PEER_COMP(ub, vb, gb, sub_, 3);
        }
#undef PEER_LOAD
#undef PEER_COMP
#undef VACC
#pragma unroll
        for (int u = 0; u < 4; ++u) {
            const int t = tok0 + 4 * wid + u, b = t / SEQ; const float* mod = (const float*)(F.ws + WS_MOD) + (size_t)b * 6144;
            float* op = F.out + (size_t)t * DM + 16 * lane; const float* g2 = F.in[IN_G2] + 16 * lane;
            const u32x4 y0 = xg[u][0], y1 = xg[u][1];
#pragma unroll
            for (int j = 0; j < 4; ++j) { const f32x4 g = *(const f32x4*)(mod + 5120 + 16 * lane + 4 * j); const f32x4 gmv = *(const f32x4*)(g2 + 4 * j) * (*(const f32x4*)(mod + 4096 + 16 * lane + 4 * j) + 1.0f);
                const unsigned w0 = (j < 2) ? y0[2 * j] : y1[2 * j - 4], w1 = (j < 2) ? y0[2 * j + 1] : y1[2 * j - 3];
                const f32x4 x = (f32x4){bflo(w0), bfhi(w0), bflo(w1), bfhi(w1)} * (f32x4){__builtin_amdgcn_rcpf(gmv.x), __builtin_amdgcn_rcpf(gmv.y), __builtin_amdgcn_rcpf(gmv.z), __builtin_amdgcn_rcpf(gmv.w)};
                *(f32x4*)(op + 4 * j) = x + g * (f32x4){(float)acc2[u][2 * j].x, (float)acc2[u][2 * j].y, (float)acc2[u][2 * j + 1].x, (float)acc2[u][2 * j + 1].y}; }
        }
    }
}
__device__ __forceinline__ void peer_phase(Frame& F) {
    for (int u = F.bid; u < T / TOK; u += F.G) {
        const int tok0 = u * TOK;
        route_head(F, tok0);
        __syncthreads();
        expert_tokens(F, tok0);
        __syncthreads();
    }
}
}

__global__ void __launch_bounds__(NTHREADS, 2) hybrid_fwd(Args args) {
    extern __shared__ __attribute__((aligned(16))) unsigned char lds_raw[];
    cg::grid_group grid = cg::this_grid();
    Frame F;
    F.lds = (LAS unsigned char*)lds_raw; F.ws = args.ws;
    F.tid = threadIdx.x; F.lane = F.tid & 63; F.wave = __builtin_amdgcn_readfirstlane(F.tid >> 6);
    F.G = gridDim.x; F.bid = blockIdx.x;
#pragma unroll
    for (int i = 0; i < 24; ++i) F.in[i] = args.in[i];
    F.out = args.out;
    unsigned char* ws = args.ws;
    const int lo = args.ph_lo, hi = args.ph_hi;
#define IN(k) (lo <= (k) && (k) < hi)
    unsigned nbar = 0; unsigned* barctr = (unsigned*)(ws + WS_BAR);
    volatile LAS unsigned* xst = (volatile LAS unsigned*)(F.lds + LDS_BYTES - 64);
    if (F.tid < 2) xst[F.tid] = 0u;
    __syncthreads();
    XcdBarrier xbar; xbar.bar = barctr; xbar.x = 0; xbar.st = xst;
#define SEAM(k) do { if (IN(k) && IN((k) + 1)) { if ((k) == 0) { asm volatile("s_waitcnt vmcnt(0) lgkmcnt(0)" ::: "memory"); __syncthreads(); grid.sync(); \
        __builtin_amdgcn_fence(__ATOMIC_ACQUIRE, "agent"); asm volatile("s_waitcnt vmcnt(0)" ::: "memory"); __syncthreads(); xbar = xcd_barrier_post(barctr, xst); } \
        else { ++nbar; grid_barrier(barctr, nbar * (unsigned)F.G); } } } while (0)
    if (IN(0)) { phase0(F); __syncthreads(); }
    SEAM(0);
    if (IN(1)) { phase1(F); }
    SEAM(1);
    if (IN(2)) {
        pg8::StaticOrder S; S.init((const bf16_t*)(ws + WS_XN), (const bf16_t*)(ws + WS_WIN), T, IN_PAD, DM, F.G, F.bid);
        EpiIn E{ws, F.in[IN_GAQ], F.in[IN_GAK], F.in[IN_GIDXK], F.in[IN_GMK]};
        pg8::gemm_phase(F.lds, DM, S, E);
    }
    SEAM(2);
    if (IN(3)) {
        { pg8::StaticOrder S; S.init((const bf16_t*)(ws + WS_CQ), (const bf16_t*)(ws + WS_WQUP), T, 768, QRANK, F.G, F.bid);
          EpiQup E{ws, F.in[IN_GMQ]}; pg8::gemm_phase(F.lds, QRANK, S, E); }
        { pg8::StaticOrder S; S.init((const bf16_t*)(ws + WS_CKV), (const bf16_t*)(ws + WS_WKVUP), T, 1024, KVRANK, F.G, F.bid);
          EpiKVup E{ws, F.in[IN_GMK]}; pg8::gemm_phase(F.lds, KVRANK, S, E); }
        indexer_phase(F);
    }
    SEAM(3);
    if (IN(4)) { att::attn_phase(F); }
    SEAM(4);
    if (IN(5)) {
        cvt_i4_rows(F.in[IN_PU], ws + WS_PU, (float*)(ws + WS_USC), PNEXP, F.bid * NWAVES + F.wave, F.G * NWAVES, F.lane);
        cvt_fp4_rows(F.in[IN_PV], ws + WS_PV, (float*)(ws + WS_VSC), PNEXP, F.bid * NWAVES + F.wave, F.G * NWAVES, F.lane);
        pg8::DualOrder S; S.A0 = (const char*)(ws + WS_QA); S.B0 = (const char*)(ws + WS_WOA); S.A1 = (const char*)(ws + WS_QMN); S.B1 = (const char*)(ws + WS_WOM);
        S.nM = T / 256; S.nN = DM / 256; S.G = F.G; S.c = F.bid; S.tstep = (size_t)256 * AW * 2;
        EpiMerge E{ws}; pg8::gemm_phase<true>(F.lds, AW, S, E);
    }
    SEAM(5);
    if (IN(6)) {
        pg8::StaticOrder S; S.init((const bf16_t*)(ws + WS_MIXED), (const bf16_t*)(ws + WS_WOUT), T, DM, DM, F.G, F.bid);
        EpiOut E{ws, F.in[IN_X], F.out, F.in[IN_G2]}; pg8::gemm_phase(F.lds, DM, S, E);
    }
    SEAM(6);
    if (IN(7)) {
        pg8::StaticOrder S; S.init((const bf16_t*)(ws + WS_X1G), (const bf16_t*)(ws + WS_WPQ), T, 2048, DM, F.G, F.bid);
        EpiPQ E{ws}; pg8::gemm_phase(F.lds, DM, S, E);
    }
    SEAM(7);
    if (IN(8)) { peer::peer_phase(F); }
#undef IN
#undef SEAM
}

extern "C" void kernel_launch(void* const* d_in, const int* in_sizes, int n_in, void* d_out, int out_size, void* d_ws, size_t ws_size, hipStream_t stream) {
    static int grid = 0;
    if (grid == 0) {
        if (n_in != 24 || out_size != T * DM || ws_size < WS_END) { fprintf(stderr, "kernel_launch: unexpected shapes (n_in %d, out %d, ws %zu < %zu)\n", n_in, out_size, ws_size, (size_t)WS_END); grid = -1; return; }
        int dev = 0, cus = 0, per_cu = 0;
        (void)hipGetDevice(&dev); (void)hipDeviceGetAttribute(&cus, hipDeviceAttributeMultiprocessorCount, dev);
        if (hipFuncSetAttribute((const void*)hybrid_fwd, hipFuncAttributeMaxDynamicSharedMemorySize, LDS_BYTES) != hipSuccess) { fprintf(stderr, "kernel_launch: hipFuncSetAttribute failed\n"); grid = -1; return; }
        if (hipOccupancyMaxActiveBlocksPerMultiprocessor(&per_cu, (const void*)hybrid_fwd, NTHREADS, LDS_BYTES) != hipSuccess || per_cu < 1) { fprintf(stderr, "kernel_launch: occupancy query says %d blocks/CU\n", per_cu); (void)hipGetLastError(); per_cu = 1; }
        grid = cus * (per_cu < 1 ? 1 : 1);
        fprintf(stderr, "kernel_launch: grid %d (cus %d, occupancy %d/CU)\n", grid, cus, per_cu);
    }
    if (grid < 0) return;
    Args a{};
    for (int i = 0; i < 24; ++i) a.in[i] = (const float*)d_in[i];
    a.out = (float*)d_out; a.ws = (unsigned char*)d_ws;
    a.ph_lo = 0; a.ph_hi = 9;
    void* kargs[] = {&a};
    hipError_t e = hipLaunchCooperativeKernel((const void*)hybrid_fwd, dim3(grid), dim3(NTHREADS), kargs, LDS_BYTES, stream);
    if (e != hipSuccess) fprintf(stderr, "kernel_launch: cooperative launch failed: %s (grid %d)\n", hipGetErrorString(e), grid);
}
```

```cpp
#include <hip/hip_runtime.h>
#include <hip/hip_cooperative_groups.h>
#include <cstdio>
#include <cstdint>
namespace cg = cooperative_groups;

#define LAS __attribute__((address_space(3)))
typedef unsigned short bf16_t;
typedef short bf16x8 __attribute__((ext_vector_type(8)));
typedef short s16x4 __attribute__((ext_vector_type(4)));
typedef float f32x2 __attribute__((ext_vector_type(2)));
typedef float f32x4 __attribute__((ext_vector_type(4)));
typedef float f32x16 __attribute__((ext_vector_type(16)));
typedef unsigned u32x2 __attribute__((ext_vector_type(2)));
typedef unsigned u32x4 __attribute__((ext_vector_type(4)));
typedef __bf16 bf16x2_t __attribute__((ext_vector_type(2)));
typedef _Float16 f16x2 __attribute__((ext_vector_type(2)));

constexpr int NB = 8, SEQ = 4096, DM = 1024, T = NB * SEQ;
constexpr int AW = 512, NH = 8, HD = 64;
constexpr int QRANK = 384, KVRANK = 256, NOPE = 64, ROPED = 32, MQK = 96;
constexpr int IN_WIDTH = 4840, IN_PAD = 5120;
constexpr int PH = 8, PNK = 128, PNEXP = 16384, PDK = 256, PTOPK = 16;
constexpr int NSEL = 256;
constexpr float EPS = 1e-6f;
constexpr float LOG2E = 1.4426950408889634f;
constexpr float C2A = 0.125f * LOG2E;
constexpr float C2B = 0.10206207261596577f * LOG2E;

constexpr size_t MiB = 1u << 20;
constexpr size_t WS_ZERO = 0, ZERO_BYTES = 2 * MiB;
constexpr size_t WS_SSQ_CQ = 0;
constexpr size_t WS_SSQ_CKV = WS_SSQ_CQ + (size_t)T * 4;
constexpr size_t WS_SSQ_X1 = WS_SSQ_CKV + (size_t)T * 4;
constexpr size_t WS_SSQ_QM = WS_SSQ_X1 + (size_t)T * 4;
constexpr size_t WS_MOD = WS_SSQ_QM + (size_t)T * 8 * 4;
constexpr size_t WS_BIASQ = WS_MOD + (size_t)NB * 6144 * 4;
constexpr size_t WS_BAR = WS_BIASQ + (size_t)NB * 2048 * 4;
static_assert(WS_BAR + 3456 * 4 <= ZERO_BYTES, "zero region");
constexpr size_t WS_WIN = 3 * MiB;
constexpr size_t WS_WQUP = WS_WIN + (size_t)IN_PAD * DM * 2;
constexpr size_t WS_WKVUP = WS_WQUP + (size_t)768 * 384 * 2;
constexpr size_t WS_WOA = WS_WKVUP + (size_t)1024 * 256 * 2;
constexpr size_t WS_WOM = WS_WOA + (size_t)1024 * 512 * 2;
constexpr size_t WS_WOUT = WS_WOM + (size_t)1024 * 512 * 2;
constexpr size_t WS_WPQ = WS_WOUT + (size_t)1024 * 1024 * 2;
constexpr size_t WS_SUBK = WS_WPQ + (size_t)2048 * 1024 * 2;
constexpr size_t WS_ROPE32 = WS_SUBK + (size_t)16 * 128 * 128 * 2;
constexpr size_t WS_ROPE16 = WS_ROPE32 + (size_t)T * 64 * 4;
constexpr size_t WS_W_END = WS_ROPE16 + (size_t)T * 32 * 4;
static_assert(WS_W_END <= 36 * MiB, "weights region");
constexpr size_t R1 = 36 * MiB;
constexpr size_t WS_XN = R1, WS_QMN = R1, WS_QMR = R1 + 32 * MiB;
constexpr size_t R2 = 100 * MiB;
constexpr size_t WS_QA = R2, WS_KA = R2 + 32 * MiB, WS_VA = R2 + 64 * MiB, WS_QI = R2 + 96 * MiB, WS_PQ = R2;
constexpr size_t R3 = 228 * MiB;
constexpr size_t WS_GA = R3, WS_GM = R3 + 64 * MiB, WS_X1G = R3;
constexpr size_t R4 = 356 * MiB;
constexpr size_t WS_KMN = R4, WS_KMR = R4 + 32 * MiB, WS_VM = R4 + 48 * MiB, WS_PU = R4, WS_PV = R4 + 16 * MiB, WS_USC = R4 + 32 * MiB, WS_VSC = R4 + 33 * MiB;
constexpr size_t R5 = 436 * MiB;
constexpr size_t WS_CQ = R5, WS_CKV = R5 + 24 * MiB, WS_KI = R5 + 40 * MiB, WS_WI = R5 + 44 * MiB, WS_KPER = R5 + 45 * MiB,
                 WS_KPESSQ = R5 + 49 * MiB, WS_MASK = R5 + 50 * MiB, WS_MIXED = R5;
constexpr size_t WS_END = 502 * MiB;
static_assert(WS_MASK + (size_t)NB * 64 * SEQ * 8 <= WS_END, "ws map");

constexpr int LDS_BYTES = 155648;
constexpr int NWAVES = 8, NTHREADS = 512;

__device__ __forceinline__ unsigned cvt_pk_bf16(float lo, float hi) { unsigned r; asm volatile("v_cvt_pk_bf16_f32 %0, %1, %2" : "=v"(r) : "v"(lo), "v"(hi)); return r; }
__device__ __forceinline__ unsigned cvtpk_s(float lo, float hi) { f32x2 v = {lo, hi}; bf16x2_t b = __builtin_convertvector(v, bf16x2_t); return __builtin_bit_cast(unsigned, b); }
__device__ __forceinline__ float bf2f(unsigned short b) { return __uint_as_float((unsigned)b << 16); }
__device__ __forceinline__ float bflo(unsigned w) { return __uint_as_float(w << 16); }
__device__ __forceinline__ float bfhi(unsigned w) { return __uint_as_float(w & 0xffff0000u); }
__device__ __forceinline__ float rdlane_f(float v, int l) { return __int_as_float(__builtin_amdgcn_readlane(__float_as_int(v), l)); }
__device__ __forceinline__ float sigmoidf_(float v) { return __builtin_amdgcn_rcpf(1.0f + __builtin_amdgcn_exp2f(-v * LOG2E)); }
#define LDS_WAIT() asm volatile("s_waitcnt lgkmcnt(0)" ::: "memory")
#define VM_WAIT() asm volatile("s_waitcnt vmcnt(0)" ::: "memory")

namespace pg8 {
constexpr int BM = 256, BK = 64, HALF = 128, HTB = HALF * BK * 2, STAGE_BYTES = 8 * HTB, NXCD = 8, WGM = 8;
__host__ __device__ __forceinline__ int lds_byte(int r, int c) { const int st = (r >> 4) * 2 + (c >> 5), rr = r & 15, cc = c & 31, ob = rr * 64 + cc * 2; return st * 1024 + (ob ^ (((ob >> 9) & 1) << 5)); }
__host__ __device__ __forceinline__ void stage_rc(int b, int& R, int& C) { const int st = b / 1024, sb = b % 1024, swz = sb ^ (((sb >> 9) & 1) << 5); R = (st >> 1) * 16 + swz / 64; C = (st & 1) * 32 + (swz % 64) / 2; }

struct Unit { int pm, pn, tag; const char* A; const char* B; };

__device__ __forceinline__ bool tile_order(int L, int nM, int nN, int& pm, int& pn) {
    const int nwg = nM * nN; if (L >= nwg) return false;
    int wgid = L; { const int q = nwg / NXCD, r = nwg % NXCD, xcd = wgid % NXCD, off = wgid / NXCD; wgid = (xcd < r ? xcd * (q + 1) : r * (q + 1) + (xcd - r) * q) + off; }
    const int nig = WGM * nN, gid = wgid / nig, fm = gid * WGM, gsz = (nM - fm) < WGM ? (nM - fm) : WGM;
    pm = fm + ((wgid % nig) % gsz); pn = (wgid % nig) / gsz; return true;
}
struct StaticOrder {
    const char* A; const char* Bt; int nM, nN, G, c; size_t tstep;
    __device__ void init(const bf16_t* A_, const bf16_t* Bt_, int M, int N, int K, int G_, int c_) { A = (const char*)A_; Bt = (const char*)Bt_; nM = M / BM; nN = N / BM; G = G_; c = c_; tstep = (size_t)BM * K * 2; }
    __device__ __forceinline__ bool next(int i, Unit& u) const {
        int pm, pn; if (!tile_order(i * G + c, nM, nN, pm, pn)) return false;
        u.pm = pm; u.pn = pn; u.tag = 0; u.A = A + (size_t)pm * tstep; u.B = Bt + (size_t)pn * tstep; return true;
    }
};
struct DualOrder {
    const char* A0; const char* B0; const char* A1; const char* B1; int nM, nN, G, c; size_t tstep;
    __device__ __forceinline__ bool next(int i, Unit& u) const {
        int pm, pn; if (!tile_order((i >> 1) * G + c, nM, nN, pm, pn)) return false;
        u.pm = pm; u.pn = pn; u.tag = i & 1; u.A = ((i & 1) ? A1 : A0) + (size_t)pm * tstep; u.B = ((i & 1) ? B1 : B0) + (size_t)pn * tstep; return true;
    }
};

template <bool MERGE = false, class Epi, class Sched>
__device__ __forceinline__ void gemm_phase(LAS unsigned char* lds, const int K, const Sched& S, const Epi& E) {
    const int tid = threadIdx.x, wid = __builtin_amdgcn_readfirstlane(tid >> 6), lane = tid & 63, wr = wid >> 2, wc = wid & 3, fr = lane & 15, fq = lane >> 4;
    const int nt = K / BK;
    unsigned voffA[2];
#pragma unroll
    for (int i = 0; i < 2; ++i) { int R, C; stage_rc(tid * 16 + i * 8192, R, C); voffA[i] = (unsigned)(R * K + C) * 2u; }
    const size_t kstep = (size_t)(BK * 2);
    const size_t hstep = (size_t)HALF * K * 2;
    const unsigned ldsw = (unsigned)wid * 1024u;
    const int aoff = lds_byte(wr * 64 + fr, fq * 8), boff = lds_byte(wc * 32 + fr, fq * 8);
#define PG8_SA(b, h) (((b) * 2 + (h)) * HTB)
#define PG8_SB(b, h) ((4 + (b) * 2 + (h)) * HTB)
#define PG8_STAGE(bufoff, gbase) do { _Pragma("unroll") for (int _i = 0; _i < 2; ++_i) \
        __builtin_amdgcn_global_load_lds((const unsigned*)((const char*)(gbase) + voffA[_i]), (LAS unsigned*)(lds + (bufoff) + ldsw + _i * 8192), 16, 0, 0); } while (0)
#define PG8_LDA(dst, b, h) do { _Pragma("unroll") for (int m = 0; m < 4; ++m) _Pragma("unroll") for (int k = 0; k < 2; ++k) dst[m][k] = *(const LAS bf16x8*)(lds + PG8_SA(b, h) + aoff + m * 2048 + k * 1024); } while (0)
#define PG8_LDB(dst, b, h) do { _Pragma("unroll") for (int n = 0; n < 2; ++n) _Pragma("unroll") for (int k = 0; k < 2; ++k) dst[n][k] = *(const LAS bf16x8*)(lds + PG8_SB(b, h) + boff + n * 2048 + k * 1024); } while (0)
#define PG8_MMA(ai, bj, At, Bt) do { __builtin_amdgcn_s_setprio(1); _Pragma("unroll") for (int m = 0; m < 4; ++m) _Pragma("unroll") for (int n = 0; n < 2; ++n) _Pragma("unroll") for (int k = 0; k < 2; ++k) \
        acc[ai][bj][m][n] = __builtin_amdgcn_mfma_f32_16x16x32_bf16(Bt[n][k], At[m][k], acc[ai][bj][m][n], 0, 0, 0); __builtin_amdgcn_s_setprio(0); } while (0)
#define PG8_WAIT_V(n) asm volatile("s_waitcnt vmcnt(" #n ")" ::: "memory")
#define PG8_WAIT_L(n) asm volatile("s_waitcnt lgkmcnt(" #n ")" ::: "memory")
#define PG8_BAR __builtin_amdgcn_s_barrier()
#define PG8_SCHED __builtin_amdgcn_sched_barrier(0)
    Unit cur, nxt; int ui = 0;
    if (!S.next(0, cur)) return;
    f32x4 acc[2][2][4][2];
#pragma unroll
    for (int a = 0; a < 2; ++a)
#pragma unroll
        for (int b = 0; b < 2; ++b)
#pragma unroll
            for (int m = 0; m < 4; ++m)
#pragma unroll
                for (int n = 0; n < 2; ++n) acc[a][b][m][n] = (f32x4){0.f, 0.f, 0.f, 0.f};
    bf16x8 At[4][2], B0[2][2], B1[2][2];
    const char* cA = cur.A; const char* cB = cur.B;
    PG8_STAGE(PG8_SB(0, 0), cB); PG8_STAGE(PG8_SB(0, 1), cB + hstep); PG8_STAGE(PG8_SA(0, 0), cA); PG8_STAGE(PG8_SA(0, 1), cA + hstep);
    if (wr == 1) PG8_BAR;
    PG8_WAIT_V(2); PG8_BAR;
    PG8_STAGE(PG8_SB(1, 0), cB + kstep); PG8_STAGE(PG8_SA(1, 0), cA + kstep); PG8_STAGE(PG8_SB(1, 1), cB + hstep + kstep);
    PG8_WAIT_V(6); PG8_BAR;
    for (;;) {
        const bool has_next = S.next(ui + 1, nxt);
        const char* nA = has_next ? nxt.A : cA; const char* nB = has_next ? nxt.B : cB;
#pragma unroll 1
        for (int t = 0; t < nt; t += 2) {
            const bool last = (t == nt - 2);
            const char* a1 = cA + (size_t)(t + 1) * kstep;
            const char* a2 = last ? nA : cA + (size_t)(t + 2) * kstep; const char* b2 = last ? nB : cB + (size_t)(t + 2) * kstep;
            const char* a3 = a2 + kstep; const char* b3 = b2 + kstep;
            PG8_LDB(B0, 0, 0); PG8_LDB(B1, 0, 1); PG8_SCHED; PG8_LDA(At, 0, 0); PG8_STAGE(PG8_SA(1, 1), a1 + hstep);
            PG8_WAIT_V(8); PG8_WAIT_L(0); PG8_BAR; PG8_MMA(0, 0, At, B0); PG8_MMA(0, 1, At, B1); PG8_BAR; PG8_SCHED;
            PG8_LDA(At, 0, 1); PG8_STAGE(PG8_SB(0, 0), b2); PG8_STAGE(PG8_SB(0, 1), b2 + hstep); PG8_STAGE(PG8_SA(0, 0), a2);
            PG8_WAIT_V(8); PG8_WAIT_L(0); PG8_BAR; PG8_MMA(1, 0, At, B0); PG8_MMA(1, 1, At, B1); PG8_BAR; PG8_SCHED;
            PG8_LDB(B0, 1, 0); PG8_LDB(B1, 1, 1); PG8_SCHED; PG8_LDA(At, 1, 0); PG8_STAGE(PG8_SA(0, 1), a2 + hstep);
            PG8_WAIT_V(8); PG8_WAIT_L(0); PG8_BAR; PG8_MMA(0, 0, At, B0); PG8_MMA(0, 1, At, B1); PG8_BAR; PG8_SCHED;
            PG8_LDA(At, 1, 1); PG8_STAGE(PG8_SB(1, 0), b3); PG8_STAGE(PG8_SB(1, 1), b3 + hstep); PG8_STAGE(PG8_SA(1, 0), a3);
            PG8_WAIT_V(8); PG8_WAIT_L(0); PG8_BAR; PG8_MMA(1, 0, At, B0); PG8_MMA(1, 1, At, B1); PG8_BAR; PG8_SCHED;
        }
        if (wr == 0) PG8_BAR;
        bool keep = false;
        if constexpr (MERGE) { if (cur.tag == 0) { E.mid(acc, cur, wr, wc, fr, fq); keep = true; } else E(acc, cur, wr, wc, fr, fq); } else E(acc, cur, wr, wc, fr, fq);
        if (!has_next) break;
        if (!keep) {
#pragma unroll
        for (int a = 0; a < 2; ++a)
#pragma unroll
            for (int b = 0; b < 2; ++b)
#pragma unroll
                for (int m = 0; m < 4; ++m)
#pragma unroll
                    for (int n = 0; n < 2; ++n) acc[a][b][m][n] = (f32x4){0.f, 0.f, 0.f, 0.f};
        }
        cur = nxt; cA = nA; cB = nB; ++ui;
        if (wr == 1) PG8_BAR;
    }
    PG8_WAIT_V(0);
    PG8_BAR;
#undef PG8_SA
#undef PG8_SB
#undef PG8_STAGE
#undef PG8_LDA
#undef PG8_LDB
#undef PG8_MMA
#undef PG8_WAIT_V
#undef PG8_WAIT_L
#undef PG8_BAR
#undef PG8_SCHED
}
}

struct Args {
    const float* in[24]; float* out; unsigned char* ws; int ph_lo, ph_hi;
};
struct Frame {
    LAS unsigned char* lds; unsigned char* ws;
    int tid, lane, wave, G, bid;
    const float* in[24]; float* out;
};
#define IN_X 0
#define IN_C 1
#define IN_POS 2
#define IN_G1 3
#define IN_G2 4
#define IN_WADA 5
#define IN_BADA 6
#define IN_WIN 7
#define IN_GAQ 8
#define IN_GAK 9
#define IN_GIDXK 10
#define IN_GMQA 11
#define IN_WMQUP 12
#define IN_GMKVA 13
#define IN_WMKVUP 14
#define IN_GMQ 15
#define IN_GMK 16
#define IN_WOA 17
#define IN_WOM 18
#define IN_WOUT 19
#define IN_WPQ 20
#define IN_SUBK 21
#define IN_PU 22
#define IN_PV 23

__device__ __forceinline__ void gemv8_block(const float* vec, int vstride, bool silu, const float* W, int N, float* out, const float* bias, int cb, LAS float* red, int wave, int lane, int tid, int kbeg = 0, int nkc = 2, bool accumulate = false) {
    const int j = cb * 64 + lane;
    float acc[8];
#pragma unroll
    for (int b = 0; b < 8; ++b) acc[b] = 0.f;
#pragma unroll 1
    for (int kc = 0; kc < nkc; ++kc) {
        const int k0 = kbeg + wave * (64 * nkc) + kc * 64;
        float cv[8];
#pragma unroll
        for (int b = 0; b < 8; ++b) { float v = vec[(size_t)b * vstride + k0 + lane]; if (silu) v = v * sigmoidf_(v); cv[b] = v; }
#pragma unroll 8
        for (int kk = 0; kk < 64; ++kk) {
            const float w = W[(size_t)(k0 + kk) * N + j];
#pragma unroll
            for (int b = 0; b < 8; ++b) acc[b] += rdlane_f(cv[b], kk) * w;
        }
    }
#pragma unroll
    for (int b = 0; b < 8; ++b) red[(wave * 8 + b) * 64 + lane] = acc[b];
    __syncthreads();
    { const int b = tid >> 6, l = tid & 63; float s = bias ? bias[cb * 64 + l] : 0.f;
#pragma unroll
      for (int w = 0; w < 8; ++w) s += red[(w * 8 + b) * 64 + l];
      if (accumulate) atomicAdd(out + (size_t)b * N + cb * 64 + l, s); else out[(size_t)b * N + cb * 64 + l] = s; }
    __syncthreads();
}

__device__ __forceinline__ int headperm(int d, int wc) { return 128 * (d >> 5) + 32 * wc + (d & 31); }
__device__ __forceinline__ int dest_win(int c) {
    if (c < 2048) { const int seg = c >> 9, hc = c & 511, h = hc >> 6, d = hc & 63; return (2 * seg + (h >> 2)) * 256 + headperm(d, h & 3); }
    if (c < 2112) { const int d = c - 2048; return 8 * 256 + headperm(d, 0); }
    if (c < 2120) return 8 * 256 + 128 + 32 + (c - 2112);
    if (c < 2504) return 9 * 256 + (c - 2120);
    if (c < 2760) return 11 * 256 + (c - 2504);
    if (c < 2792) return 8 * 256 + 32 + (c - 2760);
    if (c < 3816) return 12 * 256 + (c - 2792);
    return 16 * 256 + (c - 3816);
}
__device__ __forceinline__ int dest_qup(int c) {
    const int h = c / 96, dd = c % 96;
    if (dd < 64) return (h >> 2) * 256 + headperm(dd, h & 3);
    return 512 + 128 * (h & 1) + 32 * (h >> 1) + (dd - 64);
}
__device__ __forceinline__ int dest_kvup(int c) {
    const int h = c >> 7, dd = c & 127;
    return ((dd >> 6) * 2 + (h >> 2)) * 256 + headperm(dd & 63, h & 3);
}
template <int MODE>
__device__ __forceinline__ void transpose_item(const float* W, int K, int N, bf16_t* WT, const float* kscale, LAS float* scr, int item, int lane) {
    const int nblk = (N + 31) / 32, kb = item / nblk, nb = item % nblk, k0 = 64 * kb, n0 = 32 * nb;
#pragma unroll 8
    for (int i = 0; i < 32; ++i) {
        const int kk = 2 * i + (lane >> 5), n = n0 + (lane & 31);
        float v = (n < N) ? W[(size_t)(k0 + kk) * N + n] : 0.f;
        if (kscale) v *= kscale[k0 + kk];
        scr[kk * 33 + (lane & 31)] = v;
    }
    LDS_WAIT(); asm volatile("" ::: "memory");
    const int c = lane & 7;
#pragma unroll
    for (int j = 0; j < 4; ++j) {
        const int nn = (lane >> 3) + 8 * j, n = n0 + nn;
        if (n < N) {
            const LAS float* s = scr + (8 * c) * 33 + nn;
            u32x4 o; o.x = cvtpk_s(s[0 * 33], s[1 * 33]); o.y = cvtpk_s(s[2 * 33], s[3 * 33]); o.z = cvtpk_s(s[4 * 33], s[5 * 33]); o.w = cvtpk_s(s[6 * 33], s[7 * 33]);
            const int d = (MODE == 0) ? n : (MODE == 1) ? dest_win(n) : (MODE == 2) ? dest_qup(n) : dest_kvup(n);
            *(u32x4*)(WT + (size_t)d * K + k0 + 8 * c) = o;
        }
    }
    LDS_WAIT(); asm volatile("" ::: "memory");
}
__device__ __forceinline__ void cvt_bf16_stream(const float* src, bf16_t* dst, size_t n, size_t gtid, size_t gthreads) {
    for (size_t i = gtid * 8; i < n; i += gthreads * 8) {
        const f32x4 a = *(const f32x4*)(src + i), b = *(const f32x4*)(src + i + 4);
        u32x4 o; o.x = cvtpk_s(a.x, a.y); o.y = cvtpk_s(a.z, a.w); o.z = cvtpk_s(b.x, b.y); o.w = cvtpk_s(b.z, b.w);
        *(u32x4*)(dst + i) = o;
    }
}
__device__ __forceinline__ void cvt_fp4_rows(const float* src, unsigned char* dst, float* inv, int nrows, int gw, int NGW, int lane) {
    for (int row = gw; row < nrows; row += NGW) {
        const f32x4* p = (const f32x4*)(src + (size_t)row * DM) + 4 * lane;
        f32x4 v[4]; float am = 0.f;
#pragma unroll
        for (int j = 0; j < 4; ++j) { v[j] = p[j]; am = __builtin_fmaxf(am, __builtin_fmaxf(__builtin_fmaxf(fabsf(v[j].x), fabsf(v[j].y)), __builtin_fmaxf(fabsf(v[j].z), fabsf(v[j].w)))); }
#pragma unroll
        for (int o = 1; o < 64; o <<= 1) am = __builtin_fmaxf(am, __shfl_xor(am, o));
        am = __builtin_fmaxf(am, 1e-30f);
        const float sc = 6.f / am;
        if (lane == 0) inv[row] = am * (1.f / 6.f);
        unsigned w0 = 0u, w1 = 0u;
        w0 = __builtin_amdgcn_cvt_scalef32_pk_fp4_f32(w0, v[0].x * sc, v[0].y * sc, 1.0f, 0); w0 = __builtin_amdgcn_cvt_scalef32_pk_fp4_f32(w0, v[0].z * sc, v[0].w * sc, 1.0f, 1);
        w0 = __builtin_amdgcn_cvt_scalef32_pk_fp4_f32(w0, v[1].x * sc, v[1].y * sc, 1.0f, 2); w0 = __builtin_amdgcn_cvt_scalef32_pk_fp4_f32(w0, v[1].z * sc, v[1].w * sc, 1.0f, 3);
        w1 = __builtin_amdgcn_cvt_scalef32_pk_fp4_f32(w1, v[2].x * sc, v[2].y * sc, 1.0f, 0); w1 = __builtin_amdgcn_cvt_scalef32_pk_fp4_f32(w1, v[2].z * sc, v[2].w * sc, 1.0f, 1);
        w1 = __builtin_amdgcn_cvt_scalef32_pk_fp4_f32(w1, v[3].x * sc, v[3].y * sc, 1.0f, 2); w1 = __builtin_amdgcn_cvt_scalef32_pk_fp4_f32(w1, v[3].z * sc, v[3].w * sc, 1.0f, 3);
        *((u32x2*)(dst + (size_t)row * (DM / 2)) + lane) = (u32x2){w0, w1};
    }
}
__device__ __forceinline__ void cvt_i4_rows(const float* src, unsigned char* dst, float* inv, int nrows, int gw, int NGW, int lane) {
    for (int row = gw; row < nrows; row += NGW) {
        const f32x4* p = (const f32x4*)(src + (size_t)row * DM) + 4 * lane;
        f32x4 v[4]; float am = 0.f;
#pragma unroll
        for (int j = 0; j < 4; ++j) { v[j] = p[j]; am = __builtin_fmaxf(am, __builtin_fmaxf(__builtin_fmaxf(fabsf(v[j].x), fabsf(v[j].y)), __builtin_fmaxf(fabsf(v[j].z), fabsf(v[j].w)))); }
#pragma unroll
        for (int o = 1; o < 64; o <<= 1) am = __builtin_fmaxf(am, __shfl_xor(am, o));
        am = __builtin_fmaxf(am, 1e-30f);
        const float sc = 9.5f / am;
        if (lane == 0) inv[row] = am * (1.f / 9.5f);
        unsigned w[2] = {0u, 0u};
#pragma unroll
        for (int j = 0; j < 4; ++j) {
#pragma unroll
            for (int e = 0; e < 4; ++e) { const float x = __builtin_amdgcn_fmed3f(__builtin_rintf(v[j][e] * sc), -7.f, 7.f); w[j >> 1] |= ((unsigned)(int)x & 15u) << (4 * (4 * (j & 1) + e)); }
        }
        *((u32x2*)(dst + (size_t)row * (DM / 2)) + lane) = (u32x2){w[0], w[1]};
    }
}
__device__ __forceinline__ void rope_cs(int pos, int i, int half, float& c, float& s) {
    const float inv = (float)exp(-9.210340371976184 * (double)i / (double)half);
    const float ang = (float)pos * inv;
    double x = (double)ang * 0.15915494309189535;
    x -= rint(x);
    const float xf = (float)x;
    c = __builtin_amdgcn_cosf(xf); s = __builtin_amdgcn_sinf(xf);
}

__device__ __forceinline__ void phase0(Frame& F) {
    const int gw = F.bid * NWAVES + F.wave, NGW = F.G * NWAVES;
    unsigned char* ws = F.ws;
    for (int cb = F.G - 1 - F.bid; cb < 96; cb += F.G) gemv8_block(F.in[IN_C], DM, true, F.in[IN_WADA], 6144, (float*)(ws + WS_MOD), F.in[IN_BADA], cb, (LAS float*)(F.lds + 8 * 16384), F.wave, F.lane, F.tid);
    { const size_t gt = (size_t)F.bid * NTHREADS + F.tid, gn = (size_t)F.G * NTHREADS; u32x4* z = (u32x4*)(ws + WS_SSQ_CQ);
      for (size_t i = gt; i < (WS_MOD - WS_SSQ_CQ) / 16; i += gn) z[i] = (u32x4){0u, 0u, 0u, 0u};
      for (size_t i = gt; i < (size_t)NB * 2048 / 4; i += gn) ((u32x4*)(ws + WS_BIASQ))[i] = (u32x4){0u, 0u, 0u, 0u};
      for (size_t i = gt; i < 3456; i += gn) ((unsigned*)(ws + WS_BAR))[i] = 0u;
    }
}
__device__ __forceinline__ void phase0b(Frame& F) {
    const int gw = F.bid * NWAVES + F.wave, NGW = F.G * NWAVES; (void)gw; (void)NGW;
    unsigned char* ws = F.ws;
    LAS float* scr = (LAS float*)(F.lds + F.wave * 16384);
    constexpr int I_WIN = 16 * 152, I_QUP = 6 * 24, I_KVUP = 4 * 32, I_OA = 8 * 32, I_OUT = 16 * 32, I_PQ = 16 * 64;
    constexpr int NITEMS = I_WIN + I_QUP + I_KVUP + 2 * I_OA + I_OUT + I_PQ;
    const int ntw_ = F.G; const bool tr_wg = true;
    for (int it = F.bid * NWAVES + F.wave; tr_wg && it < NITEMS; it += ntw_ * NWAVES) {
        int r = it;
        if (r < I_WIN) { transpose_item<1>(F.in[IN_WIN], DM, IN_WIDTH, (bf16_t*)(ws + WS_WIN), nullptr, scr, r, F.lane); continue; } r -= I_WIN;
        if (r < I_QUP) { transpose_item<2>(F.in[IN_WMQUP], QRANK, 768, (bf16_t*)(ws + WS_WQUP), F.in[IN_GMQA], scr, r, F.lane); continue; } r -= I_QUP;
        if (r < I_KVUP) { transpose_item<3>(F.in[IN_WMKVUP], KVRANK, 1024, (bf16_t*)(ws + WS_WKVUP), F.in[IN_GMKVA], scr, r, F.lane); continue; } r -= I_KVUP;
        if (r < I_OA) { transpose_item<0>(F.in[IN_WOA], AW, DM, (bf16_t*)(ws + WS_WOA), nullptr, scr, r, F.lane); continue; } r -= I_OA;
        if (r < I_OA) { transpose_item<0>(F.in[IN_WOM], AW, DM, (bf16_t*)(ws + WS_WOM), nullptr, scr, r, F.lane); continue; } r -= I_OA;
        if (r < I_OUT) { transpose_item<0>(F.in[IN_WOUT], DM, DM, (bf16_t*)(ws + WS_WOUT), nullptr, scr, r, F.lane); continue; } r -= I_OUT;
        transpose_item<0>(F.in[IN_WPQ], DM, 2048, (bf16_t*)(ws + WS_WPQ), nullptr, scr, r, F.lane);
    }
    const size_t gtid = (size_t)F.bid * NTHREADS + F.tid, gth = (size_t)F.G * NTHREADS;
    cvt_bf16_stream(F.in[IN_SUBK], (bf16_t*)(ws + WS_SUBK), (size_t)16 * 128 * 128, gtid, gth);
    const int* pos = (const int*)F.in[IN_POS];
    float* r32 = (float*)(ws + WS_ROPE32); float* r16 = (float*)(ws + WS_ROPE16);
    for (size_t e = gtid; e < (size_t)T * 48; e += gth) {
        const int t = (int)(e / 48), i = (int)(e % 48); const int p = pos[t]; float c, s;
        if (i < 32) { rope_cs(p, i, 32, c, s); r32[(size_t)t * 64 + i] = c; r32[(size_t)t * 64 + 32 + i] = s; }
        else { rope_cs(p, i - 32, 16, c, s); r16[(size_t)t * 32 + (i - 32)] = c; r16[(size_t)t * 32 + 16 + (i - 32)] = s; }
    }
}

__device__ __forceinline__ float wave_sum(float v) {
#pragma unroll
    for (int o = 1; o < 64; o <<= 1) v += __shfl_xor(v, o);
    return v;
}
__device__ __forceinline__ void phase1(Frame& F) {
    phase0b(F);
    __syncthreads();
    const int gw = F.bid * NWAVES + F.wave, NGW = F.G * NWAVES;
    const float* mod = (const float*)(F.ws + WS_MOD);
    for (int tk = F.G - 1 - F.bid; tk < 64; tk += F.G) gemv8_block(mod + 3072, 6144, false, F.in[IN_WPQ], 2048, (float*)(F.ws + WS_BIASQ), nullptr, tk & 31, (LAS float*)F.lds, F.wave, F.lane, F.tid, (tk >> 5) * 512, 1, true);
    const float* g1 = F.in[IN_G1];
    bf16_t* XN = (bf16_t*)(F.ws + WS_XN);
    for (int m0 = 2 * gw; m0 < T; m0 += 2 * NGW) {
        f32x4 v[2][4]; float s[2] = {0.f, 0.f};
#pragma unroll
        for (int u = 0; u < 2; ++u) { const f32x4* xr = (const f32x4*)(F.in[IN_X] + (size_t)(m0 + u) * DM) + F.lane;
#pragma unroll
            for (int j = 0; j < 4; ++j) v[u][j] = xr[64 * j]; }
#pragma unroll
        for (int u = 0; u < 2; ++u)
#pragma unroll
            for (int j = 0; j < 4; ++j) s[u] += (v[u][j].x * v[u][j].x + v[u][j].y * v[u][j].y) + (v[u][j].z * v[u][j].z + v[u][j].w * v[u][j].w);
#pragma unroll
        for (int u = 0; u < 2; ++u) {
            const int m = m0 + u, b = m / SEQ;
            const float rinv = __builtin_amdgcn_rsqf(wave_sum(s[u]) * (1.f / DM) + EPS);
            unsigned long long* o8 = (unsigned long long*)(XN + (size_t)m * DM) + F.lane;
#pragma unroll
            for (int j = 0; j < 4; ++j) {
                const int col = 4 * F.lane + 256 * j;
                const f32x4 g = *(const f32x4*)(g1 + col), sh = *(const f32x4*)(mod + (size_t)b * 6144 + col), sc = *(const f32x4*)(mod + (size_t)b * 6144 + 1024 + col);
                const f32x4 h = v[u][j] * rinv * g * (sc + 1.0f) + sh;
                o8[64 * j] = (unsigned long long)cvtpk_s(h.x, h.y) | ((unsigned long long)cvtpk_s(h.z, h.w) << 32);
            }
        }
    }
}

__device__ __forceinline__ u32x2 pk4(const f32x4 v) { u32x2 o; o.x = cvtpk_s(v.x, v.y); o.y = cvtpk_s(v.z, v.w); return o; }
__device__ __forceinline__ void st8(bf16_t* grp, const u32x2 X, const u32x2 Y, int fq) {
    auto r0 = __builtin_amdgcn_permlane16_swap(X.x, Y.x, false, false); auto r1 = __builtin_amdgcn_permlane16_swap(X.y, Y.y, false, false);
    *(u32x4*)(grp + 8 * (fq >> 1) + 16 * (fq & 1)) = (u32x4){r0[0], r1[0], r0[1], r1[1]};
}
__device__ __forceinline__ void ld8(const bf16_t* grp, u32x2& X, u32x2& Y, int fq) {
    const u32x4 w = *(const u32x4*)(grp + 8 * (fq >> 1) + 16 * (fq & 1));
    auto r0 = __builtin_amdgcn_permlane16_swap(w[0], w[2], false, false); auto r1 = __builtin_amdgcn_permlane16_swap(w[1], w[3], false, false);
    X = (u32x2){r0[0], r1[0]}; Y = (u32x2){r0[1], r1[1]};
}
__device__ __forceinline__ float sum4sq(const f32x4 v) { return (v.x * v.x + v.y * v.y) + (v.z * v.z + v.w * v.w); }
__device__ __forceinline__ float fq_sum(float s) {
    { auto r = __builtin_amdgcn_permlane16_swap(__float_as_uint(s), __float_as_uint(s), false, false); s = __uint_as_float(r[0]) + __uint_as_float(r[1]); }
    { auto r = __builtin_amdgcn_permlane32_swap(__float_as_uint(s), __float_as_uint(s), false, false); s = __uint_as_float(r[0]) + __uint_as_float(r[1]); }
    return s;
}

struct EpiIn {
    unsigned char* ws; const float* gaq; const float* gak; const float* gidxk; const float* gmk;
    template <bool NORM>
    __device__ __forceinline__ void normrope64(const f32x4 (&acc)[2][2][4][2], int row0, int fq, const float* gain, float scale, bf16_t* dst, int pitch, int colbase) const {
        const float* rope = (const float*)(ws + WS_ROPE32);
        f32x4 gv[2][2];
#pragma unroll
        for (int bj = 0; bj < 2; ++bj)
#pragma unroll
            for (int n = 0; n < 2; ++n) gv[bj][n] = NORM ? *(const f32x4*)(gain + 32 * bj + 16 * n + 4 * fq) * scale : (f32x4){scale, scale, scale, scale};
#pragma unroll
        for (int ai = 0; ai < 2; ++ai)
#pragma unroll
            for (int m = 0; m < 4; ++m) {
                const int row = row0 + 128 * ai + 16 * m;
                float rinv = 1.f;
                if (NORM) {
                    float s = 0.f;
#pragma unroll
                    for (int bj = 0; bj < 2; ++bj)
#pragma unroll
                        for (int n = 0; n < 2; ++n) s += sum4sq(acc[ai][bj][m][n]);
                    rinv = __builtin_amdgcn_rsqf(fq_sum(s) * (1.f / 64.f) + EPS);
                }
                bf16_t* o = dst + (size_t)row * pitch + colbase; u32x2 lo[2], hi[2];
#pragma unroll
                for (int n = 0; n < 2; ++n) {
                    const f32x4 cs = *(const f32x4*)(rope + (size_t)row * 64 + 16 * n + 4 * fq), sn = *(const f32x4*)(rope + (size_t)row * 64 + 32 + 16 * n + 4 * fq);
                    const f32x4 x1 = acc[ai][0][m][n] * rinv * gv[0][n], x2 = acc[ai][1][m][n] * rinv * gv[1][n];
                    lo[n] = pk4(x1 * cs - x2 * sn); hi[n] = pk4(x2 * cs + x1 * sn);
                }
                st8(o, lo[0], lo[1], fq); st8(o + 32, hi[0], hi[1], fq);
                asm volatile("" ::: "memory");
            }
    }
    __device__ __forceinline__ void operator()(const f32x4 (&acc)[2][2][4][2], const pg8::Unit& u, int wr, int wc, int fr, int fq) const {
        const int pn = u.pn, row0 = u.pm * 256 + wr * 64 + fr;
        if (pn < 2) { normrope64<true>(acc, row0, fq, gaq, C2A, (bf16_t*)(ws + WS_QA), AW, ((pn & 1) * 4 + wc) * 64); return; }
        if (pn < 4) { normrope64<true>(acc, row0, fq, gak, 1.f, (bf16_t*)(ws + WS_KA), AW, ((pn & 1) * 4 + wc) * 64); return; }
        if (pn < 6) {
            bf16_t* dst = (bf16_t*)(ws + WS_VA);
#pragma unroll
            for (int ai = 0; ai < 2; ++ai)
#pragma unroll
                for (int m = 0; m < 4; ++m) { bf16_t* o = dst + (size_t)(row0 + 128 * ai + 16 * m) * AW + ((pn & 1) * 4 + wc) * 64;
#pragma unroll
                    for (int bj = 0; bj < 2; ++bj) st8(o + 32 * bj, pk4(acc[ai][bj][m][0]), pk4(acc[ai][bj][m][1]), fq); asm volatile("" ::: "memory"); }
            return;
        }
        if (pn < 8) { normrope64<false>(acc, row0, fq, nullptr, 1.f, (bf16_t*)(ws + WS_QI), AW, ((pn & 1) * 4 + wc) * 64); return; }
        if (pn == 8) {
            if (wc == 0) { normrope64<true>(acc, row0, fq, gidxk, 1.f, (bf16_t*)(ws + WS_KI), 64, 0); return; }
            if (wc == 1) {
                const float* rope = (const float*)(ws + WS_ROPE16);
                float* kper = (float*)(ws + WS_KPER); float* kss = (float*)(ws + WS_KPESSQ); float* wi = (float*)(ws + WS_WI);
                const f32x4 g1 = *(const f32x4*)(gmk + 64 + 4 * fq), g2 = *(const f32x4*)(gmk + 80 + 4 * fq);
#pragma unroll
                for (int ai = 0; ai < 2; ++ai)
#pragma unroll
                    for (int m = 0; m < 4; ++m) {
                        const int row = row0 + 128 * ai + 16 * m;
                        const f32x4 a = acc[ai][0][m][0], b = acc[ai][0][m][1];
                        const float s = fq_sum(sum4sq(a) + sum4sq(b));
                        if (fq == 0) kss[row] = s;
                        const f32x4 cs = *(const f32x4*)(rope + (size_t)row * 32 + 4 * fq), sn = *(const f32x4*)(rope + (size_t)row * 32 + 16 + 4 * fq);
                        const f32x4 x1 = a * g1, x2 = b * g2;
                        *(f32x4*)(kper + (size_t)row * 32 + 4 * fq) = x1 * cs - x2 * sn;
                        *(f32x4*)(kper + (size_t)row * 32 + 16 + 4 * fq) = x2 * cs + x1 * sn;
                        if (fq < 2) *(f32x4*)(wi + (size_t)row * 8 + 4 * fq) = acc[ai][1][m][0] * 0.044194173824159216f;
                        asm volatile("" ::: "memory");
                    }
            }
            return;
        }
        if (pn < 12) {
            const bool isq = pn < 11; const int cb = isq ? (pn - 9) * 256 : 0, width = isq ? QRANK : KVRANK;
            bf16_t* dst = (bf16_t*)(ws + (isq ? WS_CQ : WS_CKV)); float* ssq = (float*)(ws + (isq ? WS_SSQ_CQ : WS_SSQ_CKV));
#pragma unroll
            for (int ai = 0; ai < 2; ++ai)
#pragma unroll
                for (int m = 0; m < 4; ++m) {
                    const int row = row0 + 128 * ai + 16 * m; float s = 0.f;
#pragma unroll
                    for (int bj = 0; bj < 2; ++bj) { const int col = cb + 128 * bj + 32 * wc;
                        if (col < width) { st8(dst + (size_t)row * width + col, pk4(acc[ai][bj][m][0]), pk4(acc[ai][bj][m][1]), fq); s += sum4sq(acc[ai][bj][m][0]) + sum4sq(acc[ai][bj][m][1]); } }
                    s = fq_sum(s);
                    if (fq == 0) atomicAdd(ssq + row, s);
                    asm volatile("" ::: "memory");
                }
            return;
        }
        {
            bf16_t* dst = (bf16_t*)(ws + (pn < 16 ? WS_GA : WS_GM)); const int cb = ((pn - 12) & 3) * 256 + 32 * wc;
#pragma unroll
            for (int ai = 0; ai < 2; ++ai)
#pragma unroll
                for (int m = 0; m < 4; ++m) { bf16_t* o = dst + (size_t)(row0 + 128 * ai + 16 * m) * DM + cb;
#pragma unroll
                    for (int bj = 0; bj < 2; ++bj) { const f32x4 v = acc[ai][bj][m][0], w = acc[ai][bj][m][1];
                        st8(o + 128 * bj, pk4((f32x4){sigmoidf_(v.x), sigmoidf_(v.y), sigmoidf_(v.z), sigmoidf_(v.w)}), pk4((f32x4){sigmoidf_(w.x), sigmoidf_(w.y), sigmoidf_(w.z), sigmoidf_(w.w)}), fq); } asm volatile("" ::: "memory"); }
        }
    }
};

struct EpiQup {
    unsigned char* ws; const float* gmq;
    __device__ __forceinline__ void operator()(const f32x4 (&acc)[2][2][4][2], const pg8::Unit& u, int wr, int wc, int fr, int fq) const {
        const int pn = u.pn, row0 = u.pm * 256 + wr * 64 + fr;
        const float* ssqc = (const float*)(ws + WS_SSQ_CQ); float* ssqm = (float*)(ws + WS_SSQ_QM);
        if (pn < 2) {
            const int head = pn * 4 + wc; bf16_t* dst = (bf16_t*)(ws + WS_QMN);
            f32x4 gv[2][2];
#pragma unroll
            for (int bj = 0; bj < 2; ++bj)
#pragma unroll
                for (int n = 0; n < 2; ++n) gv[bj][n] = *(const f32x4*)(gmq + 32 * bj + 16 * n + 4 * fq) * C2B;
#pragma unroll
            for (int ai = 0; ai < 2; ++ai)
#pragma unroll
                for (int m = 0; m < 4; ++m) {
                    const int row = row0 + 128 * ai + 16 * m;
                    const float rc = __builtin_amdgcn_rsqf(ssqc[row] * (1.f / QRANK) + EPS);
                    float s = 0.f; bf16_t* o = dst + (size_t)row * 512 + head * 64;
#pragma unroll
                    for (int bj = 0; bj < 2; ++bj) { const f32x4 q0 = acc[ai][bj][m][0] * rc, q1 = acc[ai][bj][m][1] * rc; s += sum4sq(q0) + sum4sq(q1); st8(o + 32 * bj, pk4(q0 * gv[bj][0]), pk4(q1 * gv[bj][1]), fq); }
                    s = fq_sum(s);
                    if (fq == 0) atomicAdd(ssqm + (size_t)row * 8 + head, s);
                    asm volatile("" ::: "memory");
                }
            return;
        }
        {
            const float* rope = (const float*)(ws + WS_ROPE16); bf16_t* dst = (bf16_t*)(ws + WS_QMR);
            const f32x4 g1 = *(const f32x4*)(gmq + 64 + 4 * fq) * C2B, g2 = *(const f32x4*)(gmq + 80 + 4 * fq) * C2B;
#pragma unroll
            for (int ai = 0; ai < 2; ++ai)
#pragma unroll
                for (int m = 0; m < 4; ++m) {
                    const int row = row0 + 128 * ai + 16 * m;
                    const float rc = __builtin_amdgcn_rsqf(ssqc[row] * (1.f / QRANK) + EPS);
                    const f32x4 cs = *(const f32x4*)(rope + (size_t)row * 32 + 4 * fq), sn = *(const f32x4*)(rope + (size_t)row * 32 + 16 + 4 * fq);
#pragma unroll
                    for (int bj = 0; bj < 2; ++bj) {
                        const int head = 2 * wc + bj;
                        const f32x4 a = acc[ai][bj][m][0] * rc, b = acc[ai][bj][m][1] * rc;
                        const float s = fq_sum(sum4sq(a) + sum4sq(b));
                        if (fq == 0) atomicAdd(ssqm + (size_t)row * 8 + head, s);
                        const f32x4 x1 = a * g1, x2 = b * g2;
                        st8(dst + (size_t)row * 256 + head * 32, pk4(x1 * cs - x2 * sn), pk4(x2 * cs + x1 * sn), fq);
                    }
                    asm volatile("" ::: "memory");
                }
        }
    }
};
struct EpiKVup {
    unsigned char* ws; const float* gmk;
    __device__ __forceinline__ void operator()(const f32x4 (&acc)[2][2][4][2], const pg8::Unit& u, int wr, int wc, int fr, int fq) const {
        const int pn = u.pn, row0 = u.pm * 256 + wr * 64 + fr, head = (pn & 1) * 4 + wc;
        const float* ssqc = (const float*)(ws + WS_SSQ_CKV);
        if (pn < 2) {
            const float* kss = (const float*)(ws + WS_KPESSQ); const float* kper = (const float*)(ws + WS_KPER);
            bf16_t* dn = (bf16_t*)(ws + WS_KMN); bf16_t* dr = (bf16_t*)(ws + WS_KMR);
            f32x4 gv[2][2];
#pragma unroll
            for (int bj = 0; bj < 2; ++bj)
#pragma unroll
                for (int n = 0; n < 2; ++n) gv[bj][n] = *(const f32x4*)(gmk + 32 * bj + 16 * n + 4 * fq);
#pragma unroll
            for (int ai = 0; ai < 2; ++ai)
#pragma unroll
                for (int m = 0; m < 4; ++m) {
                    const int row = row0 + 128 * ai + 16 * m;
                    const float rc = __builtin_amdgcn_rsqf(ssqc[row] * (1.f / KVRANK) + EPS);
                    float s = 0.f; f32x4 kn[2][2];
#pragma unroll
                    for (int bj = 0; bj < 2; ++bj)
#pragma unroll
                        for (int n = 0; n < 2; ++n) { kn[bj][n] = acc[ai][bj][m][n] * rc; s += sum4sq(kn[bj][n]); }
                    s = fq_sum(s) + kss[row];
                    const float rinv = __builtin_amdgcn_rsqf(s * (1.f / MQK) + EPS);
                    bf16_t* o = dn + (size_t)row * 512 + head * 64;
#pragma unroll
                    for (int bj = 0; bj < 2; ++bj) st8(o + 32 * bj, pk4(kn[bj][0] * gv[bj][0] * rinv), pk4(kn[bj][1] * gv[bj][1] * rinv), fq);
                    const f32x4 ra = *(const f32x4*)(kper + (size_t)row * 32 + 8 * fq) * rinv, rb = *(const f32x4*)(kper + (size_t)row * 32 + 8 * fq + 4) * rinv;
                    u32x4 w; w.x = cvtpk_s(ra.x, ra.y); w.y = cvtpk_s(ra.z, ra.w); w.z = cvtpk_s(rb.x, rb.y); w.w = cvtpk_s(rb.z, rb.w);
                    *(u32x4*)(dr + (size_t)row * 256 + head * 32 + 8 * fq) = w;
                    asm volatile("" ::: "memory");
                }
            return;
        }
        {
            bf16_t* dst = (bf16_t*)(ws + WS_VM);
#pragma unroll
            for (int ai = 0; ai < 2; ++ai)
#pragma unroll
                for (int m = 0; m < 4; ++m) {
                    const int row = row0 + 128 * ai + 16 * m;
                    const float rc = __builtin_amdgcn_rsqf(ssqc[row] * (1.f / KVRANK) + EPS);
                    bf16_t* o = dst + (size_t)row * 512 + head * 64;
#pragma unroll
                    for (int bj = 0; bj < 2; ++bj) st8(o + 32 * bj, pk4(acc[ai][bj][m][0] * rc), pk4(acc[ai][bj][m][1] * rc), fq);
                    asm volatile("" ::: "memory");
                }
        }
    }
};

constexpr int SC_PITCH = 4104, IDX_SC_BYTES = 16 * SC_PITCH * 2, IDX_MW_OFF = IDX_SC_BYTES;
static_assert(IDX_MW_OFF % 16 == 0 && IDX_MW_OFF + 16 * 64 * 8 <= LDS_BYTES, "indexer LDS");
__device__ __forceinline__ int suffix_sum64(int v, int lane) {
#pragma unroll
    for (int o = 1; o < 64; o <<= 1) { const int t = __shfl_down(v, o); v += (lane + o < 64) ? t : 0; }
    return v;
}
__device__ __forceinline__ void radix_level(LAS unsigned* hist, int lane, int want, int& bsel, int& cabove) {
    u32x4 c = *(const LAS u32x4*)(hist + 4 * lane);
#pragma unroll
    for (int k = 1; k < 4; ++k) c += *(const LAS u32x4*)(hist + 256 * k + 4 * lane);
#pragma unroll
    for (int k = 0; k < 4; ++k) *(LAS u32x4*)(hist + 256 * k + 4 * lane) = (u32x4){0u, 0u, 0u, 0u};
    const int s = (int)(c.x + c.y + c.z + c.w), S = suffix_sum64(s, lane);
    int above = S - s, b = -1, ca = 0;
    if (above < want && S >= want) {
        if (above + (int)c.w >= want) { b = 4 * lane + 3; ca = above; }
        else if (above + (int)(c.w + c.z) >= want) { b = 4 * lane + 2; ca = above + (int)c.w; }
        else if (above + (int)(c.w + c.z + c.y) >= want) { b = 4 * lane + 1; ca = above + (int)(c.w + c.z); }
        else { b = 4 * lane; ca = above + (int)(c.w + c.z + c.y); }
    }
    const unsigned long long m = __builtin_amdgcn_ballot_w64(b >= 0);
    const int src = (int)__builtin_ctzll(m | (1ull << 63));
    bsel = __builtin_amdgcn_readlane(b, src); cabove = __builtin_amdgcn_readlane(ca, src);
}
__device__ __forceinline__ void indexer_phase(Frame& F) {
    const bf16_t* QI = (const bf16_t*)(F.ws + WS_QI); const bf16_t* KI = (const bf16_t*)(F.ws + WS_KI); const float* WI = (const float*)(F.ws + WS_WI);
    unsigned long long* MASK = (unsigned long long*)(F.ws + WS_MASK);
    LAS unsigned short* SC = (LAS unsigned short*)F.lds;
    LAS unsigned long long* MW = (LAS unsigned long long*)(F.lds + IDX_MW_OFF);
    const int lane = F.lane, wid = F.wave;
    for (int item = F.bid; item < NB * 256; item += F.G) {
        int lq = lane; asm volatile("" : "+v"(lq)); const int q = lq & 15, kq = lq >> 4;
        const int b = item >> 8, gi = item & 255, g = (b & 1) ? 255 - gi : gi, t0 = 16 * g, nkt = g + 1;
        const size_t rowq = (size_t)b * SEQ + t0 + q;
        bf16x8 bq[8][2]; float wv[8];
#pragma unroll
        for (int h = 0; h < 8; ++h) {
#pragma unroll
            for (int ks = 0; ks < 2; ++ks) bq[h][ks] = *(const bf16x8*)(QI + rowq * 512 + h * 64 + 32 * ks + 8 * kq);
            wv[h] = WI[rowq * 8 + h];
        }
        const bf16_t* kbase = KI + ((size_t)b * SEQ + q) * 64 + 8 * kq;
        const int ntw = (nkt - wid + NWAVES - 1) / NWAVES;
        bf16x8 ka[4][2], kn[4][2];
#define IDX_KLOAD(u, jj) do { int kt_ = wid + NWAVES * (jj); kt_ = kt_ < nkt ? kt_ : nkt - 1; const bf16_t* kp = kbase + (size_t)16 * kt_ * 64; kn[u][0] = *(const bf16x8*)kp; kn[u][1] = *(const bf16x8*)(kp + 32); } while (0)
#define IDX_TILE(u, jj) do { const int kt = wid + NWAVES * (jj); \
                f32x4 sc = (f32x4){0.f, 0.f, 0.f, 0.f}; \
                _Pragma("unroll") for (int h = 0; h < 8; ++h) { \
                    f32x4 c = __builtin_amdgcn_mfma_f32_16x16x32_bf16(ka[u][0], bq[h][0], (f32x4){0.f, 0.f, 0.f, 0.f}, 0, 0, 0); \
                    c = __builtin_amdgcn_mfma_f32_16x16x32_bf16(ka[u][1], bq[h][1], c, 0, 0, 0); \
                    _Pragma("unroll") for (int i = 0; i < 4; ++i) sc[i] += __builtin_amdgcn_fmed3f(c[i], 0.f, 3.0e38f) * wv[h]; } \
                unsigned short kk[4]; \
                _Pragma("unroll") for (int i = 0; i < 4; ++i) { const _Float16 hsc = (_Float16)(sc[i] + 0.0f); const unsigned short bits = __builtin_bit_cast(unsigned short, hsc); \
                    kk[i] = (bits & 0x8000u) ? (unsigned short)~bits : (unsigned short)(bits | 0x8000u); } \
                u32x2 w; w.x = (unsigned)kk[0] | ((unsigned)kk[1] << 16); w.y = (unsigned)kk[2] | ((unsigned)kk[3] << 16); \
                *(LAS u32x2*)(SC + q * SC_PITCH + 16 * kt + 4 * kq) = w; } while (0)
#pragma unroll
        for (int u = 0; u < 4; ++u) IDX_KLOAD(u, u);
        for (int j0 = 0; j0 < ntw; j0 += 4) {
#pragma unroll
            for (int u = 0; u < 4; ++u) { ka[u][0] = kn[u][0]; ka[u][1] = kn[u][1]; }
#pragma unroll
            for (int u = 0; u < 4; ++u) IDX_KLOAD(u, j0 + 4 + u);
            if (j0 + 4 <= ntw) { IDX_TILE(0, j0); IDX_TILE(1, j0 + 1); IDX_TILE(2, j0 + 2); IDX_TILE(3, j0 + 3); }
            else { IDX_TILE(0, j0); if (j0 + 1 < ntw) IDX_TILE(1, j0 + 1); if (j0 + 2 < ntw) IDX_TILE(2, j0 + 2); }
        }
#undef IDX_KLOAD
#undef IDX_TILE
        __syncthreads();
#pragma unroll 1
        for (int qi = 0; qi < 2; ++qi) {
            const int qq = 2 * wid + qi, t = t0 + qq, nr = (t >> 6) + 1;
            unsigned key[64];
#pragma unroll
            for (int r = 0; r < 64; ++r) { const int s = 64 * r + lane; key[r] = (r < nr && s <= t) ? (unsigned)SC[qq * SC_PITCH + s] : 0u; }
            unsigned thr = 0u; int need = 0;
            LAS unsigned* hist = (LAS unsigned*)(SC + qq * SC_PITCH);
            if (t + 1 > NSEL) {
                LDS_WAIT();
#pragma unroll
                for (int k = 0; k < 4; ++k) *(LAS u32x4*)(hist + 256 * k + 4 * lane) = (u32x4){0u, 0u, 0u, 0u};
                LAS unsigned* hmine = hist + 256 * (lane & 3);
#pragma unroll
                for (int r8 = 0; r8 < 8; ++r8) if (8 * r8 < nr) {
#pragma unroll
                    for (int r = 8 * r8; r < 8 * r8 + 8; ++r) if (key[r] != 0u) __hip_atomic_fetch_add(hmine + (key[r] >> 8), 1u, __ATOMIC_RELAXED, __HIP_MEMORY_SCOPE_WORKGROUP);
                }
                LDS_WAIT();
                int bh, ca_h; radix_level(hist, lane, NSEL, bh, ca_h);
                LDS_WAIT();
#pragma unroll
                for (int r8 = 0; r8 < 8; ++r8) if (8 * r8 < nr) {
#pragma unroll
                    for (int r = 8 * r8; r < 8 * r8 + 8; ++r) if ((int)(key[r] >> 8) == bh) __hip_atomic_fetch_add(hmine + (key[r] & 255u), 1u, __ATOMIC_RELAXED, __HIP_MEMORY_SCOPE_WORKGROUP);
                }
                LDS_WAIT();
                int bl, ca_l; radix_level(hist, lane, NSEL - ca_h, bl, ca_l);
                LDS_WAIT();
                thr = ((unsigned)bh << 8) | (unsigned)bl; need = NSEL - ca_h - ca_l;
            }
            unsigned wlo = 0u, whi = 0u;
#pragma unroll
            for (int r = 0; r < 64; ++r) {
                unsigned long long word = 0ull;
                if (r < nr) {
                    if (t + 1 > NSEL) {
                        const unsigned long long mg = __builtin_amdgcn_ballot_w64(key[r] > thr);
                        unsigned long long me = __builtin_amdgcn_ballot_w64(key[r] == thr);
                        if (me) { const int c = __builtin_popcountll(me);
                            if (c > need) { int drop = c - need; while (drop > 0) { me &= ~(1ull << (63 - __builtin_clzll(me))); --drop; } need = 0; } else need -= c; }
                        word = mg | me;
                    } else word = __builtin_amdgcn_ballot_w64(key[r] != 0u);
                }
                { const unsigned w0_ = (unsigned)word, w1_ = (unsigned)(word >> 32); asm volatile("s_nop 0\n\tv_writelane_b32 %0, %2, %4\n\tv_writelane_b32 %1, %3, %4" : "+v"(wlo), "+v"(whi) : "s"(w0_), "s"(w1_), "n"(r)); }
            }
            MW[qq * 64 + lane] = ((unsigned long long)whi << 32) | wlo;
        }
        __syncthreads();
        for (int i = F.tid; i < 1024; i += NTHREADS) { const int w = i >> 4, qq = i & 15; MASK[((size_t)b * 64 + w) * SEQ + t0 + qq] = MW[qq * 64 + w]; }
        __syncthreads();
    }
}

namespace att {
constexpr int KV = 64, QB = 256;
constexpr int KSLOT = 12288, VSLOT = 8192;
constexpr int NSLOT = 4;
constexpr int L_K = 0, L_V = NSLOT * KSLOT, L_WS = L_V + NSLOT * VSLOT, L_OST = L_WS + NWAVES * 64 * 4, L_BYTES = L_OST + NWAVES * 4096;
static_assert(L_BYTES <= LDS_BYTES, "attention LDS");
__device__ __forceinline__ int crow(int r, int hi) { return (r & 3) + 8 * (r >> 2) + 4 * hi; }
__device__ __forceinline__ float max3f(float a, float b, float c) { float r; asm("v_max3_f32 %0, %1, %2, %3" : "=v"(r) : "v"(a), "v"(b), "v"(c)); return r; }
__device__ __forceinline__ void glds(const void* g, LAS unsigned char* l) { __builtin_amdgcn_global_load_lds((const unsigned*)g, (LAS unsigned*)l, 16, 0, 0); }

template <int MODE>
__device__ __forceinline__ void attn_unit(Frame& F, int b, int h, int qb) {
    constexpr int NCH = MODE ? 12 : 8, ND = NCH / 2;
    const int lane = F.lane, wid = F.wave, r32 = lane & 31, hi = lane >> 5;
    unsigned char* ws = F.ws; LAS unsigned char* lds = F.lds;
    const size_t rowbase = (size_t)b * SEQ; const int q0 = qb * QB;
    const bf16_t* Kn = (const bf16_t*)(ws + (MODE ? WS_KMN : WS_KA)) + rowbase * 512 + h * 64;
    const bf16_t* Kr = (const bf16_t*)(ws + WS_KMR) + rowbase * 256 + h * 32;
    const bf16_t* Vh = (const bf16_t*)(ws + (MODE ? WS_VM : WS_VA)) + rowbase * 512 + h * 64;
    bf16_t* Qn = (bf16_t*)(ws + (MODE ? WS_QMN : WS_QA)) + (rowbase + q0 + wid * 32) * 512 + h * 64;
    const bf16_t* Qr = (const bf16_t*)(ws + WS_QMR) + (rowbase + q0 + wid * 32) * 256 + h * 32;
    LAS float* wsf = (LAS float*)(lds + L_WS) + wid * 64;
    const int NT = (q0 + QB) / KV;
    const bf16_t* ksrc0 = Kn + (size_t)lane * 512 + wid * 8;
    const bf16_t* ksrc1 = Kr + (size_t)lane * 256 + (wid & 3) * 8;
    const bf16_t* vsrc = Vh + (size_t)(16 * (wid & 3) + (lane >> 2)) * 512 + (wid >> 2) * 32 + (lane & 3) * 8;
#define ATT_DMA(t, slot) do { glds(ksrc0 + (size_t)(t) * KV * 512, lds + L_K + (slot) * KSLOT + wid * 1024); \
        if (MODE) glds(ksrc1 + (size_t)(t) * KV * 256, lds + L_K + (slot) * KSLOT + (8 + (wid & 3)) * 1024); \
        glds(vsrc + (size_t)(t) * KV * 512, lds + L_V + (slot) * VSLOT + wid * 1024); } while (0)
    ATT_DMA(0, 0); ATT_DMA(1, 1); ATT_DMA(2, 2);
    bf16x8 qr[ND];
#pragma unroll
    for (int d0 = 0; d0 < 4; ++d0) qr[d0] = *(const bf16x8*)(Qn + (size_t)r32 * 512 + d0 * 16 + hi * 8);
    if (MODE) {
#pragma unroll
        for (int d0 = 4; d0 < ND; ++d0) qr[d0] = *(const bf16x8*)(Qr + (size_t)r32 * 256 + (d0 - 4) * 16 + hi * 8);
        const float rq = __builtin_amdgcn_rsqf(((const float*)(ws + WS_SSQ_QM))[(rowbase + q0 + wid * 32 + r32) * 8 + h] * (1.f / MQK) + EPS);
#pragma unroll
        for (int d0 = 0; d0 < ND; ++d0) {
            u32x4 w = __builtin_bit_cast(u32x4, qr[d0]);
#pragma unroll
            for (int j = 0; j < 4; ++j) w[j] = cvtpk_s(bflo(w[j]) * rq, bfhi(w[j]) * rq);
            qr[d0] = __builtin_bit_cast(bf16x8, w);
        }
    }
    const unsigned long long* mrow = (const unsigned long long*)(ws + WS_MASK) + (size_t)b * 64 * SEQ + q0 + wid * 32 + r32;
    float mref = 0.f; f32x16 o[2]; o[0] = f32x16{}; o[1] = f32x16{};
    float lrun = 0.f;
    f32x16 negm = f32x16{};
    const int qrel = wid * 32 + r32;
    const unsigned vb0 = (unsigned)(uintptr_t)(lds + L_V) + ((lane >> 4) & 1) * 32 + (lane & 3) * 8 + (4 * hi + ((lane & 15) >> 2)) * 64;
    unsigned long long mw = 0ull, mwn = 0ull;
    if (MODE == 0) mwn = mrow[0];
#define ATT_QK(P0, P1, SL) do { const LAS unsigned char* kb = lds + L_K + (SL) * KSLOT + hi * 1024 + r32 * 16; \
        _Pragma("unroll") for (int d0 = 0; d0 < ND; ++d0) { \
            const bf16x8 k0 = *(const LAS bf16x8*)(kb + d0 * 2048), k1 = *(const LAS bf16x8*)(kb + d0 * 2048 + 512); \
            if (d0 == 0) { P0 = __builtin_amdgcn_mfma_f32_32x32x16_bf16(k0, qr[0], negm, 0, 0, 0); P1 = __builtin_amdgcn_mfma_f32_32x32x16_bf16(k1, qr[0], negm, 0, 0, 0); } \
            else { P0 = __builtin_amdgcn_mfma_f32_32x32x16_bf16(k0, qr[d0], P0, 0, 0, 0); P1 = __builtin_amdgcn_mfma_f32_32x32x16_bf16(k1, qr[d0], P1, 0, 0, 0); } } } while (0)
    if (MODE) asm volatile("s_waitcnt vmcnt(3)" ::: "memory"); else asm volatile("s_waitcnt vmcnt(2)" ::: "memory");
    __builtin_amdgcn_s_barrier(); asm volatile("" ::: "memory");
    f32x16 pn0, pn1;
    ATT_QK(pn0, pn1, 0);
    int slot = 0, slot1 = 1, slot3 = 3;
    for (int t = 0; t < NT; ++t) {
        if (t + 2 < NT) { if (MODE) asm volatile("s_waitcnt vmcnt(3)" ::: "memory"); else asm volatile("s_waitcnt vmcnt(2)" ::: "memory"); }
        else asm volatile("s_waitcnt vmcnt(0)" ::: "memory");
        __builtin_amdgcn_s_barrier(); asm volatile("" ::: "memory");
        mw = mwn;
        if (MODE == 0 && t + 1 < NT) mwn = mrow[(size_t)(t + 1) * SEQ];
        if (t + 3 < NT) ATT_DMA(t + 3, slot3);
        f32x16 p0 = pn0, p1 = pn1;
        if (MODE == 1) {
            const int jb = t - (NT - 4);
            if (jb >= 0) { const int kb = 64 * jb + 4 * hi;
#pragma unroll
                for (int r = 0; r < 16; ++r) { const int kv = kb + (r & 3) + 8 * (r >> 2); if (kv > qrel) p0[r] = -INFINITY; if (kv + 32 > qrel) p1[r] = -INFINITY; } }
        }
        asm volatile("s_nop 15\n\ts_nop 7" : "+v"(p0), "+v"(p1));
        float rm = max3f(p0[0], p1[0], p0[1]), rm2 = max3f(p1[1], p0[2], p1[2]);
#pragma unroll
        for (int r = 3; r < 15; r += 2) { rm = max3f(rm, p0[r], p1[r]); rm2 = max3f(rm2, p0[r + 1], p1[r + 1]); }
        rm = max3f(rm, rm2, p0[15]); rm = __builtin_fmaxf(rm, p1[15]);
        { auto rr = __builtin_amdgcn_permlane32_swap(__float_as_uint(rm), __float_as_uint(rm), false, false); rm = __builtin_fmaxf(__uint_as_float(rr[0]), __uint_as_float(rr[1])); }
        const bool resc = __any(rm > 0.f) || t == 0;
        const float dl = !resc ? 0.f : (t == 0) ? rm : __builtin_fmaxf(rm, 0.f);
        mref += dl;
#pragma unroll
        for (int r = 0; r < 16; ++r) { p0[r] -= dl; p1[r] -= dl; negm[r] -= dl; }
        if (resc) {
            const float f = __builtin_amdgcn_exp2f(-dl);
            if (hi == 0) wsf[r32] = f;
            LDS_WAIT();
#pragma unroll
            for (int r = 0; r < 16; ++r) { const float fr = wsf[crow(r, hi)]; o[0][r] *= fr; o[1][r] *= fr; }
            lrun *= f;
        }
        ATT_QK(pn0, pn1, slot1);
#pragma unroll
        for (int r = 0; r < 16; ++r) { p0[r] = __builtin_amdgcn_exp2f(p0[r]); p1[r] = __builtin_amdgcn_exp2f(p1[r]); }
        if (MODE == 0) {
            const unsigned lo = (unsigned)mw >> (4 * hi), hw = (unsigned)(mw >> 32) >> (4 * hi);
#pragma unroll
            for (int r = 0; r < 16; ++r) { const int c = (r & 3) + 8 * (r >> 2);
                unsigned m0_, m1_;
                asm("v_bfe_i32 %0, %1, %2, 1" : "=v"(m0_) : "v"(lo), "n"(c)); asm("v_bfe_i32 %0, %1, %2, 1" : "=v"(m1_) : "v"(hw), "n"(c));
                p0[r] = __uint_as_float(__float_as_uint(p0[r]) & m0_);
                p1[r] = __uint_as_float(__float_as_uint(p1[r]) & m1_); }
        }
        { float sacc = 0.f;
#pragma unroll
          for (int r = 0; r < 16; ++r) sacc += p0[r] + p1[r];
          lrun += sacc; }
        u32x4 pw0, pw1, pw2, pw3;
#pragma unroll
        for (int j = 0; j < 4; ++j) { pw0[j] = cvtpk_s(p0[2 * j], p0[2 * j + 1]); pw1[j] = cvtpk_s(p0[8 + 2 * j], p0[9 + 2 * j]); pw2[j] = cvtpk_s(p1[2 * j], p1[2 * j + 1]); pw3[j] = cvtpk_s(p1[8 + 2 * j], p1[9 + 2 * j]); }
        { const unsigned vb = vb0 + slot * VSLOT;
#pragma unroll
          for (int d0 = 0; d0 < 2; ++d0) { s16x4 lo[4], hh[4];
#pragma unroll
              for (int ks = 0; ks < 4; ++ks) {
                  asm volatile("ds_read_b64_tr_b16 %0,%1 offset:%c2" : "=&v"(lo[ks]) : "v"(vb), "i"(d0 * 4096 + ks * 1024) : "memory");
                  asm volatile("ds_read_b64_tr_b16 %0,%1 offset:%c2" : "=&v"(hh[ks]) : "v"(vb), "i"(d0 * 4096 + ks * 1024 + 512) : "memory"); }
              asm volatile("s_waitcnt lgkmcnt(0)" ::: "memory"); __builtin_amdgcn_sched_barrier(0);
#define ATT_PK(k) (bf16x8){lo[k][0], lo[k][1], lo[k][2], lo[k][3], hh[k][0], hh[k][1], hh[k][2], hh[k][3]}
              o[d0] = __builtin_amdgcn_mfma_f32_32x32x16_bf16(__builtin_bit_cast(bf16x8, pw0), ATT_PK(0), o[d0], 0, 0, 0);
              o[d0] = __builtin_amdgcn_mfma_f32_32x32x16_bf16(__builtin_bit_cast(bf16x8, pw1), ATT_PK(1), o[d0], 0, 0, 0);
              o[d0] = __builtin_amdgcn_mfma_f32_32x32x16_bf16(__builtin_bit_cast(bf16x8, pw2), ATT_PK(2), o[d0], 0, 0, 0);
              o[d0] = __builtin_amdgcn_mfma_f32_32x32x16_bf16(__builtin_bit_cast(bf16x8, pw3), ATT_PK(3), o[d0], 0, 0, 0);
#undef ATT_PK
          } }
        LDS_WAIT();
        slot = slot1; slot1 = (slot1 == NSLOT - 1) ? 0 : slot1 + 1; slot3 = (slot3 == NSLOT - 1) ? 0 : slot3 + 1;
    }
#undef ATT_QK
    __builtin_amdgcn_s_barrier(); asm volatile("" ::: "memory");
#undef ATT_DMA
    { auto rr = __builtin_amdgcn_permlane32_swap(__float_as_uint(lrun), __float_as_uint(lrun), false, false); lrun = __uint_as_float(rr[0]) + __uint_as_float(rr[1]); }
    if (hi == 0) wsf[32 + r32] = lrun;
    LDS_WAIT();
    float rli[16];
#pragma unroll
    for (int r = 0; r < 16; ++r) rli[r] = __builtin_amdgcn_rcpf(wsf[32 + crow(r, hi)]);
    LAS bf16_t* stg = (LAS bf16_t*)(lds + L_OST) + wid * 2048;
#pragma unroll
    for (int r = 0; r < 16; ++r) { const int orow = crow(r, hi);
#pragma unroll
        for (int d0 = 0; d0 < 2; ++d0) stg[orow * 64 + d0 * 32 + r32] = (bf16_t)(cvtpk_s(o[d0][r] * rli[r], 0.f) & 0xffffu); }
    LDS_WAIT();
#pragma unroll
    for (int i = 0; i < 4; ++i) { const int row = i * 8 + (lane >> 3), ch = lane & 7; const u32x4 v = *(const LAS u32x4*)(stg + row * 64 + ch * 8); *(u32x4*)(Qn + (size_t)row * 512 + ch * 8) = v; }
    LDS_WAIT(); __builtin_amdgcn_s_barrier(); asm volatile("" ::: "memory");
}

__device__ __forceinline__ void attn_phase(Frame& F) {
    const int vcu = (F.G % 8 == 0) ? (F.bid % 8) * (F.G / 8) + F.bid / 8 : F.bid;
    for (int v = vcu; v < 256; v += F.G) {
        const int bh = v >> 2, s = v & 3;
#pragma unroll 1
        for (int i = 0; i < 4; ++i) { const int qb = (i == 0) ? s : (i == 1) ? 7 - s : (i == 2) ? 8 + s : 15 - s; attn_unit<0>(F, bh >> 3, bh & 7, qb); }
#pragma unroll 1
        for (int i = 0; i < 4; ++i) { const int qb = (i == 0) ? s : (i == 1) ? 7 - s : (i == 2) ? 8 + s : 15 - s; attn_unit<1>(F, bh >> 3, bh & 7, qb); }
    }
}
}

struct EpiMerge {
    unsigned char* ws;
    __device__ __forceinline__ void mid(f32x4 (&acc)[2][2][4][2], const pg8::Unit& u, int wr, int wc, int fr, int fq) const {
        const int row0 = u.pm * 256 + wr * 64 + fr, cb = u.pn * 256 + 32 * wc + 4 * fq;
        const bf16_t* ga = (const bf16_t*)(ws + WS_GA); const bf16_t* gm = (const bf16_t*)(ws + WS_GM);
#pragma unroll
        for (int ai = 0; ai < 2; ++ai)
#pragma unroll
            for (int m = 0; m < 4; ++m) { const size_t off = (size_t)(row0 + 128 * ai + 16 * m) * DM + cb;
#pragma unroll
                for (int bj = 0; bj < 2; ++bj) { u32x2 av[2], gv[2]; ld8(ga + (off - 4 * fq) + 128 * bj, av[0], av[1], fq); ld8(gm + (off - 4 * fq) + 128 * bj, gv[0], gv[1], fq);
#pragma unroll
                    for (int n = 0; n < 2; ++n) { const u32x2 a = av[n], g = gv[n];
                        const f32x4 den = (f32x4){fmaxf(bflo(g.x), 1e-30f), fmaxf(bfhi(g.x), 1e-30f), fmaxf(bflo(g.y), 1e-30f), fmaxf(bfhi(g.y), 1e-30f)};
                        acc[ai][bj][m][n] = acc[ai][bj][m][n] * ((f32x4){bflo(a.x), bfhi(a.x), bflo(a.y), bfhi(a.y)} * (f32x4){__builtin_amdgcn_rcpf(den.x), __builtin_amdgcn_rcpf(den.y), __builtin_amdgcn_rcpf(den.z), __builtin_amdgcn_rcpf(den.w)});
                    } } asm volatile("" ::: "memory"); }
    }
    __device__ __forceinline__ void operator()(const f32x4 (&acc)[2][2][4][2], const pg8::Unit& u, int wr, int wc, int fr, int fq) const {
        const int row0 = u.pm * 256 + wr * 64 + fr, cb = u.pn * 256 + 32 * wc + 4 * fq;
        const bf16_t* gm = (const bf16_t*)(ws + WS_GM); bf16_t* mix = (bf16_t*)(ws + WS_MIXED);
#pragma unroll
        for (int ai = 0; ai < 2; ++ai)
#pragma unroll
            for (int m = 0; m < 4; ++m) { const size_t off = (size_t)(row0 + 128 * ai + 16 * m) * DM + cb;
#pragma unroll
                for (int bj = 0; bj < 2; ++bj) { u32x2 pk[2], gv[2]; ld8(gm + (off - 4 * fq) + 128 * bj, gv[0], gv[1], fq);
#pragma unroll
                    for (int n = 0; n < 2; ++n) {
                        const u32x2 g = gv[n];
                        pk[n] = pk4(acc[ai][bj][m][n] * (f32x4){fmaxf(bflo(g.x), 1e-30f), fmaxf(bfhi(g.x), 1e-30f), fmaxf(bflo(g.y), 1e-30f), fmaxf(bfhi(g.y), 1e-30f)});
                    }
                    st8(mix + (off - 4 * fq) + 128 * bj, pk[0], pk[1], fq); } asm volatile("" ::: "memory"); }
    }
};
struct EpiOut {
    unsigned char* ws; const float* x; float* out; const float* g2;
    __device__ __forceinline__ void operator()(const f32x4 (&acc)[2][2][4][2], const pg8::Unit& u, int wr, int wc, int fr, int fq) const {
        const int row0 = u.pm * 256 + wr * 64 + fr, cb = u.pn * 256 + 32 * wc + 4 * fq, b = (u.pm * 256) / SEQ;
        const float* mod = (const float*)(ws + WS_MOD) + (size_t)b * 6144; bf16_t* x1g = (bf16_t*)(ws + WS_X1G); float* ssq = (float*)(ws + WS_SSQ_X1);
        f32x4 gt[2][2], gm[2][2];
#pragma unroll
        for (int bj = 0; bj < 2; ++bj)
#pragma unroll
            for (int n = 0; n < 2; ++n) { const int c = cb + 128 * bj + 16 * n; gt[bj][n] = *(const f32x4*)(mod + 2048 + c); gm[bj][n] = *(const f32x4*)(g2 + c) * (*(const f32x4*)(mod + 4096 + c) + 1.0f); }
#pragma unroll
        for (int ai = 0; ai < 2; ++ai)
#pragma unroll
            for (int m = 0; m < 4; ++m) { const int row = row0 + 128 * ai + 16 * m; const size_t off = (size_t)row * DM + cb; float s = 0.f;
#pragma unroll
                for (int bj = 0; bj < 2; ++bj) { u32x2 pk[2];
#pragma unroll
                    for (int n = 0; n < 2; ++n) {
                        const f32x4 x1 = *(const f32x4*)(x + off + 128 * bj + 16 * n) + gt[bj][n] * acc[ai][bj][m][n];
                        s += sum4sq(x1);
                        pk[n] = pk4(x1 * gm[bj][n]);
                    }
                    st8(x1g + (off - 4 * fq) + 128 * bj, pk[0], pk[1], fq); }
                s = fq_sum(s);
                if (fq == 0) atomicAdd(ssq + row, s); asm volatile("" ::: "memory"); }
    }
};
struct EpiPQ {
    unsigned char* ws;
    __device__ __forceinline__ void operator()(const f32x4 (&acc)[2][2][4][2], const pg8::Unit& u, int wr, int wc, int fr, int fq) const {
        const int row0 = u.pm * 256 + wr * 64 + fr, cb = u.pn * 256 + 32 * wc + 4 * fq, b = (u.pm * 256) / SEQ;
        const float* bias = (const float*)(ws + WS_BIASQ) + (size_t)b * 2048; const float* ssq = (const float*)(ws + WS_SSQ_X1); bf16_t* pq = (bf16_t*)(ws + WS_PQ);
        f32x4 bv[2][2];
#pragma unroll
        for (int bj = 0; bj < 2; ++bj)
#pragma unroll
            for (int n = 0; n < 2; ++n) bv[bj][n] = *(const f32x4*)(bias + cb + 128 * bj + 16 * n);
#pragma unroll
        for (int ai = 0; ai < 2; ++ai)
#pragma unroll
            for (int m = 0; m < 4; ++m) { const int row = row0 + 128 * ai + 16 * m; const float rinv = __builtin_amdgcn_rsqf(ssq[row] * (1.f / DM) + EPS);
#pragma unroll
                for (int bj = 0; bj < 2; ++bj) st8(pq + (size_t)row * 2048 + (cb - 4 * fq) + 128 * bj, pk4(acc[ai][bj][m][0] * rinv + bv[bj][0]), pk4(acc[ai][bj][m][1] * rinv + bv[bj][1]), fq);
                asm volatile("" ::: "memory"); }
    }
};

#define XB_TMO      128
#define XB_XCNT(j)  (256  + 64 * (j))
#define XB_XSUB(j)  (1280 + 64 * (j))
#define XB_XGEN(j)  (2304 + 64 * (j))
#define XB_TOP      3328
#define XB_TOPGEN   3392
#define XB_SPIN_CAP (1u << 22)
__device__ __forceinline__ unsigned xb_ld(unsigned* p)              { return __hip_atomic_load(p, __ATOMIC_RELAXED, __HIP_MEMORY_SCOPE_AGENT); }
__device__ __forceinline__ unsigned xb_add(unsigned* p, unsigned v) { return __hip_atomic_fetch_add(p, v, __ATOMIC_RELAXED, __HIP_MEMORY_SCOPE_AGENT); }
__device__ __forceinline__ unsigned xb_xcc_id() { return (unsigned)__builtin_amdgcn_s_getreg((3 << 11) | 20) & 0xFu; }
#define XB_SPIN(cond, bar) do { unsigned _sp = 0; while (cond) { __builtin_amdgcn_s_sleep(1); \
    if ((++_sp & 255u) == 0u) { if (xb_ld(&(bar)[XB_TMO])) break; if (_sp > XB_SPIN_CAP) { atomicAdd(&(bar)[XB_TMO], 1u); break; } } } } while (0)
struct XcdBarrier { unsigned* bar; unsigned x; volatile LAS unsigned* st; };
__device__ __forceinline__ XcdBarrier xcd_barrier_post(unsigned* bar, volatile LAS unsigned* st) {
    XcdBarrier b; b.bar = bar; b.x = xb_xcc_id(); b.st = st;
    if (threadIdx.x == 0) (void)xb_add(&bar[XB_XCNT(b.x)], 1u);
    return b;
}
__device__ __forceinline__ void xcd_barrier_complete(unsigned* bar, unsigned x, unsigned& nloc, unsigned& nx) {
    const unsigned G = gridDim.x * gridDim.y * gridDim.z;
    unsigned sum, cnt, mine, sp = 0u;
    for (;;) {
        sum = 0u; cnt = 0u; mine = 0u;
#pragma unroll
        for (unsigned j = 0; j < 16; ++j) { const unsigned c = xb_ld(&bar[XB_XCNT(j)]); sum += c; cnt += (c > 0u) ? 1u : 0u; mine = (j == x) ? c : mine; }
        if (sum == G) break;
        __builtin_amdgcn_s_sleep(1);
        if ((++sp & 255u) == 0u) { if (xb_ld(&bar[XB_TMO])) break; if (sp > XB_SPIN_CAP) { atomicAdd(&bar[XB_TMO], 1u); break; } }
    }
    nloc = mine > 0u ? mine : 1u; nx = cnt > 0u ? cnt : 1u;
}
__device__ __forceinline__ void xcd_barrier(const XcdBarrier& b) {
    asm volatile("s_waitcnt vmcnt(0) lgkmcnt(0)" ::: "memory");
    __syncthreads();
    if (threadIdx.x == 0) {
        unsigned* bar = b.bar;
        __builtin_amdgcn_s_waitcnt(0);
        unsigned nloc = b.st[0], nx = b.st[1];
        if (nloc == 0u) { xcd_barrier_complete(bar, b.x, nloc, nx); b.st[0] = nloc; b.st[1] = nx; }
        const unsigned old = xb_add(&bar[XB_XSUB(b.x)], 1u);
        const unsigned gen = old / nloc;
        if (old + 1u == (gen + 1u) * nloc) {
            __builtin_amdgcn_fence(__ATOMIC_RELEASE, "agent");
            asm volatile("s_waitcnt vmcnt(0)" ::: "memory");
            const unsigned og = xb_add(&bar[XB_TOP], 1u);
            const unsigned tg = og / nx;
            if (og + 1u == (tg + 1u) * nx) xb_add(&bar[XB_TOPGEN], 1u);
            else XB_SPIN(xb_ld(&bar[XB_TOPGEN]) == tg, bar);
            __builtin_amdgcn_fence(__ATOMIC_ACQUIRE, "agent");
            xb_add(&bar[XB_XGEN(b.x)], 1u);
            asm volatile("s_waitcnt vmcnt(0)" ::: "memory");
        } else {
            XB_SPIN(xb_ld(&bar[XB_XGEN(b.x)]) == gen, bar);
            __builtin_amdgcn_fence(__ATOMIC_ACQUIRE, "agent");
            asm volatile("s_waitcnt vmcnt(0)" ::: "memory");
        }
    }
    __syncthreads();
}
#define grid_barrier(ctr, target) xcd_barrier(xbar)


namespace peer {
constexpr int TOK = 32;
constexpr int L_EXP = 0, L_GATE = L_EXP + TOK * 128 * 2, L_TOPI = L_GATE + TOK * 128 * 4, L_TOPV = L_TOPI + NWAVES * TOK * 32, L_CNT = L_TOPV + NWAVES * TOK * 32 * 4, L_SU = L_CNT + NWAVES * 64 * 4, L_BYTES = L_SU + TOK * 128 * 4;
static_assert(L_BYTES <= LDS_BYTES, "peer LDS");
__device__ __forceinline__ unsigned sortable(float v) { const unsigned u = __float_as_uint(v); return (u & 0x80000000u) ? ~u : (u | 0x80000000u); }
__device__ __forceinline__ float unsortable(unsigned k) { return __uint_as_float((k & 0x80000000u) ? (k & 0x7fffffffu) : ~k); }
__device__ __forceinline__ unsigned pair_max(unsigned m) { auto rr = __builtin_amdgcn_permlane32_swap(m, m, false, false); return rr[0] > rr[1] ? rr[0] : rr[1]; }
__device__ __forceinline__ float gelu_tanh(float x) { const float y = 0.7978845608028654f * (x + 0.044715f * x * x * x); const float e = __builtin_amdgcn_exp2f(y * (2.f * LOG2E)); return 0.5f * x * (2.f - 2.f * __builtin_amdgcn_rcpf(e + 1.f)); }

template <int CTRL> __device__ __forceinline__ float dppf(float v) { return __int_as_float(__builtin_amdgcn_update_dpp(0, __float_as_int(v), CTRL, 0xf, 0xf, true)); }
__device__ __forceinline__ float wsum_dpp(float v) {
    v += dppf<0xB1>(v); v += dppf<0x4E>(v); v += dppf<0x141>(v); v += dppf<0x140>(v);
    { auto r = __builtin_amdgcn_permlane16_swap(__float_as_uint(v), __float_as_uint(v), false, false); v = __uint_as_float(r[0]) + __uint_as_float(r[1]); }
    { auto r = __builtin_amdgcn_permlane32_swap(__float_as_uint(v), __float_as_uint(v), false, false); v = __uint_as_float(r[0]) + __uint_as_float(r[1]); }
    return v;
}
__device__ __forceinline__ void route_head(Frame& F, int tok0) {
    int lane = F.lane; asm volatile("" : "+v"(lane));
    const int h = F.wave, r32 = lane & 31, hi = lane >> 5;
    const bf16_t* PQ = (const bf16_t*)(F.ws + WS_PQ) + (size_t)(tok0 + r32) * 2048 + h * 256;
    const bf16_t* SK = (const bf16_t*)(F.ws + WS_SUBK) + (size_t)h * 2 * 128 * 128;
    LAS unsigned char* topi = (LAS unsigned char*)(F.lds + L_TOPI) + h * (TOK * 32) + r32 * 32;
    LAS float* topv = (LAS float*)(F.lds + L_TOPV) + h * (TOK * 32) + r32 * 32;
#pragma unroll 1
    for (int p = 0; p < 2; ++p) {
        f32x16 acc[4]; acc[0] = f32x16{}; acc[1] = f32x16{}; acc[2] = f32x16{}; acc[3] = f32x16{};
#pragma unroll 2
        for (int ks = 0; ks < 8; ++ks) {
            const bf16x8 bq = *(const bf16x8*)(PQ + p * 128 + 16 * ks + 8 * hi);
#pragma unroll
            for (int kb = 0; kb < 4; ++kb) {
                const bf16x8 ak = *(const bf16x8*)(SK + ((size_t)p * 128 + 32 * kb + r32) * 128 + 16 * ks + 8 * hi);
                acc[kb] = __builtin_amdgcn_mfma_f32_32x32x16_bf16(ak, bq, acc[kb], 0, 0, 0);
            }
        }
        unsigned key[64];
#pragma unroll
        for (int kb = 0; kb < 4; ++kb)
#pragma unroll
            for (int r = 0; r < 16; ++r) { const int kidx = 32 * kb + (r & 3) + 8 * (r >> 2) + 4 * hi; key[kb * 16 + r] = ((sortable(acc[kb][r]) >> 1) & ~127u) | (unsigned)(127 - kidx); }
        unsigned prev = 0x80000000u;
#pragma unroll 1
        for (int it = 0; it < 16; ++it) {
            unsigned mv = key[0] - prev;
#pragma unroll
            for (int r = 1; r < 64; ++r) { const unsigned d = key[r] - prev; mv = d > mv ? d : mv; }
            mv = pair_max(mv);
            const unsigned m = prev + mv; prev = m;
            if (hi == 0) { topi[p * 16 + it] = (unsigned char)(127 - (m & 127u)); topv[p * 16 + it] = unsortable((m & ~127u) << 1); }
        }
    }
    LDS_WAIT();
    unsigned cand[25];
    { float av[16], bv[16];
#pragma unroll
      for (int i = 0; i < 16; ++i) { av[i] = topv[i]; bv[i] = topv[16 + i]; }
      int n = 0;
#pragma unroll
      for (int i = 0; i < 16; ++i)
#pragma unroll
          for (int j = 0; j < 16; ++j) if ((i + 1) * (j + 1) <= 16) { const unsigned k = ((sortable(av[i] + bv[j]) >> 1) & ~255u) | (unsigned)(255 - (i * 16 + j)); if ((n & 1) == 0) { cand[n >> 1] = hi ? 0u : k; } else { cand[n >> 1] = hi ? k : cand[n >> 1]; } ++n; } }
    LAS unsigned short* ex_o = (LAS unsigned short*)(F.lds + L_EXP) + r32 * 128 + h * 16;
    LAS float* g_o = (LAS float*)(F.lds + L_GATE) + r32 * 128 + h * 16;
    float den = 0.f, s0 = 0.f; unsigned prevc = 0x80000000u;
#pragma unroll 1
    for (int it = 0; it < 16; ++it) {
        unsigned mv = cand[0] - prevc;
#pragma unroll
        for (int r = 1; r < 25; ++r) { const unsigned d = cand[r] - prevc; mv = d > mv ? d : mv; }
        mv = pair_max(mv);
        const unsigned m = prevc + mv; prevc = m;
        const float sv = unsortable((m & ~255u) << 1); const unsigned pos = 255u - (m & 255u), i = pos >> 4, j = pos & 15u;
        if (it == 0) s0 = sv;
        const float ex = __builtin_amdgcn_exp2f((sv - s0) * LOG2E); den += ex;
        if (hi == 0) { ex_o[it] = (unsigned short)((unsigned)topi[i] * 128u + (unsigned)topi[16 + j]); g_o[it] = ex; }
    }
    const float rden = __builtin_amdgcn_rcpf(den);
    LDS_WAIT();
    if (hi == 0) {
#pragma unroll
        for (int it = 0; it < 16; ++it) g_o[it] *= rden;
    }
}

__device__ __forceinline__ void expert_tokens(Frame& F, int tok0) {
    int lane = F.lane; const int wid = F.wave;
    asm volatile("" : "+v"(lane));
    const unsigned char* PU = F.ws + WS_PU; const unsigned char* PV = F.ws + WS_PV;
    const float* USC = (const float*)(F.ws + WS_USC); const float* VSC = (const float*)(F.ws + WS_VSC);
    const float* ssq = (const float*)(F.ws + WS_SSQ_X1); const bf16_t* X1G = (const bf16_t*)(F.ws + WS_X1G);
    LAS unsigned* cnt = (LAS unsigned*)(F.lds + L_CNT) + wid * 64;
#pragma unroll 1
    for (int tt = 0; tt < 4; ++tt) {
        const int tl = 4 * wid + tt;
        LAS unsigned short* ex_l = (LAS unsigned short*)(F.lds + L_EXP) + tl * 128; LAS float* g_l = (LAS float*)(F.lds + L_GATE) + tl * 128; LAS float* su_l = (LAS float*)(F.lds + L_SU) + tl * 128;
        cnt[lane] = 0u;
        const unsigned e0 = ex_l[lane], e1 = ex_l[lane + 64]; const float g0 = g_l[lane] * VSC[e0], g1 = g_l[lane + 64] * VSC[e1]; const float s0 = USC[e0], s1 = USC[e1];
        const unsigned b0 = e0 >> 8, b1 = e1 >> 8;
        LDS_WAIT(); asm volatile("" ::: "memory");
        const unsigned r0 = __hip_atomic_fetch_add(cnt + b0, 1u, __ATOMIC_RELAXED, __HIP_MEMORY_SCOPE_WORKGROUP);
        const unsigned r1 = __hip_atomic_fetch_add(cnt + b1, 1u, __ATOMIC_RELAXED, __HIP_MEMORY_SCOPE_WORKGROUP);
        LDS_WAIT(); asm volatile("" ::: "memory");
        const int c = (int)cnt[lane]; int incl = c;
#pragma unroll
        for (int o = 1; o < 64; o <<= 1) { const int tv = __shfl_up(incl, o); incl += (lane >= o) ? tv : 0; }
        const int excl = incl - c;
        const int p0 = __shfl(excl, (int)b0) + (int)r0, p1 = __shfl(excl, (int)b1) + (int)r1;
        ex_l[p0] = (unsigned short)e0; ex_l[p1] = (unsigned short)e1; g_l[p0] = g0; g_l[p1] = g1; su_l[p0] = s0; su_l[p1] = s1;
        LDS_WAIT(); asm volatile("" ::: "memory");
    }
    {
        unsigned hA[4][2], hB[4][2]; float hinv[4]; f16x2 acc2[4][8]; u32x4 xg[4][2];
#pragma unroll
        for (int u = 0; u < 4; ++u) {
            const int t = tok0 + 4 * wid + u, b = t / SEQ;
            const float* mod = (const float*)(F.ws + WS_MOD) + (size_t)b * 6144;
            const float rinv = __builtin_amdgcn_rsqf(ssq[t] * (1.f / DM) + EPS);
            const u32x4 x0 = *(const u32x4*)(X1G + (size_t)t * DM + 16 * lane), x1 = *(const u32x4*)(X1G + (size_t)t * DM + 16 * lane + 8);
            float hv[16]; float amax = 1e-30f; xg[u][0] = x0; xg[u][1] = x1;
#pragma unroll
            for (int j = 0; j < 4; ++j) { const f32x4 sh = *(const f32x4*)(mod + 3072 + 16 * lane + 4 * j); const unsigned w0 = (j < 2) ? x0[2 * j] : x1[2 * j - 4], w1 = (j < 2) ? x0[2 * j + 1] : x1[2 * j - 3];
                hv[4 * j] = bflo(w0) * rinv + sh.x; hv[4 * j + 1] = bfhi(w0) * rinv + sh.y; hv[4 * j + 2] = bflo(w1) * rinv + sh.z; hv[4 * j + 3] = bfhi(w1) * rinv + sh.w; }
#pragma unroll
            for (int i = 0; i < 16; ++i) amax = fmaxf(amax, fabsf(hv[i]));
#pragma unroll
            for (int o = 32; o >= 1; o >>= 1) amax = fmaxf(amax, __shfl_xor(amax, o));
            const float hs = 119.f / amax; hinv[u] = amax * (1.f / 119.f);
            hA[u][0] = hA[u][1] = hB[u][0] = hB[u][1] = 0u;
#pragma unroll
            for (int i = 0; i < 16; ++i) { const int q = (int)__builtin_rintf(hv[i] * hs); const int lo = ((q + 8) & 15) - 8; const int hi = (q - lo) >> 4;
                hA[u][i >> 3] |= ((unsigned)hi & 15u) << (4 * (i & 7)); hB[u][i >> 3] |= ((unsigned)lo & 15u) << (4 * (i & 7)); }
#pragma unroll
            for (int i = 0; i < 8; ++i) acc2[u][i] = (f16x2){(_Float16)0.f, (_Float16)0.f};
            asm volatile("" ::: "memory");
        }
        const LAS unsigned short* ex_w = (const LAS unsigned short*)(F.lds + L_EXP) + (4 * wid) * 128;
        const LAS float* g_w = (const LAS float*)(F.lds + L_GATE) + (4 * wid) * 128;
        const LAS float* su_w = (const LAS float*)(F.lds + L_SU) + (4 * wid) * 128;
        const int kl = ((lane >> 5) & 1) | (((lane >> 4) & 1) << 1);
        const unsigned voff = 8u * (unsigned)lane;
        const __amdgpu_buffer_rsrc_t rsU = __builtin_amdgcn_make_buffer_rsrc((void*)PU, (short)0, PNEXP * (DM / 2), 0x00020000), rsV = __builtin_amdgcn_make_buffer_rsrc((void*)PV, (short)0, PNEXP * (DM / 2), 0x00020000);
        u32x2 ua[4], va[4], ub[4], vb[4]; float ga, gb, sua, sub_;
#define PEER_LOAD(U, V, G, SU, u, e0) do { _Pragma("unroll") for (int k = 0; k < 4; ++k) { const int eid = __builtin_amdgcn_readfirstlane((int)ex_w[(u) * 128 + (e0) + k]); \
            U[k] = (u32x2)__builtin_amdgcn_raw_buffer_load_b64(rsU, (int)voff, eid * (DM / 2), 0); V[k] = (u32x2)__builtin_amdgcn_raw_buffer_load_b64(rsV, (int)voff, eid * (DM / 2), 0); } \
            { SU = su_w[(u) * 128 + (e0) + kl] * hinv[u]; G = g_w[(u) * 128 + (e0) + kl]; } } while (0)
#define VACC(j, b) acc2[u_][4 * (j) + (b)] = __builtin_elementwise_fma(c2, __builtin_bit_cast(f16x2, __builtin_amdgcn_cvt_scalef32_pk_f16_fp4(Vk[j], 1.0f, b)), acc2[u_][4 * (j) + (b)])
#define PEER_COMP(U, V, G, SU, u) do { constexpr int u_ = (u); float dd[4]; _Pragma("unroll") for (int k = 0; k < 4; ++k) { \
            const int da = __builtin_amdgcn_sdot8((int)U[k][1], (int)hA[u_][1], __builtin_amdgcn_sdot8((int)U[k][0], (int)hA[u_][0], 0, false), false); \
            const int db = __builtin_amdgcn_sdot8((int)U[k][1], (int)hB[u_][1], __builtin_amdgcn_sdot8((int)U[k][0], (int)hB[u_][0], 0, false), false); \
            dd[k] = (float)(16 * da + db); } \
            float z; { auto r0 = __builtin_amdgcn_permlane32_swap(__float_as_uint(dd[0]), __float_as_uint(dd[1]), false, false); const float s01 = __uint_as_float(r0[0]) + __uint_as_float(r0[1]); \
              auto r1 = __builtin_amdgcn_permlane32_swap(__float_as_uint(dd[2]), __float_as_uint(dd[3]), false, false); const float s23 = __uint_as_float(r1[0]) + __uint_as_float(r1[1]); \
              auto r2 = __builtin_amdgcn_permlane16_swap(__float_as_uint(s01), __float_as_uint(s23), false, false); z = __uint_as_float(r2[0]) + __uint_as_float(r2[1]); } \
            z += dppf<0xB1>(z); z += dppf<0x4E>(z); z += dppf<0x141>(z); z += dppf<0x140>(z); \
            const float cf_ = G * gelu_tanh(z * SU); const f16x2 ch_ = (f16x2){(_Float16)cf_, (_Float16)cf_}; const int ci = __builtin_bit_cast(int, ch_); \
            _Pragma("unroll") for (int k = 0; k < 4; ++k) { const f16x2 c2 = __builtin_bit_cast(f16x2, __builtin_amdgcn_readlane(ci, ((k & 1) << 5) | ((k >> 1) << 4))); const u32x2 Vk = V[k]; \
            VACC(0, 0); VACC(0, 1); VACC(0, 2); VACC(0, 3); VACC(1, 0); VACC(1, 1); VACC(1, 2); VACC(1, 3); } } while (0)
        PEER_LOAD(ua, va, ga, sua, 0, 0);
#pragma unroll 1
        for (int j = 0; j < 32; ++j) {
            const int jn = (j + 1 < 32) ? j + 1 : 31;
            PEER_LOAD(ub, vb, gb, sub_, 1, 4 * j);     PEER_COMP(ua, va, ga, sua, 0);
            PEER_LOAD(ua, va, ga, sua, 2, 4 * j);      PEER_COMP(ub, vb, gb, sub_, 1);
            PEER_LOAD(ub, vb, gb, sub_, 3, 4 * j);     PEER_COMP(ua, va, ga, sua, 2);
            PEER_LOAD(ua, va, ga, sua, 0, 4 * jn);     PEER_COMP(ub, vb, gb, sub_, 3);
        }
#undef PEER_LOAD
#undef PEER_COMP
#undef VACC
#pragma unroll
        for (int u = 0; u < 4; ++u) {
            const int t = tok0 + 4 * wid + u, b = t / SEQ; const float* mod = (const float*)(F.ws + WS_MOD) + (size_t)b * 6144;
            float* op = F.out + (size_t)t * DM + 16 * lane; const float* g2 = F.in[IN_G2] + 16 * lane;
            const u32x4 y0 = xg[u][0], y1 = xg[u][1];
#pragma unroll
            for (int j = 0; j < 4; ++j) { const f32x4 g = *(const f32x4*)(mod + 5120 + 16 * lane + 4 * j); const f32x4 gmv = *(const f32x4*)(g2 + 4 * j) * (*(const f32x4*)(mod + 4096 + 16 * lane + 4 * j) + 1.0f);
                const unsigned w0 = (j < 2) ? y0[2 * j] : y1[2 * j - 4], w1 = (j < 2) ? y0[2 * j + 1] : y1[2 * j - 3];
                const f32x4 x = (f32x4){bflo(w0), bfhi(w0), bflo(w1), bfhi(w1)} * (f32x4){__builtin_amdgcn_rcpf(gmv.x), __builtin_amdgcn_rcpf(gmv.y), __builtin_amdgcn_rcpf(gmv.z), __builtin_amdgcn_rcpf(gmv.w)};
                *(f32x4*)(op + 4 * j) = x + g * (f32x4){(float)acc2[u][2 * j].x, (float)acc2[u][2 * j].y, (float)acc2[u][2 * j + 1].x, (float)acc2[u][2 * j + 1].y}; }
        }
    }
}
__device__ __forceinline__ void peer_phase(Frame& F) {
    for (int u = F.bid; u < T / TOK; u += F.G) {
        const int tok0 = u * TOK;
        route_head(F, tok0);
        __syncthreads();
        expert_tokens(F, tok0);
        __syncthreads();
    }
}
}

__global__ void __launch_bounds__(NTHREADS, 2) hybrid_fwd(Args args) {
    extern __shared__ __attribute__((aligned(16))) unsigned char lds_raw[];
    cg::grid_group grid = cg::this_grid();
    Frame F;
    F.lds = (LAS unsigned char*)lds_raw; F.ws = args.ws;
    F.tid = threadIdx.x; F.lane = F.tid & 63; F.wave = __builtin_amdgcn_readfirstlane(F.tid >> 6);
    F.G = gridDim.x; F.bid = blockIdx.x;
#pragma unroll
    for (int i = 0; i < 24; ++i) F.in[i] = args.in[i];
    F.out = args.out;
    unsigned char* ws = args.ws;
    const int lo = args.ph_lo, hi = args.ph_hi;
#define IN(k) (lo <= (k) && (k) < hi)
    unsigned nbar = 0; unsigned* barctr = (unsigned*)(ws + WS_BAR);
    volatile LAS unsigned* xst = (volatile LAS unsigned*)(F.lds + LDS_BYTES - 64);
    if (F.tid < 2) xst[F.tid] = 0u;
    __syncthreads();
    XcdBarrier xbar; xbar.bar = barctr; xbar.x = 0; xbar.st = xst;
#define SEAM(k) do { if (IN(k) && IN((k) + 1)) { if ((k) == 0) { asm volatile("s_waitcnt vmcnt(0) lgkmcnt(0)" ::: "memory"); __syncthreads(); grid.sync(); \
        __builtin_amdgcn_fence(__ATOMIC_ACQUIRE, "agent"); asm volatile("s_waitcnt vmcnt(0)" ::: "memory"); __syncthreads(); xbar = xcd_barrier_post(barctr, xst); } \
        else { ++nbar; grid_barrier(barctr, nbar * (unsigned)F.G); } } } while (0)
    if (IN(0)) { phase0(F); __syncthreads(); }
    SEAM(0);
    if (IN(1)) { phase1(F); }
    SEAM(1);
    if (IN(2)) {
        pg8::StaticOrder S; S.init((const bf16_t*)(ws + WS_XN), (const bf16_t*)(ws + WS_WIN), T, IN_PAD, DM, F.G, F.bid);
        EpiIn E{ws, F.in[IN_GAQ], F.in[IN_GAK], F.in[IN_GIDXK], F.in[IN_GMK]};
        pg8::gemm_phase(F.lds, DM, S, E);
    }
    SEAM(2);
    if (IN(3)) {
        { pg8::StaticOrder S; S.init((const bf16_t*)(ws + WS_CQ), (const bf16_t*)(ws + WS_WQUP), T, 768, QRANK, F.G, F.bid);
          EpiQup E{ws, F.in[IN_GMQ]}; pg8::gemm_phase(F.lds, QRANK, S, E); }
        { pg8::StaticOrder S; S.init((const bf16_t*)(ws + WS_CKV), (const bf16_t*)(ws + WS_WKVUP), T, 1024, KVRANK, F.G, F.bid);
          EpiKVup E{ws, F.in[IN_GMK]}; pg8::gemm_phase(F.lds, KVRANK, S, E); }
        indexer_phase(F);
    }
    SEAM(3);
    if (IN(4)) { att::attn_phase(F); }
    SEAM(4);
    if (IN(5)) {
        cvt_i4_rows(F.in[IN_PU], ws + WS_PU, (float*)(ws + WS_USC), PNEXP, F.bid * NWAVES + F.wave, F.G * NWAVES, F.lane);
        cvt_fp4_rows(F.in[IN_PV], ws + WS_PV, (float*)(ws + WS_VSC), PNEXP, F.bid * NWAVES + F.wave, F.G * NWAVES, F.lane);
        pg8::DualOrder S; S.A0 = (const char*)(ws + WS_QA); S.B0 = (const char*)(ws + WS_WOA); S.A1 = (const char*)(ws + WS_QMN); S.B1 = (const char*)(ws + WS_WOM);
        S.nM = T / 256; S.nN = DM / 256; S.G = F.G; S.c = F.bid; S.tstep = (size_t)256 * AW * 2;
        EpiMerge E{ws}; pg8::gemm_phase<true>(F.lds, AW, S, E);
    }
    SEAM(5);
    if (IN(6)) {
        pg8::StaticOrder S; S.init((const bf16_t*)(ws + WS_MIXED), (const bf16_t*)(ws + WS_WOUT), T, DM, DM, F.G, F.bid);
        EpiOut E{ws, F.in[IN_X], F.out, F.in[IN_G2]}; pg8::gemm_phase(F.lds, DM, S, E);
    }
    SEAM(6);
    if (IN(7)) {
        pg8::StaticOrder S; S.init((const bf16_t*)(ws + WS_X1G), (const bf16_t*)(ws + WS_WPQ), T, 2048, DM, F.G, F.bid);
        EpiPQ E{ws}; pg8::gemm_phase(F.lds, DM, S, E);
    }
    SEAM(7);
    if (IN(8)) { peer::peer_phase(F); }
#undef IN
#undef SEAM
}

extern "C" void kernel_launch(void* const* d_in, const int* in_sizes, int n_in, void* d_out, int out_size, void* d_ws, size_t ws_size, hipStream_t stream) {
    static int grid = 0;
    if (grid == 0) {
        if (n_in != 24 || out_size != T * DM || ws_size < WS_END) { fprintf(stderr, "kernel_launch: unexpected shapes (n_in %d, out %d, ws %zu < %zu)\n", n_in, out_size, ws_size, (size_t)WS_END); grid = -1; return; }
        int dev = 0, cus = 0, per_cu = 0;
        (void)hipGetDevice(&dev); (void)hipDeviceGetAttribute(&cus, hipDeviceAttributeMultiprocessorCount, dev);
        if (hipFuncSetAttribute((const void*)hybrid_fwd, hipFuncAttributeMaxDynamicSharedMemorySize, LDS_BYTES) != hipSuccess) { fprintf(stderr, "kernel_launch: hipFuncSetAttribute failed\n"); grid = -1; return; }
        if (hipOccupancyMaxActiveBlocksPerMultiprocessor(&per_cu, (const void*)hybrid_fwd, NTHREADS, LDS_BYTES) != hipSuccess || per_cu < 1) { fprintf(stderr, "kernel_launch: occupancy query says %d blocks/CU\n", per_cu); (void)hipGetLastError(); per_cu = 1; }
        grid = cus * (per_cu < 1 ? 1 : 1);
        fprintf(stderr, "kernel_launch: grid %d (cus %d, occupancy %d/CU)\n", grid, cus, per_cu);
    }
    if (grid < 0) return;
    Args a{};
    for (int i = 0; i < 24; ++i) a.in[i] = (const float*)d_in[i];
    a.out = (float*)d_out; a.ws = (unsigned char*)d_ws;
    a.ph_lo = 0; a.ph_hi = 9;
    void* kargs[] = {&a};
    hipError_t e = hipLaunchCooperativeKernel((const void*)hybrid_fwd, dim3(grid), dim3(NTHREADS), kargs, LDS_BYTES, stream);
    if (e != hipSuccess) fprintf(stderr, "kernel_launch: cooperative launch failed: %s (grid %d)\n", hipGetErrorString(e), grid);
}
```

```cpp
#include <hip/hip_runtime.h>
#include <hip/hip_cooperative_groups.h>
#include <cstdio>
#include <cstdint>
namespace cg = cooperative_groups;

#define LAS __attribute__((address_space(3)))
typedef unsigned short bf16_t;
typedef short bf16x8 __attribute__((ext_vector_type(8)));
typedef short s16x4 __attribute__((ext_vector_type(4)));
typedef float f32x2 __attribute__((ext_vector_type(2)));
typedef float f32x4 __attribute__((ext_vector_type(4)));
typedef float f32x16 __attribute__((ext_vector_type(16)));
typedef unsigned u32x2 __attribute__((ext_vector_type(2)));
typedef unsigned u32x4 __attribute__((ext_vector_type(4)));
typedef int i32x8 __attribute__((ext_vector_type(8)));
typedef __bf16 bf16x2_t __attribute__((ext_vector_type(2)));
typedef _Float16 f16x2 __attribute__((ext_vector_type(2)));

constexpr int NB = 8, SEQ = 4096, DM = 1024, T = NB * SEQ;
constexpr int AW = 512, NH = 8, HD = 64;
constexpr int QRANK = 384, KVRANK = 256, NOPE = 64, ROPED = 32, MQK = 96;
constexpr int IN_WIDTH = 4840, IN_PAD = 5120;
constexpr int PH = 8, PNK = 128, PNEXP = 16384, PDK = 256, PTOPK = 16;
constexpr int NSEL = 256;
constexpr float EPS = 1e-6f;
constexpr float LOG2E = 1.4426950408889634f;
constexpr float C2A = 0.125f * LOG2E;
constexpr float C2B = 0.10206207261596577f * LOG2E;

constexpr size_t MiB = 1u << 20;
constexpr size_t WS_ZERO = 0, ZERO_BYTES = 2 * MiB;
constexpr size_t WS_SSQ_CQ = 0;
constexpr size_t WS_SSQ_CKV = WS_SSQ_CQ + (size_t)T * 4;
constexpr size_t WS_SSQ_X1 = WS_SSQ_CKV + (size_t)T * 4;
constexpr size_t WS_SSQ_QM = WS_SSQ_X1 + (size_t)T * 4;
constexpr size_t WS_MOD = WS_SSQ_QM + (size_t)T * 8 * 4;
constexpr size_t WS_BIASQ = WS_MOD + (size_t)NB * 6144 * 4;
constexpr size_t WS_BAR = WS_BIASQ + (size_t)NB * 2048 * 4;
static_assert(WS_BAR + 3456 * 4 <= ZERO_BYTES, "zero region");
constexpr size_t WS_WIN = 3 * MiB;
constexpr size_t WS_WQUP = WS_WIN + (size_t)IN_PAD * DM * 2;
constexpr size_t WS_WKVUP = WS_WQUP + (size_t)768 * 384 * 2;
constexpr size_t WS_WOA = WS_WKVUP + (size_t)1024 * 256 * 2;
constexpr size_t WS_WOM = WS_WOA + (size_t)1024 * 512 * 2;
constexpr size_t WS_WOUT = WS_WOM + (size_t)1024 * 512 * 2;
constexpr size_t WS_WPQ = WS_WOUT + (size_t)1024 * 1024 * 2;
constexpr size_t WS_SUBK = WS_WPQ + (size_t)2048 * 1024 * 2;
constexpr size_t WS_ROPE32 = WS_SUBK + (size_t)16 * 128 * 128 * 2;
constexpr size_t WS_ROPE16 = WS_ROPE32 + (size_t)T * 64 * 4;
constexpr size_t WS_W_END = WS_ROPE16 + (size_t)T * 32 * 4;
static_assert(WS_W_END <= 36 * MiB, "weights region");
constexpr size_t R1 = 36 * MiB;
constexpr size_t WS_XN = R1, WS_QMN = R1, WS_QMR = R1 + 32 * MiB;
constexpr size_t R2 = 100 * MiB;
constexpr size_t WS_QA = R2, WS_KA = R2 + 32 * MiB, WS_VA = R2 + 64 * MiB, WS_QI = R2 + 96 * MiB, WS_PQ = R2;
constexpr size_t R3 = 228 * MiB;
constexpr size_t WS_GA = R3, WS_GM = R3 + 64 * MiB, WS_X1G = R3;
constexpr size_t R4 = 356 * MiB;
constexpr size_t WS_KMN = R4, WS_KMR = R4 + 32 * MiB, WS_VM = R4 + 48 * MiB, WS_PU = R4, WS_PV = R4 + 16 * MiB, WS_USC = R4 + 32 * MiB, WS_VSC = R4 + 33 * MiB;
constexpr size_t R5 = 436 * MiB;
constexpr size_t WS_CQ = R5, WS_CKV = R5 + 24 * MiB, WS_KI = R5 + 40 * MiB, WS_WI = R5 + 44 * MiB, WS_KPER = R5 + 45 * MiB,
                 WS_KPESSQ = R5 + 49 * MiB, WS_MASK = R5 + 50 * MiB, WS_MIXED = R5;
constexpr size_t WS_END = 502 * MiB;
static_assert(WS_MASK + (size_t)NB * 64 * SEQ * 8 <= WS_END, "ws map");

constexpr int LDS_BYTES = 155648;
constexpr int NWAVES = 8, NTHREADS = 512;

__device__ __forceinline__ unsigned cvt_pk_bf16(float lo, float hi) { unsigned r; asm volatile("v_cvt_pk_bf16_f32 %0, %1, %2" : "=v"(r) : "v"(lo), "v"(hi)); return r; }
__device__ __forceinline__ unsigned cvtpk_s(float lo, float hi) { f32x2 v = {lo, hi}; bf16x2_t b = __builtin_convertvector(v, bf16x2_t); return __builtin_bit_cast(unsigned, b); }
__device__ __forceinline__ float bf2f(unsigned short b) { return __uint_as_float((unsigned)b << 16); }
__device__ __forceinline__ float bflo(unsigned w) { return __uint_as_float(w << 16); }
__device__ __forceinline__ float bfhi(unsigned w) { return __uint_as_float(w & 0xffff0000u); }
__device__ __forceinline__ float rdlane_f(float v, int l) { return __int_as_float(__builtin_amdgcn_readlane(__float_as_int(v), l)); }
__device__ __forceinline__ float sigmoidf_(float v) { return __builtin_amdgcn_rcpf(1.0f + __builtin_amdgcn_exp2f(-v * LOG2E)); }
#define LDS_WAIT() asm volatile("s_waitcnt lgkmcnt(0)" ::: "memory")
#define VM_WAIT() asm volatile("s_waitcnt vmcnt(0)" ::: "memory")

namespace pg8 {
constexpr int BM = 256, BK = 64, HALF = 128, HTB = HALF * BK * 2, STAGE_BYTES = 8 * HTB, NXCD = 8, WGM = 8;
__host__ __device__ __forceinline__ int lds_byte(int r, int c) { const int st = (r >> 4) * 2 + (c >> 5), rr = r & 15, cc = c & 31, ob = rr * 64 + cc * 2; return st * 1024 + (ob ^ (((ob >> 9) & 1) << 5)); }
__host__ __device__ __forceinline__ void stage_rc(int b, int& R, int& C) { const int st = b / 1024, sb = b % 1024, swz = sb ^ (((sb >> 9) & 1) << 5); R = (st >> 1) * 16 + swz / 64; C = (st & 1) * 32 + (swz % 64) / 2; }

struct Unit { int pm, pn, tag; const char* A; const char* B; };

__device__ __forceinline__ bool tile_order(int L, int nM, int nN, int& pm, int& pn) {
    const int nwg = nM * nN; if (L >= nwg) return false;
    int wgid = L; { const int q = nwg / NXCD, r = nwg % NXCD, xcd = wgid % NXCD, off = wgid / NXCD; wgid = (xcd < r ? xcd * (q + 1) : r * (q + 1) + (xcd - r) * q) + off; }
    const int nig = WGM * nN, gid = wgid / nig, fm = gid * WGM, gsz = (nM - fm) < WGM ? (nM - fm) : WGM;
    pm = fm + ((wgid % nig) % gsz); pn = (wgid % nig) / gsz; return true;
}
struct StaticOrder {
    const char* A; const char* Bt; int nM, nN, G, c; size_t tstep;
    __device__ void init(const bf16_t* A_, const bf16_t* Bt_, int M, int N, int K, int G_, int c_) { A = (const char*)A_; Bt = (const char*)Bt_; nM = M / BM; nN = N / BM; G = G_; c = c_; tstep = (size_t)BM * K * 2; }
    __device__ __forceinline__ bool next(int i, Unit& u) const {
        int pm, pn; if (!tile_order(i * G + c, nM, nN, pm, pn)) return false;
        u.pm = pm; u.pn = pn; u.tag = 0; u.A = A + (size_t)pm * tstep; u.B = Bt + (size_t)pn * tstep; return true;
    }
};
struct DualOrder {
    const char* A0; const char* B0; const char* A1; const char* B1; int nM, nN, G, c; size_t tstep;
    __device__ __forceinline__ bool next(int i, Unit& u) const {
        int pm, pn; if (!tile_order((i >> 1) * G + c, nM, nN, pm, pn)) return false;
        u.pm = pm; u.pn = pn; u.tag = i & 1; u.A = ((i & 1) ? A1 : A0) + (size_t)pm * tstep; u.B = ((i & 1) ? B1 : B0) + (size_t)pn * tstep; return true;
    }
};

template <bool MERGE = false, class Epi, class Sched>
__device__ __forceinline__ void gemm_phase(LAS unsigned char* lds, const int K, const Sched& S, const Epi& E) {
    const int tid = threadIdx.x, wid = __builtin_amdgcn_readfirstlane(tid >> 6), lane = tid & 63, wr = wid >> 2, wc = wid & 3, fr = lane & 15, fq = lane >> 4;
    const int nt = K / BK;
    unsigned voffA[2];
#pragma unroll
    for (int i = 0; i < 2; ++i) { int R, C; stage_rc(tid * 16 + i * 8192, R, C); voffA[i] = (unsigned)(R * K + C) * 2u; }
    const size_t kstep = (size_t)(BK * 2);
    const size_t hstep = (size_t)HALF * K * 2;
    const unsigned ldsw = (unsigned)wid * 1024u;
    const int aoff = lds_byte(wr * 64 + fr, fq * 8), boff = lds_byte(wc * 32 + fr, fq * 8);
#define PG8_SA(b, h) (((b) * 2 + (h)) * HTB)
#define PG8_SB(b, h) ((4 + (b) * 2 + (h)) * HTB)
#define PG8_STAGE(bufoff, gbase) do { _Pragma("unroll") for (int _i = 0; _i < 2; ++_i) \
        __builtin_amdgcn_global_load_lds((const unsigned*)((const char*)(gbase) + voffA[_i]), (LAS unsigned*)(lds + (bufoff) + ldsw + _i * 8192), 16, 0, 0); } while (0)
#define PG8_LDA(dst, b, h) do { _Pragma("unroll") for (int m = 0; m < 4; ++m) _Pragma("unroll") for (int k = 0; k < 2; ++k) dst[m][k] = *(const LAS bf16x8*)(lds + PG8_SA(b, h) + aoff + m * 2048 + k * 1024); } while (0)
#define PG8_LDB(dst, b, h) do { _Pragma("unroll") for (int n = 0; n < 2; ++n) _Pragma("unroll") for (int k = 0; k < 2; ++k) dst[n][k] = *(const LAS bf16x8*)(lds + PG8_SB(b, h) + boff + n * 2048 + k * 1024); } while (0)
#define PG8_MMA(ai, bj, At, Bt) do { __builtin_amdgcn_s_setprio(1); _Pragma("unroll") for (int m = 0; m < 4; ++m) _Pragma("unroll") for (int n = 0; n < 2; ++n) _Pragma("unroll") for (int k = 0; k < 2; ++k) \
        acc[ai][bj][m][n] = __builtin_amdgcn_mfma_f32_16x16x32_bf16(Bt[n][k], At[m][k], acc[ai][bj][m][n], 0, 0, 0); __builtin_amdgcn_s_setprio(0); } while (0)
#define PG8_WAIT_V(n) asm volatile("s_waitcnt vmcnt(" #n ")" ::: "memory")
#define PG8_WAIT_L(n) asm volatile("s_waitcnt lgkmcnt(" #n ")" ::: "memory")
#define PG8_BAR __builtin_amdgcn_s_barrier()
#define PG8_SCHED __builtin_amdgcn_sched_barrier(0)
    Unit cur, nxt; int ui = 0;
    if (!S.next(0, cur)) return;
    f32x4 acc[2][2][4][2];
#pragma unroll
    for (int a = 0; a < 2; ++a)
#pragma unroll
        for (int b = 0; b < 2; ++b)
#pragma unroll
            for (int m = 0; m < 4; ++m)
#pragma unroll
                for (int n = 0; n < 2; ++n) acc[a][b][m][n] = (f32x4){0.f, 0.f, 0.f, 0.f};
    bf16x8 At[4][2], B0[2][2], B1[2][2];
    const char* cA = cur.A; const char* cB = cur.B;
    PG8_STAGE(PG8_SB(0, 0), cB); PG8_STAGE(PG8_SB(0, 1), cB + hstep); PG8_STAGE(PG8_SA(0, 0), cA); PG8_STAGE(PG8_SA(0, 1), cA + hstep);
    if (wr == 1) PG8_BAR;
    PG8_WAIT_V(2); PG8_BAR;
    PG8_STAGE(PG8_SB(1, 0), cB + kstep); PG8_STAGE(PG8_SA(1, 0), cA + kstep); PG8_STAGE(PG8_SB(1, 1), cB + hstep + kstep);
    PG8_WAIT_V(6); PG8_BAR;
    for (;;) {
        const bool has_next = S.next(ui + 1, nxt);
        const char* nA = has_next ? nxt.A : cA; const char* nB = has_next ? nxt.B : cB;
#pragma unroll 1
        for (int t = 0; t < nt; t += 2) {
            const bool last = (t == nt - 2);
            const char* a1 = cA + (size_t)(t + 1) * kstep;
            const char* a2 = last ? nA : cA + (size_t)(t + 2) * kstep; const char* b2 = last ? nB : cB + (size_t)(t + 2) * kstep;
            const char* a3 = a2 + kstep; const char* b3 = b2 + kstep;
            PG8_LDB(B0, 0, 0); PG8_LDB(B1, 0, 1); PG8_SCHED; PG8_LDA(At, 0, 0); PG8_STAGE(PG8_SA(1, 1), a1 + hstep);
            PG8_WAIT_V(8); PG8_WAIT_L(0); PG8_BAR; PG8_MMA(0, 0, At, B0); PG8_MMA(0, 1, At, B1); PG8_BAR; PG8_SCHED;
            PG8_LDA(At, 0, 1); PG8_STAGE(PG8_SB(0, 0), b2); PG8_STAGE(PG8_SB(0, 1), b2 + hstep); PG8_STAGE(PG8_SA(0, 0), a2);
            PG8_WAIT_V(8); PG8_WAIT_L(0); PG8_BAR; PG8_MMA(1, 0, At, B0); PG8_MMA(1, 1, At, B1); PG8_BAR; PG8_SCHED;
            PG8_LDB(B0, 1, 0); PG8_LDB(B1, 1, 1); PG8_SCHED; PG8_LDA(At, 1, 0); PG8_STAGE(PG8_SA(0, 1), a2 + hstep);
            PG8_WAIT_V(8); PG8_WAIT_L(0); PG8_BAR; PG8_MMA(0, 0, At, B0); PG8_MMA(0, 1, At, B1); PG8_BAR; PG8_SCHED;
            PG8_LDA(At, 1, 1); PG8_STAGE(PG8_SB(1, 0), b3); PG8_STAGE(PG8_SB(1, 1), b3 + hstep); PG8_STAGE(PG8_SA(1, 0), a3);
            PG8_WAIT_V(8); PG8_WAIT_L(0); PG8_BAR; PG8_MMA(1, 0, At, B0); PG8_MMA(1, 1, At, B1); PG8_BAR; PG8_SCHED;
        }
        if (wr == 0) PG8_BAR;
        bool keep = false;
        if constexpr (MERGE) { if (cur.tag == 0) { E.mid(acc, cur, wr, wc, fr, fq); keep = true; } else E(acc, cur, wr, wc, fr, fq); } else E(acc, cur, wr, wc, fr, fq);
        if (!has_next) break;
        if (!keep) {
#pragma unroll
        for (int a = 0; a < 2; ++a)
#pragma unroll
            for (int b = 0; b < 2; ++b)
#pragma unroll
                for (int m = 0; m < 4; ++m)
#pragma unroll
                    for (int n = 0; n < 2; ++n) acc[a][b][m][n] = (f32x4){0.f, 0.f, 0.f, 0.f};
        }
        cur = nxt; cA = nA; cB = nB; ++ui;
        if (wr == 1) PG8_BAR;
    }
    PG8_WAIT_V(0);
    PG8_BAR;
#undef PG8_SA
#undef PG8_SB
#undef PG8_STAGE
#undef PG8_LDA
#undef PG8_LDB
#undef PG8_MMA
#undef PG8_WAIT_V
#undef PG8_WAIT_L
#undef PG8_BAR
#undef PG8_SCHED
}
}

struct Args {
    const float* in[24]; float* out; unsigned char* ws; int ph_lo, ph_hi;
};
struct Frame {
    LAS unsigned char* lds; unsigned char* ws;
    int tid, lane, wave, G, bid;
    const float* in[24]; float* out;
};
#define IN_X 0
#define IN_C 1
#define IN_POS 2
#define IN_G1 3
#define IN_G2 4
#define IN_WADA 5
#define IN_BADA 6
#define IN_WIN 7
#define IN_GAQ 8
#define IN_GAK 9
#define IN_GIDXK 10
#define IN_GMQA 11
#define IN_WMQUP 12
#define IN_GMKVA 13
#define IN_WMKVUP 14
#define IN_GMQ 15
#define IN_GMK 16
#define IN_WOA 17
#define IN_WOM 18
#define IN_WOUT 19
#define IN_WPQ 20
#define IN_SUBK 21
#define IN_PU 22
#define IN_PV 23

__device__ __forceinline__ void gemv8_block(const float* vec, int vstride, bool silu, const float* W, int N, float* out, const float* bias, int cb, LAS float* red, int wave, int lane, int tid, int kbeg = 0, int nkc = 2, bool accumulate = false) {
    const int j = cb * 64 + lane;
    float acc[8];
#pragma unroll
    for (int b = 0; b < 8; ++b) acc[b] = 0.f;
#pragma unroll 1
    for (int kc = 0; kc < nkc; ++kc) {
        const int k0 = kbeg + wave * (64 * nkc) + kc * 64;
        float cv[8];
#pragma unroll
        for (int b = 0; b < 8; ++b) { float v = vec[(size_t)b * vstride + k0 + lane]; if (silu) v = v * sigmoidf_(v); cv[b] = v; }
#pragma unroll 8
        for (int kk = 0; kk < 64; ++kk) {
            const float w = W[(size_t)(k0 + kk) * N + j];
#pragma unroll
            for (int b = 0; b < 8; ++b) acc[b] += rdlane_f(cv[b], kk) * w;
        }
    }
#pragma unroll
    for (int b = 0; b < 8; ++b) red[(wave * 8 + b) * 64 + lane] = acc[b];
    __syncthreads();
    { const int b = tid >> 6, l = tid & 63; float s = bias ? bias[cb * 64 + l] : 0.f;
#pragma unroll
      for (int w = 0; w < 8; ++w) s += red[(w * 8 + b) * 64 + l];
      if (accumulate) atomicAdd(out + (size_t)b * N + cb * 64 + l, s); else out[(size_t)b * N + cb * 64 + l] = s; }
    __syncthreads();
}

__device__ __forceinline__ int headperm(int d, int wc) { return 128 * (d >> 5) + 32 * wc + (d & 31); }
__device__ __forceinline__ int dest_win(int c) {
    if (c < 2048) { const int seg = c >> 9, hc = c & 511, h = hc >> 6, d = hc & 63; return (2 * seg + (h >> 2)) * 256 + headperm(d, h & 3); }
    if (c < 2112) { const int d = c - 2048; return 8 * 256 + headperm(d, 0); }
    if (c < 2120) return 8 * 256 + 128 + 32 + (c - 2112);
    if (c < 2504) return 9 * 256 + (c - 2120);
    if (c < 2760) return 11 * 256 + (c - 2504);
    if (c < 2792) return 8 * 256 + 32 + (c - 2760);
    if (c < 3816) return 12 * 256 + (c - 2792);
    return 16 * 256 + (c - 3816);
}
__device__ __forceinline__ int dest_qup(int c) {
    const int h = c / 96, dd = c % 96;
    if (dd < 64) return (h >> 2) * 256 + headperm(dd, h & 3);
    return 512 + 128 * (h & 1) + 32 * (h >> 1) + (dd - 64);
}
__device__ __forceinline__ int dest_kvup(int c) {
    const int h = c >> 7, dd = c & 127;
    return ((dd >> 6) * 2 + (h >> 2)) * 256 + headperm(dd & 63, h & 3);
}
template <int MODE>
__device__ __forceinline__ void transpose_item(const float* W, int K, int N, bf16_t* WT, const float* kscale, LAS float* scr, int item, int lane) {
    const int nblk = (N + 31) / 32, kb = item / nblk, nb = item % nblk, k0 = 64 * kb, n0 = 32 * nb;
#pragma unroll 8
    for (int i = 0; i < 32; ++i) {
        const int kk = 2 * i + (lane >> 5), n = n0 + (lane & 31);
        float v = (n < N) ? W[(size_t)(k0 + kk) * N + n] : 0.f;
        if (kscale) v *= kscale[k0 + kk];
        scr[kk * 33 + (lane & 31)] = v;
    }
    LDS_WAIT(); asm volatile("" ::: "memory");
    const int c = lane & 7;
#pragma unroll
    for (int j = 0; j < 4; ++j) {
        const int nn = (lane >> 3) + 8 * j, n = n0 + nn;
        if (n < N) {
            const LAS float* s = scr + (8 * c) * 33 + nn;
            u32x4 o; o.x = cvtpk_s(s[0 * 33], s[1 * 33]); o.y = cvtpk_s(s[2 * 33], s[3 * 33]); o.z = cvtpk_s(s[4 * 33], s[5 * 33]); o.w = cvtpk_s(s[6 * 33], s[7 * 33]);
            const int d = (MODE == 0) ? n : (MODE == 1) ? dest_win(n) : (MODE == 2) ? dest_qup(n) : dest_kvup(n);
            *(u32x4*)(WT + (size_t)d * K + k0 + 8 * c) = o;
        }
    }
    LDS_WAIT(); asm volatile("" ::: "memory");
}
__device__ __forceinline__ void cvt_bf16_stream(const float* src, bf16_t* dst, size_t n, size_t gtid, size_t gthreads) {
    for (size_t i = gtid * 8; i < n; i += gthreads * 8) {
        const f32x4 a = *(const f32x4*)(src + i), b = *(const f32x4*)(src + i + 4);
        u32x4 o; o.x = cvtpk_s(a.x, a.y); o.y = cvtpk_s(a.z, a.w); o.z = cvtpk_s(b.x, b.y); o.w = cvtpk_s(b.z, b.w);
        *(u32x4*)(dst + i) = o;
    }
}
__device__ __forceinline__ void cvt_fp4_rows(const float* src, unsigned char* dst, float* inv, int nrows, int gw, int NGW, int lane) {
    for (int row = gw; row < nrows; row += NGW) {
        const float* p = src + (size_t)row * DM + 256 * (lane & 3) + 64 * (lane >> 4) + ((lane >> 2) & 3);
        f32x4 v[4]; float am = 0.f;
#pragma unroll
        for (int j = 0; j < 4; ++j) { v[j] = (f32x4){p[16 * j], p[16 * j + 4], p[16 * j + 8], p[16 * j + 12]}; am = __builtin_fmaxf(am, __builtin_fmaxf(__builtin_fmaxf(fabsf(v[j].x), fabsf(v[j].y)), __builtin_fmaxf(fabsf(v[j].z), fabsf(v[j].w)))); }
#pragma unroll
        for (int o = 1; o < 64; o <<= 1) am = __builtin_fmaxf(am, __shfl_xor(am, o));
        am = __builtin_fmaxf(am, 1e-30f);
        const float sc = 6.f / am;
        if (lane == 0) inv[row] = am * (1.f / 6.f);
        unsigned w0 = 0u, w1 = 0u;
        w0 = __builtin_amdgcn_cvt_scalef32_pk_fp4_f32(w0, v[0].x * sc, v[0].y * sc, 1.0f, 0); w0 = __builtin_amdgcn_cvt_scalef32_pk_fp4_f32(w0, v[0].z * sc, v[0].w * sc, 1.0f, 1);
        w0 = __builtin_amdgcn_cvt_scalef32_pk_fp4_f32(w0, v[1].x * sc, v[1].y * sc, 1.0f, 2); w0 = __builtin_amdgcn_cvt_scalef32_pk_fp4_f32(w0, v[1].z * sc, v[1].w * sc, 1.0f, 3);
        w1 = __builtin_amdgcn_cvt_scalef32_pk_fp4_f32(w1, v[2].x * sc, v[2].y * sc, 1.0f, 0); w1 = __builtin_amdgcn_cvt_scalef32_pk_fp4_f32(w1, v[2].z * sc, v[2].w * sc, 1.0f, 1);
        w1 = __builtin_amdgcn_cvt_scalef32_pk_fp4_f32(w1, v[3].x * sc, v[3].y * sc, 1.0f, 2); w1 = __builtin_amdgcn_cvt_scalef32_pk_fp4_f32(w1, v[3].z * sc, v[3].w * sc, 1.0f, 3);
        *((u32x2*)(dst + (size_t)row * (DM / 2)) + lane) = (u32x2){w0, w1};
    }
}
__device__ __forceinline__ void cvt_i4_rows(const float* src, unsigned char* dst, float* inv, int nrows, int gw, int NGW, int lane) {
    for (int row = gw; row < nrows; row += NGW) {
        const f32x4* p = (const f32x4*)(src + (size_t)row * DM) + 4 * lane;
        f32x4 v[4]; float am = 0.f;
#pragma unroll
        for (int j = 0; j < 4; ++j) { v[j] = p[j]; am = __builtin_fmaxf(am, __builtin_fmaxf(__builtin_fmaxf(fabsf(v[j].x), fabsf(v[j].y)), __builtin_fmaxf(fabsf(v[j].z), fabsf(v[j].w)))); }
#pragma unroll
        for (int o = 1; o < 64; o <<= 1) am = __builtin_fmaxf(am, __shfl_xor(am, o));
        am = __builtin_fmaxf(am, 1e-30f);
        const float sc = 9.5f / am;
        if (lane == 0) inv[row] = am * (1.f / 9.5f);
        unsigned w[2] = {0u, 0u};
#pragma unroll
        for (int j = 0; j < 4; ++j) {
#pragma unroll
            for (int e = 0; e < 4; ++e) { const float x = __builtin_amdgcn_fmed3f(__builtin_rintf(v[j][e] * sc), -7.f, 7.f); w[j >> 1] |= ((unsigned)(int)x & 15u) << (4 * (4 * (j & 1) + e)); }
        }
        *((u32x2*)(dst + (size_t)row * (DM / 2)) + lane) = (u32x2){w[0], w[1]};
    }
}
__device__ __forceinline__ void rope_cs(int pos, int i, int half, float& c, float& s) {
    const float inv = (float)exp(-9.210340371976184 * (double)i / (double)half);
    const float ang = (float)pos * inv;
    double x = (double)ang * 0.15915494309189535;
    x -= rint(x);
    const float xf = (float)x;
    c = __builtin_amdgcn_cosf(xf); s = __builtin_amdgcn_sinf(xf);
}

__device__ __forceinline__ void phase0(Frame& F) {
    const int gw = F.bid * NWAVES + F.wave, NGW = F.G * NWAVES;
    unsigned char* ws = F.ws;
    for (int cb = F.G - 1 - F.bid; cb < 96; cb += F.G) gemv8_block(F.in[IN_C], DM, true, F.in[IN_WADA], 6144, (float*)(ws + WS_MOD), F.in[IN_BADA], cb, (LAS float*)(F.lds + 8 * 16384), F.wave, F.lane, F.tid);
    { const size_t gt = (size_t)F.bid * NTHREADS + F.tid, gn = (size_t)F.G * NTHREADS; u32x4* z = (u32x4*)(ws + WS_SSQ_CQ);
      for (size_t i = gt; i < (WS_MOD - WS_SSQ_CQ) / 16; i += gn) z[i] = (u32x4){0u, 0u, 0u, 0u};
      for (size_t i = gt; i < (size_t)NB * 2048 / 4; i += gn) ((u32x4*)(ws + WS_BIASQ))[i] = (u32x4){0u, 0u, 0u, 0u};
      for (size_t i = gt; i < 3456; i += gn) ((unsigned*)(ws + WS_BAR))[i] = 0u;
    }
}
__device__ __forceinline__ void phase0b(Frame& F) {
    const int gw = F.bid * NWAVES + F.wave, NGW = F.G * NWAVES; (void)gw; (void)NGW;
    unsigned char* ws = F.ws;
    LAS float* scr = (LAS float*)(F.lds + F.wave * 16384);
    constexpr int I_WIN = 16 * 152, I_QUP = 6 * 24, I_KVUP = 4 * 32, I_OA = 8 * 32, I_OUT = 16 * 32, I_PQ = 16 * 64;
    constexpr int NITEMS = I_WIN + I_QUP + I_KVUP + 2 * I_OA + I_OUT + I_PQ;
    const int ntw_ = F.G; const bool tr_wg = true;
    for (int it = F.bid * NWAVES + F.wave; tr_wg && it < NITEMS; it += ntw_ * NWAVES) {
        int r = it;
        if (r < I_WIN) { transpose_item<1>(F.in[IN_WIN], DM, IN_WIDTH, (bf16_t*)(ws + WS_WIN), nullptr, scr, r, F.lane); continue; } r -= I_WIN;
        if (r < I_QUP) { transpose_item<2>(F.in[IN_WMQUP], QRANK, 768, (bf16_t*)(ws + WS_WQUP), F.in[IN_GMQA], scr, r, F.lane); continue; } r -= I_QUP;
        if (r < I_KVUP) { transpose_item<3>(F.in[IN_WMKVUP], KVRANK, 1024, (bf16_t*)(ws + WS_WKVUP), F.in[IN_GMKVA], scr, r, F.lane); continue; } r -= I_KVUP;
        if (r < I_OA) { transpose_item<0>(F.in[IN_WOA], AW, DM, (bf16_t*)(ws + WS_WOA), nullptr, scr, r, F.lane); continue; } r -= I_OA;
        if (r < I_OA) { transpose_item<0>(F.in[IN_WOM], AW, DM, (bf16_t*)(ws + WS_WOM), nullptr, scr, r, F.lane); continue; } r -= I_OA;
        if (r < I_OUT) { transpose_item<0>(F.in[IN_WOUT], DM, DM, (bf16_t*)(ws + WS_WOUT), nullptr, scr, r, F.lane); continue; } r -= I_OUT;
        transpose_item<0>(F.in[IN_WPQ], DM, 2048, (bf16_t*)(ws + WS_WPQ), nullptr, scr, r, F.lane);
    }
    const size_t gtid = (size_t)F.bid * NTHREADS + F.tid, gth = (size_t)F.G * NTHREADS;
    for (size_t g = gtid; g < (size_t)16 * 128 * 128 / 8; g += gth) {
        const int ln = (int)(g & 63), ks = (int)((g >> 6) & 7), kb = (int)((g >> 9) & 3), hp = (int)(g >> 11);
        const float* sp = F.in[IN_SUBK] + ((size_t)hp * 128 + 32 * kb + (ln & 31)) * 128 + 16 * ks + 8 * (ln >> 5);
        const f32x4 a = *(const f32x4*)sp, b = *(const f32x4*)(sp + 4);
        u32x4 o; o.x = cvtpk_s(a.x, a.y); o.y = cvtpk_s(a.z, a.w); o.z = cvtpk_s(b.x, b.y); o.w = cvtpk_s(b.z, b.w);
        *(u32x4*)((bf16_t*)(ws + WS_SUBK) + g * 8) = o;
    }
    const int* pos = (const int*)F.in[IN_POS];
    float* r32 = (float*)(ws + WS_ROPE32); float* r16 = (float*)(ws + WS_ROPE16);
    for (size_t e = gtid; e < (size_t)T * 48; e += gth) {
        const int t = (int)(e / 48), i = (int)(e % 48); const int p = pos[t]; float c, s;
        if (i < 32) { rope_cs(p, i, 32, c, s); r32[(size_t)t * 64 + i] = c; r32[(size_t)t * 64 + 32 + i] = s; }
        else { rope_cs(p, i - 32, 16, c, s); r16[(size_t)t * 32 + (i - 32)] = c; r16[(size_t)t * 32 + 16 + (i - 32)] = s; }
    }
}

__device__ __forceinline__ float wave_sum(float v) {
#pragma unroll
    for (int o = 1; o < 64; o <<= 1) v += __shfl_xor(v, o);
    return v;
}
__device__ __forceinline__ void phase1(Frame& F) {
    phase0b(F);
    __syncthreads();
    const int gw = F.bid * NWAVES + F.wave, NGW = F.G * NWAVES;
    const float* mod = (const float*)(F.ws + WS_MOD);
    for (int tk = F.G - 1 - F.bid; tk < 64; tk += F.G) gemv8_block(mod + 3072, 6144, false, F.in[IN_WPQ], 2048, (float*)(F.ws + WS_BIASQ), nullptr, tk & 31, (LAS float*)F.lds, F.wave, F.lane, F.tid, (tk >> 5) * 512, 1, true);
    const float* g1 = F.in[IN_G1];
    bf16_t* XN = (bf16_t*)(F.ws + WS_XN);
    for (int m0 = 2 * gw; m0 < T; m0 += 2 * NGW) {
        f32x4 v[2][4]; float s[2] = {0.f, 0.f};
#pragma unroll
        for (int u = 0; u < 2; ++u) { const f32x4* xr = (const f32x4*)(F.in[IN_X] + (size_t)(m0 + u) * DM) + F.lane;
#pragma unroll
            for (int j = 0; j < 4; ++j) v[u][j] = __builtin_nontemporal_load(xr + 64 * j); }
#pragma unroll
        for (int u = 0; u < 2; ++u)
#pragma unroll
            for (int j = 0; j < 4; ++j) s[u] += (v[u][j].x * v[u][j].x + v[u][j].y * v[u][j].y) + (v[u][j].z * v[u][j].z + v[u][j].w * v[u][j].w);
#pragma unroll
        for (int u = 0; u < 2; ++u) {
            const int m = m0 + u, b = m / SEQ;
            const float rinv = __builtin_amdgcn_rsqf(wave_sum(s[u]) * (1.f / DM) + EPS);
            unsigned long long* o8 = (unsigned long long*)(XN + (size_t)m * DM) + F.lane;
#pragma unroll
            for (int j = 0; j < 4; ++j) {
                const int col = 4 * F.lane + 256 * j;
                const f32x4 g = *(const f32x4*)(g1 + col), sh = *(const f32x4*)(mod + (size_t)b * 6144 + col), sc = *(const f32x4*)(mod + (size_t)b * 6144 + 1024 + col);
                const f32x4 h = v[u][j] * rinv * g * (sc + 1.0f) + sh;
                o8[64 * j] = (unsigned long long)cvtpk_s(h.x, h.y) | ((unsigned long long)cvtpk_s(h.z, h.w) << 32);
            }
        }
    }
}

__device__ __forceinline__ u32x2 pk4(const f32x4 v) { u32x2 o; o.x = cvtpk_s(v.x, v.y); o.y = cvtpk_s(v.z, v.w); return o; }
__device__ __forceinline__ void st8(bf16_t* grp, const u32x2 X, const u32x2 Y, int fq) {
    auto r0 = __builtin_amdgcn_permlane16_swap(X.x, Y.x, false, false); auto r1 = __builtin_amdgcn_permlane16_swap(X.y, Y.y, false, false);
    *(u32x4*)(grp + 8 * (fq >> 1) + 16 * (fq & 1)) = (u32x4){r0[0], r1[0], r0[1], r1[1]};
}
__device__ __forceinline__ void ld8(const bf16_t* grp, u32x2& X, u32x2& Y, int fq) {
    const u32x4 w = *(const u32x4*)(grp + 8 * (fq >> 1) + 16 * (fq & 1));
    auto r0 = __builtin_amdgcn_permlane16_swap(w[0], w[2], false, false); auto r1 = __builtin_amdgcn_permlane16_swap(w[1], w[3], false, false);
    X = (u32x2){r0[0], r1[0]}; Y = (u32x2){r0[1], r1[1]};
}
__device__ __forceinline__ float sum4sq(const f32x4 v) { return (v.x * v.x + v.y * v.y) + (v.z * v.z + v.w * v.w); }
__device__ __forceinline__ float fq_sum(float s) {
    { auto r = __builtin_amdgcn_permlane16_swap(__float_as_uint(s), __float_as_uint(s), false, false); s = __uint_as_float(r[0]) + __uint_as_float(r[1]); }
    { auto r = __builtin_amdgcn_permlane32_swap(__float_as_uint(s), __float_as_uint(s), false, false); s = __uint_as_float(r[0]) + __uint_as_float(r[1]); }
    return s;
}

struct EpiIn {
    unsigned char* ws; const float* gaq; const float* gak; const float* gidxk; const float* gmk;
    template <bool NORM>
    __device__ __forceinline__ void normrope64(const f32x4 (&acc)[2][2][4][2], int row0, int fq, const float* gain, float scale, bf16_t* dst, int pitch, int colbase) const {
        const float* rope = (const float*)(ws + WS_ROPE32);
        f32x4 gv[2][2];
#pragma unroll
        for (int bj = 0; bj < 2; ++bj)
#pragma unroll
            for (int n = 0; n < 2; ++n) gv[bj][n] = NORM ? *(const f32x4*)(gain + 32 * bj + 16 * n + 4 * fq) * scale : (f32x4){scale, scale, scale, scale};
#pragma unroll
        for (int ai = 0; ai < 2; ++ai)
#pragma unroll
            for (int m = 0; m < 4; ++m) {
                const int row = row0 + 128 * ai + 16 * m;
                float rinv = 1.f;
                if (NORM) {
                    float s = 0.f;
#pragma unroll
                    for (int bj = 0; bj < 2; ++bj)
#pragma unroll
                        for (int n = 0; n < 2; ++n) s += sum4sq(acc[ai][bj][m][n]);
                    rinv = __builtin_amdgcn_rsqf(fq_sum(s) * (1.f / 64.f) + EPS);
                }
                bf16_t* o = dst + (size_t)row * pitch + colbase; u32x2 lo[2], hi[2];
#pragma unroll
                for (int n = 0; n < 2; ++n) {
                    const f32x4 cs = *(const f32x4*)(rope + (size_t)row * 64 + 16 * n + 4 * fq), sn = *(const f32x4*)(rope + (size_t)row * 64 + 32 + 16 * n + 4 * fq);
                    const f32x4 x1 = acc[ai][0][m][n] * rinv * gv[0][n], x2 = acc[ai][1][m][n] * rinv * gv[1][n];
                    lo[n] = pk4(x1 * cs - x2 * sn); hi[n] = pk4(x2 * cs + x1 * sn);
                }
                st8(o, lo[0], lo[1], fq); st8(o + 32, hi[0], hi[1], fq);
                asm volatile("" ::: "memory");
            }
    }
    __device__ __forceinline__ void operator()(const f32x4 (&acc)[2][2][4][2], const pg8::Unit& u, int wr, int wc, int fr, int fq) const {
        const int pn = u.pn, row0 = u.pm * 256 + wr * 64 + fr;
        if (pn < 2) { normrope64<true>(acc, row0, fq, gaq, C2A, (bf16_t*)(ws + WS_QA), AW, ((pn & 1) * 4 + wc) * 64); return; }
        if (pn < 4) { normrope64<true>(acc, row0, fq, gak, 1.f, (bf16_t*)(ws + WS_KA), AW, ((pn & 1) * 4 + wc) * 64); return; }
        if (pn < 6) {
            bf16_t* dst = (bf16_t*)(ws + WS_VA);
#pragma unroll
            for (int ai = 0; ai < 2; ++ai)
#pragma unroll
                for (int m = 0; m < 4; ++m) { bf16_t* o = dst + (size_t)(row0 + 128 * ai + 16 * m) * AW + ((pn & 1) * 4 + wc) * 64;
#pragma unroll
                    for (int bj = 0; bj < 2; ++bj) st8(o + 32 * bj, pk4(acc[ai][bj][m][0]), pk4(acc[ai][bj][m][1]), fq); asm volatile("" ::: "memory"); }
            return;
        }
        if (pn < 8) { normrope64<false>(acc, row0, fq, nullptr, 1.f, (bf16_t*)(ws + WS_QI), AW, ((pn & 1) * 4 + wc) * 64); return; }
        if (pn == 8) {
            if (wc == 0) { normrope64<true>(acc, row0, fq, gidxk, 1.f, (bf16_t*)(ws + WS_KI), 64, 0); return; }
            if (wc == 1) {
                const float* rope = (const float*)(ws + WS_ROPE16);
                float* kper = (float*)(ws + WS_KPER); float* kss = (float*)(ws + WS_KPESSQ); float* wi = (float*)(ws + WS_WI);
                const f32x4 g1 = *(const f32x4*)(gmk + 64 + 4 * fq), g2 = *(const f32x4*)(gmk + 80 + 4 * fq);
#pragma unroll
                for (int ai = 0; ai < 2; ++ai)
#pragma unroll
                    for (int m = 0; m < 4; ++m) {
                        const int row = row0 + 128 * ai + 16 * m;
                        const f32x4 a = acc[ai][0][m][0], b = acc[ai][0][m][1];
                        const float s = fq_sum(sum4sq(a) + sum4sq(b));
                        if (fq == 0) kss[row] = s;
                        const f32x4 cs = *(const f32x4*)(rope + (size_t)row * 32 + 4 * fq), sn = *(const f32x4*)(rope + (size_t)row * 32 + 16 + 4 * fq);
                        const f32x4 x1 = a * g1, x2 = b * g2;
                        *(f32x4*)(kper + (size_t)row * 32 + 4 * fq) = x1 * cs - x2 * sn;
                        *(f32x4*)(kper + (size_t)row * 32 + 16 + 4 * fq) = x2 * cs + x1 * sn;
                        if (fq < 2) *(f32x4*)(wi + (size_t)row * 8 + 4 * fq) = acc[ai][1][m][0] * 0.044194173824159216f;
                        asm volatile("" ::: "memory");
                    }
            }
            return;
        }
        if (pn < 12) {
            const bool isq = pn < 11; const int cb = isq ? (pn - 9) * 256 : 0, width = isq ? QRANK : KVRANK;
            bf16_t* dst = (bf16_t*)(ws + (isq ? WS_CQ : WS_CKV)); float* ssq = (float*)(ws + (isq ? WS_SSQ_CQ : WS_SSQ_CKV));
#pragma unroll
            for (int ai = 0; ai < 2; ++ai)
#pragma unroll
                for (int m = 0; m < 4; ++m) {
                    const int row = row0 + 128 * ai + 16 * m; float s = 0.f;
#pragma unroll
                    for (int bj = 0; bj < 2; ++bj) { const int col = cb + 128 * bj + 32 * wc;
                        if (col < width) { st8(dst + (size_t)row * width + col, pk4(acc[ai][bj][m][0]), pk4(acc[ai][bj][m][1]), fq); s += sum4sq(acc[ai][bj][m][0]) + sum4sq(acc[ai][bj][m][1]); } }
                    s = fq_sum(s);
                    if (fq == 0) atomicAdd(ssq + row, s);
                    asm volatile("" ::: "memory");
                }
            return;
        }
        {
            bf16_t* dst = (bf16_t*)(ws + (pn < 16 ? WS_GA : WS_GM)); const int cb = ((pn - 12) & 3) * 256 + 32 * wc;
#pragma unroll
            for (int ai = 0; ai < 2; ++ai)
#pragma unroll
                for (int m = 0; m < 4; ++m) { bf16_t* o = dst + (size_t)(row0 + 128 * ai + 16 * m) * DM + cb;
#pragma unroll
                    for (int bj = 0; bj < 2; ++bj) { const f32x4 v = acc[ai][bj][m][0], w = acc[ai][bj][m][1];
                        st8(o + 128 * bj, pk4((f32x4){sigmoidf_(v.x), sigmoidf_(v.y), sigmoidf_(v.z), sigmoidf_(v.w)}), pk4((f32x4){sigmoidf_(w.x), sigmoidf_(w.y), sigmoidf_(w.z), sigmoidf_(w.w)}), fq); } asm volatile("" ::: "memory"); }
        }
    }
};

struct EpiQup {
    unsigned char* ws; const float* gmq;
    __device__ __forceinline__ void operator()(const f32x4 (&acc)[2][2][4][2], const pg8::Unit& u, int wr, int wc, int fr, int fq) const {
        const int pn = u.pn, row0 = u.pm * 256 + wr * 64 + fr;
        const float* ssqc = (const float*)(ws + WS_SSQ_CQ); float* ssqm = (float*)(ws + WS_SSQ_QM);
        if (pn < 2) {
            const int head = pn * 4 + wc; bf16_t* dst = (bf16_t*)(ws + WS_QMN);
            f32x4 gv[2][2];
#pragma unroll
            for (int bj = 0; bj < 2; ++bj)
#pragma unroll
                for (int n = 0; n < 2; ++n) gv[bj][n] = *(const f32x4*)(gmq + 32 * bj + 16 * n + 4 * fq) * C2B;
#pragma unroll
            for (int ai = 0; ai < 2; ++ai)
#pragma unroll
                for (int m = 0; m < 4; ++m) {
                    const int row = row0 + 128 * ai + 16 * m;
                    const float rc = __builtin_amdgcn_rsqf(ssqc[row] * (1.f / QRANK) + EPS);
                    float s = 0.f; bf16_t* o = dst + (size_t)row * 512 + head * 64;
#pragma unroll
                    for (int bj = 0; bj < 2; ++bj) { const f32x4 q0 = acc[ai][bj][m][0] * rc, q1 = acc[ai][bj][m][1] * rc; s += sum4sq(q0) + sum4sq(q1); st8(o + 32 * bj, pk4(q0 * gv[bj][0]), pk4(q1 * gv[bj][1]), fq); }
                    s = fq_sum(s);
                    if (fq == 0) atomicAdd(ssqm + (size_t)row * 8 + head, s);
                    asm volatile("" ::: "memory");
                }
            return;
        }
        {
            const float* rope = (const float*)(ws + WS_ROPE16); bf16_t* dst = (bf16_t*)(ws + WS_QMR);
            const f32x4 g1 = *(const f32x4*)(gmq + 64 + 4 * fq) * C2B, g2 = *(const f32x4*)(gmq + 80 + 4 * fq) * C2B;
#pragma unroll
            for (int ai = 0; ai < 2; ++ai)
#pragma unroll
                for (int m = 0; m < 4; ++m) {
                    const int row = row0 + 128 * ai + 16 * m;
                    const float rc = __builtin_amdgcn_rsqf(ssqc[row] * (1.f / QRANK) + EPS);
                    const f32x4 cs = *(const f32x4*)(rope + (size_t)row * 32 + 4 * fq), sn = *(const f32x4*)(rope + (size_t)row * 32 + 16 + 4 * fq);
#pragma unroll
                    for (int bj = 0; bj < 2; ++bj) {
                        const int head = 2 * wc + bj;
                        const f32x4 a = acc[ai][bj][m][0] * rc, b = acc[ai][bj][m][1] * rc;
                        const float s = fq_sum(sum4sq(a) + sum4sq(b));
                        if (fq == 0) atomicAdd(ssqm + (size_t)row * 8 + head, s);
                        const f32x4 x1 = a * g1, x2 = b * g2;
                        st8(dst + (size_t)row * 256 + head * 32, pk4(x1 * cs - x2 * sn), pk4(x2 * cs + x1 * sn), fq);
                    }
                    asm volatile("" ::: "memory");
                }
        }
    }
};
struct EpiKVup {
    unsigned char* ws; const float* gmk;
    __device__ __forceinline__ void operator()(const f32x4 (&acc)[2][2][4][2], const pg8::Unit& u, int wr, int wc, int fr, int fq) const {
        const int pn = u.pn, row0 = u.pm * 256 + wr * 64 + fr, head = (pn & 1) * 4 + wc;
        const float* ssqc = (const float*)(ws + WS_SSQ_CKV);
        if (pn < 2) {
            const float* kss = (const float*)(ws + WS_KPESSQ); const float* kper = (const float*)(ws + WS_KPER);
            bf16_t* dn = (bf16_t*)(ws + WS_KMN); bf16_t* dr = (bf16_t*)(ws + WS_KMR);
            f32x4 gv[2][2];
#pragma unroll
            for (int bj = 0; bj < 2; ++bj)
#pragma unroll
                for (int n = 0; n < 2; ++n) gv[bj][n] = *(const f32x4*)(gmk + 32 * bj + 16 * n + 4 * fq);
#pragma unroll
            for (int ai = 0; ai < 2; ++ai)
#pragma unroll
                for (int m = 0; m < 4; ++m) {
                    const int row = row0 + 128 * ai + 16 * m;
                    const float rc = __builtin_amdgcn_rsqf(ssqc[row] * (1.f / KVRANK) + EPS);
                    float s = 0.f; f32x4 kn[2][2];
#pragma unroll
                    for (int bj = 0; bj < 2; ++bj)
#pragma unroll
                        for (int n = 0; n < 2; ++n) { kn[bj][n] = acc[ai][bj][m][n] * rc; s += sum4sq(kn[bj][n]); }
                    s = fq_sum(s) + kss[row];
                    const float rinv = __builtin_amdgcn_rsqf(s * (1.f / MQK) + EPS);
                    bf16_t* o = dn + (size_t)row * 512 + head * 64;
#pragma unroll
                    for (int bj = 0; bj < 2; ++bj) st8(o + 32 * bj, pk4(kn[bj][0] * gv[bj][0] * rinv), pk4(kn[bj][1] * gv[bj][1] * rinv), fq);
                    const f32x4 ra = *(const f32x4*)(kper + (size_t)row * 32 + 8 * fq) * rinv, rb = *(const f32x4*)(kper + (size_t)row * 32 + 8 * fq + 4) * rinv;
                    u32x4 w; w.x = cvtpk_s(ra.x, ra.y); w.y = cvtpk_s(ra.z, ra.w); w.z = cvtpk_s(rb.x, rb.y); w.w = cvtpk_s(rb.z, rb.w);
                    *(u32x4*)(dr + (size_t)row * 256 + head * 32 + 8 * fq) = w;
                    asm volatile("" ::: "memory");
                }
            return;
        }
        {
            bf16_t* dst = (bf16_t*)(ws + WS_VM);
#pragma unroll
            for (int ai = 0; ai < 2; ++ai)
#pragma unroll
                for (int m = 0; m < 4; ++m) {
                    const int row = row0 + 128 * ai + 16 * m;
                    const float rc = __builtin_amdgcn_rsqf(ssqc[row] * (1.f / KVRANK) + EPS);
                    bf16_t* o = dst + (size_t)row * 512 + head * 64;
#pragma unroll
                    for (int bj = 0; bj < 2; ++bj) st8(o + 32 * bj, pk4(acc[ai][bj][m][0] * rc), pk4(acc[ai][bj][m][1] * rc), fq);
                    asm volatile("" ::: "memory");
                }
        }
    }
};

constexpr int SC_PITCH = 4104, IDX_SC_BYTES = 16 * SC_PITCH * 2, IDX_MW_OFF = IDX_SC_BYTES;
static_assert(IDX_MW_OFF % 16 == 0 && IDX_MW_OFF + 16 * 64 * 8 <= LDS_BYTES, "indexer LDS");
__device__ __forceinline__ int suffix_sum64(int v, int lane) {
#pragma unroll
    for (int o = 1; o < 64; o <<= 1) { const int t = __shfl_down(v, o); v += (lane + o < 64) ? t : 0; }
    return v;
}
__device__ __forceinline__ void radix_level(LAS unsigned* hist, int lane, int want, int& bsel, int& cabove) {
    u32x4 c = *(const LAS u32x4*)(hist + 4 * lane);
#pragma unroll
    for (int k = 1; k < 4; ++k) c += *(const LAS u32x4*)(hist + 256 * k + 4 * lane);
#pragma unroll
    for (int k = 0; k < 4; ++k) *(LAS u32x4*)(hist + 256 * k + 4 * lane) = (u32x4){0u, 0u, 0u, 0u};
    const int s = (int)(c.x + c.y + c.z + c.w), S = suffix_sum64(s, lane);
    int above = S - s, b = -1, ca = 0;
    if (above < want && S >= want) {
        if (above + (int)c.w >= want) { b = 4 * lane + 3; ca = above; }
        else if (above + (int)(c.w + c.z) >= want) { b = 4 * lane + 2; ca = above + (int)c.w; }
        else if (above + (int)(c.w + c.z + c.y) >= want) { b = 4 * lane + 1; ca = above + (int)(c.w + c.z); }
        else { b = 4 * lane; ca = above + (int)(c.w + c.z + c.y); }
    }
    const unsigned long long m = __builtin_amdgcn_ballot_w64(b >= 0);
    const int src = (int)__builtin_ctzll(m | (1ull << 63));
    bsel = __builtin_amdgcn_readlane(b, src); cabove = __builtin_amdgcn_readlane(ca, src);
}
__device__ __forceinline__ void indexer_phase(Frame& F) {
    const bf16_t* QI = (const bf16_t*)(F.ws + WS_QI); const bf16_t* KI = (const bf16_t*)(F.ws + WS_KI); const float* WI = (const float*)(F.ws + WS_WI);
    unsigned long long* MASK = (unsigned long long*)(F.ws + WS_MASK);
    LAS unsigned short* SC = (LAS unsigned short*)F.lds;
    LAS unsigned long long* MW = (LAS unsigned long long*)(F.lds + IDX_MW_OFF);
    const int lane = F.lane, wid = F.wave;
    for (int item = F.bid; item < NB * 256; item += F.G) {
        int lq = lane; asm volatile("" : "+v"(lq)); const int q = lq & 15, kq = lq >> 4;
        const int b = item >> 8, gi = item & 255, g = (b & 1) ? 255 - gi : gi, t0 = 16 * g, nkt = g + 1;
        const size_t rowq = (size_t)b * SEQ + t0 + q;
        bf16x8 bq[8][2]; float wv[8];
#pragma unroll
        for (int h = 0; h < 8; ++h) {
#pragma unroll
            for (int ks = 0; ks < 2; ++ks) bq[h][ks] = *(const bf16x8*)(QI + rowq * 512 + h * 64 + 32 * ks + 8 * kq);
            wv[h] = WI[rowq * 8 + h];
        }
        const bf16_t* kbase = KI + ((size_t)b * SEQ + q) * 64 + 8 * kq;
        const int ntw = (nkt - wid + NWAVES - 1) / NWAVES;
        bf16x8 ka[4][2], kn[4][2];
#define IDX_KLOAD(u, jj) do { int kt_ = wid + NWAVES * (jj); kt_ = kt_ < nkt ? kt_ : nkt - 1; const bf16_t* kp = kbase + (size_t)16 * kt_ * 64; kn[u][0] = *(const bf16x8*)kp; kn[u][1] = *(const bf16x8*)(kp + 32); } while (0)
#define IDX_TILE(u, jj) do { const int kt = wid + NWAVES * (jj); \
                f32x4 sc = (f32x4){0.f, 0.f, 0.f, 0.f}; \
                _Pragma("unroll") for (int h = 0; h < 8; ++h) { \
                    f32x4 c = __builtin_amdgcn_mfma_f32_16x16x32_bf16(ka[u][0], bq[h][0], (f32x4){0.f, 0.f, 0.f, 0.f}, 0, 0, 0); \
                    c = __builtin_amdgcn_mfma_f32_16x16x32_bf16(ka[u][1], bq[h][1], c, 0, 0, 0); \
                    _Pragma("unroll") for (int i = 0; i < 4; ++i) sc[i] += __builtin_amdgcn_fmed3f(c[i], 0.f, 3.0e38f) * wv[h]; } \
                unsigned short kk[4]; \
                _Pragma("unroll") for (int i = 0; i < 4; ++i) { const _Float16 hsc = (_Float16)(sc[i] + 0.0f); const unsigned short bits = __builtin_bit_cast(unsigned short, hsc); \
                    kk[i] = (bits & 0x8000u) ? (unsigned short)~bits : (unsigned short)(bits | 0x8000u); } \
                u32x2 w; w.x = (unsigned)kk[0] | ((unsigned)kk[1] << 16); w.y = (unsigned)kk[2] | ((unsigned)kk[3] << 16); \
                *(LAS u32x2*)(SC + q * SC_PITCH + 16 * kt + 4 * kq) = w; } while (0)
#pragma unroll
        for (int u = 0; u < 4; ++u) IDX_KLOAD(u, u);
        for (int j0 = 0; j0 < ntw; j0 += 4) {
#pragma unroll
            for (int u = 0; u < 4; ++u) { ka[u][0] = kn[u][0]; ka[u][1] = kn[u][1]; }
#pragma unroll
            for (int u = 0; u < 4; ++u) IDX_KLOAD(u, j0 + 4 + u);
            if (j0 + 4 <= ntw) { IDX_TILE(0, j0); IDX_TILE(1, j0 + 1); IDX_TILE(2, j0 + 2); IDX_TILE(3, j0 + 3); }
            else { IDX_TILE(0, j0); if (j0 + 1 < ntw) IDX_TILE(1, j0 + 1); if (j0 + 2 < ntw) IDX_TILE(2, j0 + 2); }
        }
#undef IDX_KLOAD
#undef IDX_TILE
        __syncthreads();
#pragma unroll 1
        for (int qi = 0; qi < 2; ++qi) {
            const int qq = 2 * wid + qi, t = t0 + qq, nr = (t >> 6) + 1;
            unsigned key[64];
#pragma unroll
            for (int r = 0; r < 64; ++r) { const int s = 64 * r + lane; key[r] = (r < nr && s <= t) ? (unsigned)SC[qq * SC_PITCH + s] : 0u; }
            unsigned thr = 0u; int need = 0;
            LAS unsigned* hist = (LAS unsigned*)(SC + qq * SC_PITCH);
            if (t + 1 > NSEL) {
                LDS_WAIT();
#pragma unroll
                for (int k = 0; k < 4; ++k) *(LAS u32x4*)(hist + 256 * k + 4 * lane) = (u32x4){0u, 0u, 0u, 0u};
                LAS unsigned* hmine = hist + 256 * (lane & 3);
#pragma unroll
                for (int r8 = 0; r8 < 8; ++r8) if (8 * r8 < nr) {
#pragma unroll
                    for (int r = 8 * r8; r < 8 * r8 + 8; ++r) if (key[r] != 0u) __hip_atomic_fetch_add(hmine + (key[r] >> 8), 1u, __ATOMIC_RELAXED, __HIP_MEMORY_SCOPE_WORKGROUP);
                }
                LDS_WAIT();
                int bh, ca_h; radix_level(hist, lane, NSEL, bh, ca_h);
                LDS_WAIT();
#pragma unroll
                for (int r8 = 0; r8 < 8; ++r8) if (8 * r8 < nr) {
#pragma unroll
                    for (int r = 8 * r8; r < 8 * r8 + 8; ++r) if ((int)(key[r] >> 8) == bh) __hip_atomic_fetch_add(hmine + (key[r] & 255u), 1u, __ATOMIC_RELAXED, __HIP_MEMORY_SCOPE_WORKGROUP);
                }
                LDS_WAIT();
                int bl, ca_l; radix_level(hist, lane, NSEL - ca_h, bl, ca_l);
                LDS_WAIT();
                thr = ((unsigned)bh << 8) | (unsigned)bl; need = NSEL - ca_h - ca_l;
            }
            unsigned wlo = 0u, whi = 0u;
#pragma unroll
            for (int r = 0; r < 64; ++r) {
                unsigned long long word = 0ull;
                if (r < nr) {
                    if (t + 1 > NSEL) {
                        const unsigned long long mg = __builtin_amdgcn_ballot_w64(key[r] > thr);
                        unsigned long long me = __builtin_amdgcn_ballot_w64(key[r] == thr);
                        if (me) { const int c = __builtin_popcountll(me);
                            if (c > need) { int drop = c - need; while (drop > 0) { me &= ~(1ull << (63 - __builtin_clzll(me))); --drop; } need = 0; } else need -= c; }
                        word = mg | me;
                    } else word = __builtin_amdgcn_ballot_w64(key[r] != 0u);
                }
                { const unsigned w0_ = (unsigned)word, w1_ = (unsigned)(word >> 32); asm volatile("s_nop 0\n\tv_writelane_b32 %0, %2, %4\n\tv_writelane_b32 %1, %3, %4" : "+v"(wlo), "+v"(whi) : "s"(w0_), "s"(w1_), "n"(r)); }
            }
            MW[qq * 64 + lane] = ((unsigned long long)whi << 32) | wlo;
        }
        __syncthreads();
        for (int i = F.tid; i < 1024; i += NTHREADS) { const int w = i >> 4, qq = i & 15; MASK[((size_t)b * 64 + w) * SEQ + t0 + qq] = MW[qq * 64 + w]; }
        __syncthreads();
    }
}

namespace att {
constexpr int KV = 64, QB = 256;
constexpr int KSLOT = 12288, VSLOT = 8192;
constexpr int NSLOT = 4;
constexpr int L_K = 0, L_V = NSLOT * KSLOT, L_WS = L_V + NSLOT * VSLOT, L_OST = L_WS + NWAVES * 64 * 4, L_BYTES = L_OST + NWAVES * 4096;
static_assert(L_BYTES <= LDS_BYTES, "attention LDS");
__device__ __forceinline__ int crow(int r, int hi) { return (r & 3) + 8 * (r >> 2) + 4 * hi; }
__device__ __forceinline__ float max3f(float a, float b, float c) { float r; asm("v_max3_f32 %0, %1, %2, %3" : "=v"(r) : "v"(a), "v"(b), "v"(c)); return r; }
__device__ __forceinline__ void glds(const void* g, LAS unsigned char* l) { __builtin_amdgcn_global_load_lds((const unsigned*)g, (LAS unsigned*)l, 16, 0, 0); }

template <int MODE>
__device__ __forceinline__ void attn_unit(Frame& F, int b, int h, int qb) {
    constexpr int NCH = MODE ? 12 : 8, ND = NCH / 2;
    const int lane = F.lane, wid = F.wave, r32 = lane & 31, hi = lane >> 5;
    unsigned char* ws = F.ws; LAS unsigned char* lds = F.lds;
    const size_t rowbase = (size_t)b * SEQ; const int q0 = qb * QB;
    const bf16_t* Kn = (const bf16_t*)(ws + (MODE ? WS_KMN : WS_KA)) + rowbase * 512 + h * 64;
    const bf16_t* Kr = (const bf16_t*)(ws + WS_KMR) + rowbase * 256 + h * 32;
    const bf16_t* Vh = (const bf16_t*)(ws + (MODE ? WS_VM : WS_VA)) + rowbase * 512 + h * 64;
    bf16_t* Qn = (bf16_t*)(ws + (MODE ? WS_QMN : WS_QA)) + (rowbase + q0 + wid * 32) * 512 + h * 64;
    const bf16_t* Qr = (const bf16_t*)(ws + WS_QMR) + (rowbase + q0 + wid * 32) * 256 + h * 32;
    LAS float* wsf = (LAS float*)(lds + L_WS) + wid * 64;
    const int NT = (q0 + QB) / KV;
    const bf16_t* ksrc0 = Kn + (size_t)lane * 512 + wid * 8;
    const bf16_t* ksrc1 = Kr + (size_t)lane * 256 + (wid & 3) * 8;
    const bf16_t* vsrc = Vh + (size_t)(16 * (wid & 3) + (lane >> 2)) * 512 + (wid >> 2) * 32 + (lane & 3) * 8;
#define ATT_DMA(t, slot) do { glds(ksrc0 + (size_t)(t) * KV * 512, lds + L_K + (slot) * KSLOT + wid * 1024); \
        if (MODE) glds(ksrc1 + (size_t)(t) * KV * 256, lds + L_K + (slot) * KSLOT + (8 + (wid & 3)) * 1024); \
        glds(vsrc + (size_t)(t) * KV * 512, lds + L_V + (slot) * VSLOT + wid * 1024); } while (0)
    ATT_DMA(0, 0); ATT_DMA(1, 1); ATT_DMA(2, 2);
    bf16x8 qr[ND];
#pragma unroll
    for (int d0 = 0; d0 < 4; ++d0) qr[d0] = *(const bf16x8*)(Qn + (size_t)r32 * 512 + d0 * 16 + hi * 8);
    if (MODE) {
#pragma unroll
        for (int d0 = 4; d0 < ND; ++d0) qr[d0] = *(const bf16x8*)(Qr + (size_t)r32 * 256 + (d0 - 4) * 16 + hi * 8);
        const float rq = __builtin_amdgcn_rsqf(((const float*)(ws + WS_SSQ_QM))[(rowbase + q0 + wid * 32 + r32) * 8 + h] * (1.f / MQK) + EPS);
#pragma unroll
        for (int d0 = 0; d0 < ND; ++d0) {
            u32x4 w = __builtin_bit_cast(u32x4, qr[d0]);
#pragma unroll
            for (int j = 0; j < 4; ++j) w[j] = cvtpk_s(bflo(w[j]) * rq, bfhi(w[j]) * rq);
            qr[d0] = __builtin_bit_cast(bf16x8, w);
        }
    }
    const unsigned long long* mrow = (const unsigned long long*)(ws + WS_MASK) + (size_t)b * 64 * SEQ + q0 + wid * 32 + r32;
    float mref = 0.f; f32x16 o[2]; o[0] = f32x16{}; o[1] = f32x16{};
    float lrun = 0.f;
    f32x16 negm = f32x16{};
    const int qrel = wid * 32 + r32;
    const unsigned vb0 = (unsigned)(uintptr_t)(lds + L_V) + ((lane >> 4) & 1) * 32 + (lane & 3) * 8 + (4 * hi + ((lane & 15) >> 2)) * 64;
    unsigned long long mw = 0ull, mwn = 0ull;
    if (MODE == 0) mwn = mrow[0];
#define ATT_QK(P0, P1, SL) do { const LAS unsigned char* kb = lds + L_K + (SL) * KSLOT + hi * 1024 + r32 * 16; \
        _Pragma("unroll") for (int d0 = 0; d0 < ND; ++d0) { \
            const bf16x8 k0 = *(const LAS bf16x8*)(kb + d0 * 2048), k1 = *(const LAS bf16x8*)(kb + d0 * 2048 + 512); \
            if (d0 == 0) { P0 = __builtin_amdgcn_mfma_f32_32x32x16_bf16(k0, qr[0], negm, 0, 0, 0); P1 = __builtin_amdgcn_mfma_f32_32x32x16_bf16(k1, qr[0], negm, 0, 0, 0); } \
            else { P0 = __builtin_amdgcn_mfma_f32_32x32x16_bf16(k0, qr[d0], P0, 0, 0, 0); P1 = __builtin_amdgcn_mfma_f32_32x32x16_bf16(k1, qr[d0], P1, 0, 0, 0); } } } while (0)
    if (MODE) asm volatile("s_waitcnt vmcnt(3)" ::: "memory"); else asm volatile("s_waitcnt vmcnt(2)" ::: "memory");
    __builtin_amdgcn_s_barrier(); asm volatile("" ::: "memory");
    f32x16 pn0, pn1;
    ATT_QK(pn0, pn1, 0);
    asm volatile("s_nop 15\n\ts_nop 7" : "+v"(pn0), "+v"(pn1));
    int slot = 0, slot1 = 1, slot3 = 3;
    for (int t = 0; t < NT; ++t) {
        if (t + 2 < NT) { if (MODE) asm volatile("s_waitcnt vmcnt(3)" ::: "memory"); else asm volatile("s_waitcnt vmcnt(2)" ::: "memory"); }
        else asm volatile("s_waitcnt vmcnt(0)" ::: "memory");
        __builtin_amdgcn_s_barrier(); asm volatile("" ::: "memory");
        mw = mwn;
        if (MODE == 0 && t + 1 < NT) mwn = mrow[(size_t)(t + 1) * SEQ];
        if (t + 3 < NT) ATT_DMA(t + 3, slot3);
        f32x16 p0 = pn0, p1 = pn1;
        if (MODE == 1) {
            const int jb = t - (NT - 4);
            if (jb >= 0) { const int kb = 64 * jb + 4 * hi;
#pragma unroll
                for (int r = 0; r < 16; ++r) { const int kv = kb + (r & 3) + 8 * (r >> 2); if (kv > qrel) p0[r] = -INFINITY; if (kv + 32 > qrel) p1[r] = -INFINITY; } }
        }
        float rm = max3f(p0[0], p1[0], p0[1]), rm2 = max3f(p1[1], p0[2], p1[2]);
#pragma unroll
        for (int r = 3; r < 15; r += 2) { rm = max3f(rm, p0[r], p1[r]); rm2 = max3f(rm2, p0[r + 1], p1[r + 1]); }
        rm = max3f(rm, rm2, p0[15]); rm = __builtin_fmaxf(rm, p1[15]);
        { auto rr = __builtin_amdgcn_permlane32_swap(__float_as_uint(rm), __float_as_uint(rm), false, false); rm = __builtin_fmaxf(__uint_as_float(rr[0]), __uint_as_float(rr[1])); }
        const bool resc = __any(rm > 0.f) || t == 0;
        const float dl = !resc ? 0.f : (t == 0) ? rm : __builtin_fmaxf(rm, 0.f);
        mref += dl;
#pragma unroll
        for (int r = 0; r < 16; ++r) { p0[r] -= dl; p1[r] -= dl; negm[r] -= dl; }
        if (resc) {
            const float f = __builtin_amdgcn_exp2f(-dl);
            if (hi == 0) wsf[r32] = f;
            LDS_WAIT();
#pragma unroll
            for (int r = 0; r < 16; ++r) { const float fr = wsf[crow(r, hi)]; o[0][r] *= fr; o[1][r] *= fr; }
            lrun *= f;
        }
        ATT_QK(pn0, pn1, slot1);
#pragma unroll
        for (int r = 0; r < 16; ++r) { p0[r] = __builtin_amdgcn_exp2f(p0[r]); p1[r] = __builtin_amdgcn_exp2f(p1[r]); }
        if (MODE == 0) {
            const unsigned lo = (unsigned)mw >> (4 * hi), hw = (unsigned)(mw >> 32) >> (4 * hi);
#pragma unroll
            for (int r = 0; r < 16; ++r) { const int c = (r & 3) + 8 * (r >> 2);
                unsigned m0_, m1_;
                asm("v_bfe_i32 %0, %1, %2, 1" : "=v"(m0_) : "v"(lo), "n"(c)); asm("v_bfe_i32 %0, %1, %2, 1" : "=v"(m1_) : "v"(hw), "n"(c));
                p0[r] = __uint_as_float(__float_as_uint(p0[r]) & m0_);
                p1[r] = __uint_as_float(__float_as_uint(p1[r]) & m1_); }
        }
        { float sacc = 0.f;
#pragma unroll
          for (int r = 0; r < 16; ++r) sacc += p0[r] + p1[r];
          lrun += sacc; }
        u32x4 pw0, pw1, pw2, pw3;
#pragma unroll
        for (int j = 0; j < 4; ++j) { pw0[j] = cvtpk_s(p0[2 * j], p0[2 * j + 1]); pw1[j] = cvtpk_s(p0[8 + 2 * j], p0[9 + 2 * j]); pw2[j] = cvtpk_s(p1[2 * j], p1[2 * j + 1]); pw3[j] = cvtpk_s(p1[8 + 2 * j], p1[9 + 2 * j]); }
        { const unsigned vb = vb0 + slot * VSLOT;
#pragma unroll
          for (int d0 = 0; d0 < 2; ++d0) { s16x4 lo[4], hh[4];
#pragma unroll
              for (int ks = 0; ks < 4; ++ks) {
                  asm volatile("ds_read_b64_tr_b16 %0,%1 offset:%c2" : "=&v"(lo[ks]) : "v"(vb), "i"(d0 * 4096 + ks * 1024) : "memory");
                  asm volatile("ds_read_b64_tr_b16 %0,%1 offset:%c2" : "=&v"(hh[ks]) : "v"(vb), "i"(d0 * 4096 + ks * 1024 + 512) : "memory"); }
              asm volatile("s_waitcnt lgkmcnt(0)" ::: "memory"); __builtin_amdgcn_sched_barrier(0);
#define ATT_PK(k) (bf16x8){lo[k][0], lo[k][1], lo[k][2], lo[k][3], hh[k][0], hh[k][1], hh[k][2], hh[k][3]}
              o[d0] = __builtin_amdgcn_mfma_f32_32x32x16_bf16(__builtin_bit_cast(bf16x8, pw0), ATT_PK(0), o[d0], 0, 0, 0);
              o[d0] = __builtin_amdgcn_mfma_f32_32x32x16_bf16(__builtin_bit_cast(bf16x8, pw1), ATT_PK(1), o[d0], 0, 0, 0);
              o[d0] = __builtin_amdgcn_mfma_f32_32x32x16_bf16(__builtin_bit_cast(bf16x8, pw2), ATT_PK(2), o[d0], 0, 0, 0);
              o[d0] = __builtin_amdgcn_mfma_f32_32x32x16_bf16(__builtin_bit_cast(bf16x8, pw3), ATT_PK(3), o[d0], 0, 0, 0);
#undef ATT_PK
          } }
        LDS_WAIT();
        slot = slot1; slot1 = (slot1 == NSLOT - 1) ? 0 : slot1 + 1; slot3 = (slot3 == NSLOT - 1) ? 0 : slot3 + 1;
    }
#undef ATT_QK
    __builtin_amdgcn_s_barrier(); asm volatile("" ::: "memory");
#undef ATT_DMA
    { auto rr = __builtin_amdgcn_permlane32_swap(__float_as_uint(lrun), __float_as_uint(lrun), false, false); lrun = __uint_as_float(rr[0]) + __uint_as_float(rr[1]); }
    if (hi == 0) wsf[32 + r32] = lrun;
    LDS_WAIT();
    float rli[16];
#pragma unroll
    for (int r = 0; r < 16; ++r) rli[r] = __builtin_amdgcn_rcpf(wsf[32 + crow(r, hi)]);
    LAS bf16_t* stg = (LAS bf16_t*)(lds + L_OST) + wid * 2048;
#pragma unroll
    for (int r = 0; r < 16; ++r) { const int orow = crow(r, hi);
#pragma unroll
        for (int d0 = 0; d0 < 2; ++d0) stg[orow * 64 + d0 * 32 + r32] = (bf16_t)(cvtpk_s(o[d0][r] * rli[r], 0.f) & 0xffffu); }
    LDS_WAIT();
#pragma unroll
    for (int i = 0; i < 4; ++i) { const int row = i * 8 + (lane >> 3), ch = lane & 7; const u32x4 v = *(const LAS u32x4*)(stg + row * 64 + ch * 8); *(u32x4*)(Qn + (size_t)row * 512 + ch * 8) = v; }
    LDS_WAIT(); __builtin_amdgcn_s_barrier(); asm volatile("" ::: "memory");
}

__device__ __forceinline__ void attn_phase(Frame& F) {
    const int vcu = (F.G % 8 == 0) ? (F.bid % 8) * (F.G / 8) + F.bid / 8 : F.bid;
    for (int v = vcu; v < 256; v += F.G) {
        const int bh = v >> 2, s = v & 3;
#pragma unroll 1
        for (int i = 0; i < 4; ++i) { const int qb = (i == 0) ? s : (i == 1) ? 7 - s : (i == 2) ? 8 + s : 15 - s; attn_unit<0>(F, bh >> 3, bh & 7, qb); }
#pragma unroll 1
        for (int i = 0; i < 4; ++i) { const int qb = (i == 0) ? s : (i == 1) ? 7 - s : (i == 2) ? 8 + s : 15 - s; attn_unit<1>(F, bh >> 3, bh & 7, qb); }
    }
}
}

struct EpiMerge {
    unsigned char* ws;
    __device__ __forceinline__ void mid(f32x4 (&acc)[2][2][4][2], const pg8::Unit& u, int wr, int wc, int fr, int fq) const {
        const int row0 = u.pm * 256 + wr * 64 + fr, cb = u.pn * 256 + 32 * wc + 4 * fq;
        const bf16_t* ga = (const bf16_t*)(ws + WS_GA); const bf16_t* gm = (const bf16_t*)(ws + WS_GM);
#pragma unroll
        for (int ai = 0; ai < 2; ++ai)
#pragma unroll
            for (int m = 0; m < 4; ++m) { const size_t off = (size_t)(row0 + 128 * ai + 16 * m) * DM + cb;
#pragma unroll
                for (int bj = 0; bj < 2; ++bj) { u32x2 av[2], gv[2]; ld8(ga + (off - 4 * fq) + 128 * bj, av[0], av[1], fq); ld8(gm + (off - 4 * fq) + 128 * bj, gv[0], gv[1], fq);
#pragma unroll
                    for (int n = 0; n < 2; ++n) { const u32x2 a = av[n], g = gv[n];
                        const f32x4 den = (f32x4){fmaxf(bflo(g.x), 1e-30f), fmaxf(bfhi(g.x), 1e-30f), fmaxf(bflo(g.y), 1e-30f), fmaxf(bfhi(g.y), 1e-30f)};
                        acc[ai][bj][m][n] = acc[ai][bj][m][n] * ((f32x4){bflo(a.x), bfhi(a.x), bflo(a.y), bfhi(a.y)} * (f32x4){__builtin_amdgcn_rcpf(den.x), __builtin_amdgcn_rcpf(den.y), __builtin_amdgcn_rcpf(den.z), __builtin_amdgcn_rcpf(den.w)});
                    } } asm volatile("" ::: "memory"); }
    }
    __device__ __forceinline__ void operator()(const f32x4 (&acc)[2][2][4][2], const pg8::Unit& u, int wr, int wc, int fr, int fq) const {
        const int row0 = u.pm * 256 + wr * 64 + fr, cb = u.pn * 256 + 32 * wc + 4 * fq;
        const bf16_t* gm = (const bf16_t*)(ws + WS_GM); bf16_t* mix = (bf16_t*)(ws + WS_MIXED);
#pragma unroll
        for (int ai = 0; ai < 2; ++ai)
#pragma unroll
            for (int m = 0; m < 4; ++m) { const size_t off = (size_t)(row0 + 128 * ai + 16 * m) * DM + cb;
#pragma unroll
                for (int bj = 0; bj < 2; ++bj) { u32x2 pk[2], gv[2]; ld8(gm + (off - 4 * fq) + 128 * bj, gv[0], gv[1], fq);
#pragma unroll
                    for (int n = 0; n < 2; ++n) {
                        const u32x2 g = gv[n];
                        pk[n] = pk4(acc[ai][bj][m][n] * (f32x4){fmaxf(bflo(g.x), 1e-30f), fmaxf(bfhi(g.x), 1e-30f), fmaxf(bflo(g.y), 1e-30f), fmaxf(bfhi(g.y), 1e-30f)});
                    }
                    st8(mix + (off - 4 * fq) + 128 * bj, pk[0], pk[1], fq); } asm volatile("" ::: "memory"); }
    }
};
struct EpiOut {
    unsigned char* ws; const float* x; float* out; const float* g2;
    __device__ __forceinline__ void operator()(const f32x4 (&acc)[2][2][4][2], const pg8::Unit& u, int wr, int wc, int fr, int fq) const {
        const int row0 = u.pm * 256 + wr * 64 + fr, cb = u.pn * 256 + 32 * wc + 4 * fq, b = (u.pm * 256) / SEQ;
        const float* mod = (const float*)(ws + WS_MOD) + (size_t)b * 6144; bf16_t* x1g = (bf16_t*)(ws + WS_X1G); float* ssq = (float*)(ws + WS_SSQ_X1);
        f32x4 gt[2][2], gm[2][2];
#pragma unroll
        for (int bj = 0; bj < 2; ++bj)
#pragma unroll
            for (int n = 0; n < 2; ++n) { const int c = cb + 128 * bj + 16 * n; gt[bj][n] = *(const f32x4*)(mod + 2048 + c); gm[bj][n] = *(const f32x4*)(g2 + c) * (*(const f32x4*)(mod + 4096 + c) + 1.0f); }
#pragma unroll
        for (int ai = 0; ai < 2; ++ai)
#pragma unroll
            for (int m = 0; m < 4; ++m) { const int row = row0 + 128 * ai + 16 * m; const size_t off = (size_t)row * DM + cb; float s = 0.f;
#pragma unroll
                for (int bj = 0; bj < 2; ++bj) { u32x2 pk[2];
#pragma unroll
                    for (int n = 0; n < 2; ++n) {
                        const f32x4 x1 = *(const f32x4*)(x + off + 128 * bj + 16 * n) + gt[bj][n] * acc[ai][bj][m][n];
                        s += sum4sq(x1);
                        pk[n] = pk4(x1 * gm[bj][n]);
                    }
                    st8(x1g + (off - 4 * fq) + 128 * bj, pk[0], pk[1], fq); }
                s = fq_sum(s);
                if (fq == 0) atomicAdd(ssq + row, s); asm volatile("" ::: "memory"); }
    }
};
struct EpiPQ {
    unsigned char* ws;
    __device__ __forceinline__ void operator()(const f32x4 (&acc)[2][2][4][2], const pg8::Unit& u, int wr, int wc, int fr, int fq) const {
        const int row0 = u.pm * 256 + wr * 64 + fr, cb = u.pn * 256 + 32 * wc + 4 * fq, b = (u.pm * 256) / SEQ;
        const float* bias = (const float*)(ws + WS_BIASQ) + (size_t)b * 2048; const float* ssq = (const float*)(ws + WS_SSQ_X1); bf16_t* pq = (bf16_t*)(ws + WS_PQ);
        f32x4 bv[2][2];
#pragma unroll
        for (int bj = 0; bj < 2; ++bj)
#pragma unroll
            for (int n = 0; n < 2; ++n) bv[bj][n] = *(const f32x4*)(bias + cb + 128 * bj + 16 * n);
#pragma unroll
        for (int ai = 0; ai < 2; ++ai)
#pragma unroll
            for (int m = 0; m < 4; ++m) { const int row = row0 + 128 * ai + 16 * m; const float rinv = __builtin_amdgcn_rsqf(ssq[row] * (1.f / DM) + EPS);
#pragma unroll
                for (int bj = 0; bj < 2; ++bj) {
                    const u32x2 X = pk4(acc[ai][bj][m][0] * rinv + bv[bj][0]), Y = pk4(acc[ai][bj][m][1] * rinv + bv[bj][1]);
                    auto r0 = __builtin_amdgcn_permlane16_swap(X.x, Y.x, false, false); auto r1 = __builtin_amdgcn_permlane16_swap(X.y, Y.y, false, false);
                    const int col = (cb - 4 * fq) + 128 * bj + 8 * (fq >> 1) + 16 * (fq & 1);
                    const size_t fo = ((((size_t)(row >> 5) * 8 + (col >> 8)) * 2 + ((col >> 7) & 1)) * 8 + ((col >> 4) & 7)) * 64 + ((col >> 3) & 1) * 32 + (row & 31);
                    *(u32x4*)(pq + fo * 8) = (u32x4){r0[0], r1[0], r0[1], r1[1]}; }
                asm volatile("" ::: "memory"); }
    }
};

#define XB_TMO      128
#define XB_XCNT(j)  (256  + 64 * (j))
#define XB_XSUB(j)  (1280 + 64 * (j))
#define XB_XGEN(j)  (2304 + 64 * (j))
#define XB_TOP      3328
#define XB_TOPGEN   3392
#define XB_SPIN_CAP (1u << 22)
__device__ __forceinline__ unsigned xb_ld(unsigned* p)              { return __hip_atomic_load(p, __ATOMIC_RELAXED, __HIP_MEMORY_SCOPE_AGENT); }
__device__ __forceinline__ unsigned xb_add(unsigned* p, unsigned v) { return __hip_atomic_fetch_add(p, v, __ATOMIC_RELAXED, __HIP_MEMORY_SCOPE_AGENT); }
__device__ __forceinline__ unsigned xb_xcc_id() { return (unsigned)__builtin_amdgcn_s_getreg((3 << 11) | 20) & 0xFu; }
#define XB_SPIN(cond, bar) do { unsigned _sp = 0; while (cond) { __builtin_amdgcn_s_sleep(1); \
    if ((++_sp & 255u) == 0u) { if (xb_ld(&(bar)[XB_TMO])) break; if (_sp > XB_SPIN_CAP) { atomicAdd(&(bar)[XB_TMO], 1u); break; } } } } while (0)
struct XcdBarrier { unsigned* bar; unsigned x; volatile LAS unsigned* st; };
__device__ __forceinline__ XcdBarrier xcd_barrier_post(unsigned* bar, volatile LAS unsigned* st) {
    XcdBarrier b; b.bar = bar; b.x = xb_xcc_id(); b.st = st;
    if (threadIdx.x == 0) (void)xb_add(&bar[XB_XCNT(b.x)], 1u);
    return b;
}
__device__ __forceinline__ void xcd_barrier_complete(unsigned* bar, unsigned x, unsigned& nloc, unsigned& nx) {
    const unsigned G = gridDim.x * gridDim.y * gridDim.z;
    unsigned sum, cnt, mine, sp = 0u;
    for (;;) {
        sum = 0u; cnt = 0u; mine = 0u;
#pragma unroll
        for (unsigned j = 0; j < 16; ++j) { const unsigned c = xb_ld(&bar[XB_XCNT(j)]); sum += c; cnt += (c > 0u) ? 1u : 0u; mine = (j == x) ? c : mine; }
        if (sum == G) break;
        __builtin_amdgcn_s_sleep(1);
        if ((++sp & 255u) == 0u) { if (xb_ld(&bar[XB_TMO])) break; if (sp > XB_SPIN_CAP) { atomicAdd(&bar[XB_TMO], 1u); break; } }
    }
    nloc = mine > 0u ? mine : 1u; nx = cnt > 0u ? cnt : 1u;
}
__device__ __forceinline__ void xcd_barrier(const XcdBarrier& b) {
    asm volatile("s_waitcnt vmcnt(0) lgkmcnt(0)" ::: "memory");
    __syncthreads();
    if (threadIdx.x == 0) {
        unsigned* bar = b.bar;
        __builtin_amdgcn_s_waitcnt(0);
        unsigned nloc = b.st[0], nx = b.st[1];
        if (nloc == 0u) { xcd_barrier_complete(bar, b.x, nloc, nx); b.st[0] = nloc; b.st[1] = nx; }
        const unsigned old = xb_add(&bar[XB_XSUB(b.x)], 1u);
        const unsigned gen = old / nloc;
        if (old + 1u == (gen + 1u) * nloc) {
            __builtin_amdgcn_fence(__ATOMIC_RELEASE, "agent");
            asm volatile("s_waitcnt vmcnt(0)" ::: "memory");
            const unsigned og = xb_add(&bar[XB_TOP], 1u);
            const unsigned tg = og / nx;
            if (og + 1u == (tg + 1u) * nx) xb_add(&bar[XB_TOPGEN], 1u);
            else XB_SPIN(xb_ld(&bar[XB_TOPGEN]) == tg, bar);
            __builtin_amdgcn_fence(__ATOMIC_ACQUIRE, "agent");
            xb_add(&bar[XB_XGEN(b.x)], 1u);
            asm volatile("s_waitcnt vmcnt(0)" ::: "memory");
        } else {
            XB_SPIN(xb_ld(&bar[XB_XGEN(b.x)]) == gen, bar);
            __builtin_amdgcn_fence(__ATOMIC_ACQUIRE, "agent");
            asm volatile("s_waitcnt vmcnt(0)" ::: "memory");
        }
    }
    __syncthreads();
}
#define grid_barrier(ctr, target) xcd_barrier(xbar)


namespace peer {
constexpr int TOK = 32;
constexpr int L_EXP = 0, L_GATE = L_EXP + TOK * 128 * 2, L_TOPI = L_GATE + TOK * 128 * 4, L_TOPV = L_TOPI + NWAVES * TOK * 32, L_CNT = L_TOPV + NWAVES * TOK * 32 * 4, L_SU = L_CNT + NWAVES * 64 * 4, L_X1 = L_SU + TOK * 128 * 4, L_BYTES = L_X1 + TOK * DM * 2;
static_assert(L_BYTES <= LDS_BYTES, "peer LDS");
__device__ __forceinline__ unsigned sortable(float v) { const unsigned u = __float_as_uint(v); return (u & 0x80000000u) ? ~u : (u | 0x80000000u); }
__device__ __forceinline__ float unsortable(unsigned k) { return __uint_as_float((k & 0x80000000u) ? (k & 0x7fffffffu) : ~k); }
__device__ __forceinline__ unsigned pair_max(unsigned m) { auto rr = __builtin_amdgcn_permlane32_swap(m, m, false, false); return rr[0] > rr[1] ? rr[0] : rr[1]; }
__device__ __forceinline__ float gelu_tanh(float x) { const float y = 0.7978845608028654f * (x + 0.044715f * x * x * x); const float e = __builtin_amdgcn_exp2f(y * (2.f * LOG2E)); return 0.5f * x * (2.f - 2.f * __builtin_amdgcn_rcpf(e + 1.f)); }

template <int CTRL> __device__ __forceinline__ float dppf(float v) { return __int_as_float(__builtin_amdgcn_update_dpp(0, __float_as_int(v), CTRL, 0xf, 0xf, true)); }
__device__ __forceinline__ float wsum_dpp(float v) {
    v += dppf<0xB1>(v); v += dppf<0x4E>(v); v += dppf<0x141>(v); v += dppf<0x140>(v);
    { auto r = __builtin_amdgcn_permlane16_swap(__float_as_uint(v), __float_as_uint(v), false, false); v = __uint_as_float(r[0]) + __uint_as_float(r[1]); }
    { auto r = __builtin_amdgcn_permlane32_swap(__float_as_uint(v), __float_as_uint(v), false, false); v = __uint_as_float(r[0]) + __uint_as_float(r[1]); }
    return v;
}
__device__ __forceinline__ void route_head(Frame& F, int tok0) {
    int lane = F.lane; asm volatile("" : "+v"(lane));
    const int h = F.wave, r32 = lane & 31, hi = lane >> 5;
    const bf16_t* PQ = (const bf16_t*)(F.ws + WS_PQ) + ((size_t)(tok0 >> 5) * 8 + h) * 8192;
    const bf16_t* SK = (const bf16_t*)(F.ws + WS_SUBK) + (size_t)h * 2 * 128 * 128;
    LAS unsigned char* topi = (LAS unsigned char*)(F.lds + L_TOPI) + h * (TOK * 32) + r32 * 32;
    LAS float* topv = (LAS float*)(F.lds + L_TOPV) + h * (TOK * 32) + r32 * 32;
#pragma unroll 1
    for (int p = 0; p < 2; ++p) {
        f32x16 acc[4]; acc[0] = f32x16{}; acc[1] = f32x16{}; acc[2] = f32x16{}; acc[3] = f32x16{};
#pragma unroll
        for (int ks = 0; ks < 8; ++ks) {
            const bf16x8 bq = *(const bf16x8*)(PQ + ((p * 8 + ks) * 64 + lane) * 8);
#pragma unroll
            for (int kb = 0; kb < 4; ++kb) {
                const bf16x8 ak = *(const bf16x8*)(SK + (((p * 4 + kb) * 8 + ks) * 64 + lane) * 8);
                acc[kb] = __builtin_amdgcn_mfma_f32_32x32x16_bf16(ak, bq, acc[kb], 0, 0, 0);
            }
        }
        unsigned key[64];
#pragma unroll
        for (int kb = 0; kb < 4; ++kb)
#pragma unroll
            for (int r = 0; r < 16; ++r) { const int kidx = 32 * kb + (r & 3) + 8 * (r >> 2) + 4 * hi; key[kb * 16 + r] = ((sortable(acc[kb][r]) >> 1) & ~127u) | (unsigned)(127 - kidx); }
        unsigned prev = 0x80000000u;
#pragma unroll 1
        for (int it = 0; it < 16; ++it) {
            unsigned mv = key[0] - prev;
#pragma unroll
            for (int r = 1; r < 64; ++r) { const unsigned d = key[r] - prev; mv = d > mv ? d : mv; }
            mv = pair_max(mv);
            const unsigned m = prev + mv; prev = m;
            if (hi == 0) { topi[p * 16 + it] = (unsigned char)(127 - (m & 127u)); topv[p * 16 + it] = unsortable((m & ~127u) << 1); }
        }
    }
    LDS_WAIT();
    unsigned cand[25];
    { float av[16], bv[16];
#pragma unroll
      for (int i = 0; i < 16; ++i) { av[i] = topv[i]; bv[i] = topv[16 + i]; }
      int n = 0;
#pragma unroll
      for (int i = 0; i < 16; ++i)
#pragma unroll
          for (int j = 0; j < 16; ++j) if ((i + 1) * (j + 1) <= 16) { const unsigned k = ((sortable(av[i] + bv[j]) >> 1) & ~255u) | (unsigned)(255 - (i * 16 + j)); if ((n & 1) == 0) { cand[n >> 1] = hi ? 0u : k; } else { cand[n >> 1] = hi ? k : cand[n >> 1]; } ++n; } }
    LAS unsigned short* ex_o = (LAS unsigned short*)(F.lds + L_EXP) + r32 * 128 + h * 16;
    LAS float* g_o = (LAS float*)(F.lds + L_GATE) + r32 * 128 + h * 16;
    float den = 0.f, s0 = 0.f; unsigned prevc = 0x80000000u;
#pragma unroll 1
    for (int it = 0; it < 16; ++it) {
        unsigned mv = cand[0] - prevc;
#pragma unroll
        for (int r = 1; r < 25; ++r) { const unsigned d = cand[r] - prevc; mv = d > mv ? d : mv; }
        mv = pair_max(mv);
        const unsigned m = prevc + mv; prevc = m;
        const float sv = unsortable((m & ~255u) << 1); const unsigned pos = 255u - (m & 255u), i = pos >> 4, j = pos & 15u;
        if (it == 0) s0 = sv;
        const float ex = __builtin_amdgcn_exp2f((sv - s0) * LOG2E); den += ex;
        if (hi == 0) { ex_o[it] = (unsigned short)((unsigned)topi[i] * 128u + (unsigned)topi[16 + j]); g_o[it] = ex; }
    }
    const float rden = __builtin_amdgcn_rcpf(den);
    LDS_WAIT();
    if (hi == 0) {
#pragma unroll
        for (int it = 0; it < 16; ++it) g_o[it] *= rden;
    }
}

__device__ __forceinline__ void expert_tokens(Frame& F, int tok0) {
    int lane = F.lane; const int wid = F.wave;
    asm volatile("" : "+v"(lane));
    const unsigned char* PU = F.ws + WS_PU; const unsigned char* PV = F.ws + WS_PV;
    const float* USC = (const float*)(F.ws + WS_USC); const float* VSC = (const float*)(F.ws + WS_VSC);
    const float* ssq = (const float*)(F.ws + WS_SSQ_X1); const bf16_t* X1G = (const bf16_t*)(F.ws + WS_X1G);
    LAS unsigned* cnt = (LAS unsigned*)(F.lds + L_CNT) + wid * 64;
    LAS float* gf = (LAS float*)(F.lds + L_TOPV) + 4 * wid;
#pragma unroll 1
    for (int tt = 0; tt < 4; ++tt) {
        const int tl = 4 * wid + tt;
        LAS unsigned short* ex_l = (LAS unsigned short*)(F.lds + L_EXP) + tl * 128; LAS float* g_l = (LAS float*)(F.lds + L_GATE) + tl * 128; LAS float* su_l = (LAS float*)(F.lds + L_SU) + tl * 128;
        cnt[lane] = 0u;
        const unsigned e0 = ex_l[lane], e1 = ex_l[lane + 64]; float g0 = g_l[lane] * VSC[e0], g1 = g_l[lane + 64] * VSC[e1]; const float s0 = USC[e0], s1 = USC[e1];
        { float gm = fmaxf(fmaxf(g0, g1), 1e-30f);
#pragma unroll
          for (int o = 32; o >= 1; o >>= 1) gm = fmaxf(gm, __shfl_xor(gm, o));
          const unsigned E = (__float_as_uint(gm) >> 23) & 255u; const float up = __uint_as_float((257u - E) << 23);
          g0 *= up; g1 *= up; if (lane == 0) gf[tt] = __uint_as_float((E - 3u) << 23); }
        const unsigned b0 = e0 >> 8, b1 = e1 >> 8;
        LDS_WAIT(); asm volatile("" ::: "memory");
        const unsigned r0 = __hip_atomic_fetch_add(cnt + b0, 1u, __ATOMIC_RELAXED, __HIP_MEMORY_SCOPE_WORKGROUP);
        const unsigned r1 = __hip_atomic_fetch_add(cnt + b1, 1u, __ATOMIC_RELAXED, __HIP_MEMORY_SCOPE_WORKGROUP);
        LDS_WAIT(); asm volatile("" ::: "memory");
        const int c = (int)cnt[lane]; int incl = c;
#pragma unroll
        for (int o = 1; o < 64; o <<= 1) { const int tv = __shfl_up(incl, o); incl += (lane >= o) ? tv : 0; }
        const int excl = incl - c;
        const int p0 = __shfl(excl, (int)b0) + (int)r0, p1 = __shfl(excl, (int)b1) + (int)r1;
        ex_l[p0] = (unsigned short)e0; ex_l[p1] = (unsigned short)e1; g_l[p0] = g0; g_l[p1] = g1; su_l[p0] = s0; su_l[p1] = s1;
        LDS_WAIT(); asm volatile("" ::: "memory");
    }
    {
        unsigned hA[4][2], hB[4][2]; float hinv[4]; f32x4 D[4][4];
#pragma unroll
        for (int u = 0; u < 4; ++u) {
            const int t = tok0 + 4 * wid + u, b = t / SEQ;
            const float* mod = (const float*)(F.ws + WS_MOD) + (size_t)b * 6144;
            const float rinv = __builtin_amdgcn_rsqf(ssq[t] * (1.f / DM) + EPS);
            const u32x4 x0 = __builtin_nontemporal_load((const u32x4*)(X1G + (size_t)t * DM + 16 * lane)), x1 = __builtin_nontemporal_load((const u32x4*)(X1G + (size_t)t * DM + 16 * lane + 8));
            float hv[16]; float amax = 1e-30f;
            { LAS u32x4* xs = (LAS u32x4*)(F.lds + L_X1 + (4 * wid + u) * (DM * 2) + 32 * lane); xs[0] = x0; xs[1] = x1; }
#pragma unroll
            for (int j = 0; j < 4; ++j) { const f32x4 sh = *(const f32x4*)(mod + 3072 + 16 * lane + 4 * j); const unsigned w0 = (j < 2) ? x0[2 * j] : x1[2 * j - 4], w1 = (j < 2) ? x0[2 * j + 1] : x1[2 * j - 3];
                hv[4 * j] = bflo(w0) * rinv + sh.x; hv[4 * j + 1] = bfhi(w0) * rinv + sh.y; hv[4 * j + 2] = bflo(w1) * rinv + sh.z; hv[4 * j + 3] = bfhi(w1) * rinv + sh.w; }
#pragma unroll
            for (int i = 0; i < 16; ++i) amax = fmaxf(amax, fabsf(hv[i]));
#pragma unroll
            for (int o = 32; o >= 1; o >>= 1) amax = fmaxf(amax, __shfl_xor(amax, o));
            const float hs = 119.f / amax; hinv[u] = amax * (1.f / 119.f);
            hA[u][0] = hA[u][1] = hB[u][0] = hB[u][1] = 0u;
#pragma unroll
            for (int i = 0; i < 16; ++i) { const int q = (int)__builtin_rintf(hv[i] * hs); const int lo = ((q + 8) & 15) - 8; const int hi = (q - lo) >> 4;
                hA[u][i >> 3] |= ((unsigned)hi & 15u) << (4 * (i & 7)); hB[u][i >> 3] |= ((unsigned)lo & 15u) << (4 * (i & 7)); }
#pragma unroll
            for (int i = 0; i < 4; ++i) D[u][i] = (f32x4){0.f, 0.f, 0.f, 0.f};
            asm volatile("" ::: "memory");
        }
        const LAS unsigned short* ex_w = (const LAS unsigned short*)(F.lds + L_EXP) + (4 * wid) * 128;
        const LAS float* g_w = (const LAS float*)(F.lds + L_GATE) + (4 * wid) * 128;
        const LAS float* su_w = (const LAS float*)(F.lds + L_SU) + (4 * wid) * 128;
        const int kl = ((lane >> 5) & 1) | (((lane >> 4) & 1) << 1);
        const unsigned voff = 8u * (unsigned)lane;
        const int nq = lane & 15, kqa = lane >> 4;
        const int vpos = 4 * (kqa >> 1) + (kqa & 1);
        const int vlo = 32 * nq;
        const unsigned sel0 = 0x0c0c0c0cu & ~(0xffu << (8 * (nq & 3))), sel1 = sel0 | (1u << (8 * (nq & 3)));
        const unsigned m0 = ((nq >> 2) == 0) ? ~0u : 0u, m1 = ((nq >> 2) == 1) ? ~0u : 0u, m2 = ((nq >> 2) == 2) ? ~0u : 0u, m3 = ((nq >> 2) == 3) ? ~0u : 0u;
        const __amdgpu_buffer_rsrc_t rsU = __builtin_amdgcn_make_buffer_rsrc((void*)PU, (short)0, PNEXP * (DM / 2), 0x00020000), rsV = __builtin_amdgcn_make_buffer_rsrc((void*)PV, (short)0, PNEXP * (DM / 2), 0x00020000);
        u32x2 ua[8], ub[8], va[2][4], vb[2][4]; float ga0, ga1, gb0, gb1, sa0, sa1, sb0, sb1;
#define GRP_LOAD(U, V, G0, G1, S0, S1, u, e0) do { _Pragma("unroll") for (int k = 0; k < 8; ++k) { const int eid = __builtin_amdgcn_readfirstlane((int)ex_w[(u) * 128 + (e0) + k]); \
            U[k] = (u32x2)__builtin_amdgcn_raw_buffer_load_b64(rsU, (int)voff, eid * (DM / 2), 0); } \
            _Pragma("unroll") for (int sl = 0; sl < 2; ++sl) { const int vo = (int)ex_w[(u) * 128 + (e0) + vpos + 2 * sl] * (DM / 2) + vlo; \
              _Pragma("unroll") for (int bq = 0; bq < 4; ++bq) V[sl][bq] = (u32x2)__builtin_amdgcn_raw_buffer_load_b64(rsV, vo + 8 * bq, 0, 0); } \
            { S0 = su_w[(u) * 128 + (e0) + kl] * hinv[u]; G0 = g_w[(u) * 128 + (e0) + kl]; S1 = su_w[(u) * 128 + (e0) + 4 + kl] * hinv[u]; G1 = g_w[(u) * 128 + (e0) + 4 + kl]; } } while (0)
#define BATCH_Z(Z, U, k0) do { float dd[4]; _Pragma("unroll") for (int k = 0; k < 4; ++k) { \
            int da0_, db0_;                                                             \
            asm("v_dot8_i32_i4 %0, %1, %2, 0" : "=v"(da0_) : "v"(U[(k0) + k][0]), "v"(hA[u_][0])); asm("v_dot8_i32_i4 %0, %1, %2, 0" : "=v"(db0_) : "v"(U[(k0) + k][0]), "v"(hB[u_][0])); \
            const int da = __builtin_amdgcn_sdot8((int)U[(k0) + k][1], (int)hA[u_][1], da0_, false); \
            const int db = __builtin_amdgcn_sdot8((int)U[(k0) + k][1], (int)hB[u_][1], db0_, false); \
            dd[k] = (float)(16 * da + db); } \
            float z; { auto r0 = __builtin_amdgcn_permlane32_swap(__float_as_uint(dd[0]), __float_as_uint(dd[1]), false, false); const float s01 = __uint_as_float(r0[0]) + __uint_as_float(r0[1]); \
              auto r1 = __builtin_amdgcn_permlane32_swap(__float_as_uint(dd[2]), __float_as_uint(dd[3]), false, false); const float s23 = __uint_as_float(r1[0]) + __uint_as_float(r1[1]); \
              auto r2 = __builtin_amdgcn_permlane16_swap(__float_as_uint(s01), __float_as_uint(s23), false, false); z = __uint_as_float(r2[0]) + __uint_as_float(r2[1]); } \
            z += dppf<0xB1>(z); z += dppf<0x4E>(z); z += dppf<0x141>(z); z += dppf<0x140>(z); Z = z; } while (0)
#define GRP_COMP(U, V, G0, G1, S0, S1, u) do { constexpr int u_ = (u); float z0_, z1_; BATCH_Z(z0_, U, 0); BATCH_Z(z1_, U, 4); \
            const float c0_ = __builtin_amdgcn_fmed3f(G0 * gelu_tanh(z0_ * S0), -448.f, 448.f), c1_ = __builtin_amdgcn_fmed3f(G1 * gelu_tanh(z1_ * S1), -448.f, 448.f); \
            const int hi_ = __builtin_amdgcn_cvt_pk_fp8_f32(c0_, c1_, 0, false); const auto bk_ = __builtin_amdgcn_cvt_pk_f32_fp8(hi_, false); \
            const int lo_ = __builtin_amdgcn_cvt_pk_fp8_f32(c0_ - bk_[0], c1_ - bk_[1], 0, false); \
            const unsigned pa_ = __builtin_amdgcn_perm(0u, (unsigned)hi_, sel0), pb_ = __builtin_amdgcn_perm(0u, (unsigned)hi_, sel1), qa_ = __builtin_amdgcn_perm(0u, (unsigned)lo_, sel0), qb_ = __builtin_amdgcn_perm(0u, (unsigned)lo_, sel1); \
            const i32x8 Bh_ = (i32x8){(int)(pa_ & m0), (int)(pa_ & m1), (int)(pa_ & m2), (int)(pa_ & m3), (int)(pb_ & m0), (int)(pb_ & m1), (int)(pb_ & m2), (int)(pb_ & m3)}; \
            const i32x8 Bl_ = (i32x8){(int)(qa_ & m0), (int)(qa_ & m1), (int)(qa_ & m2), (int)(qa_ & m3), (int)(qb_ & m0), (int)(qb_ & m1), (int)(qb_ & m2), (int)(qb_ & m3)}; \
            _Pragma("unroll") for (int bq = 0; bq < 4; ++bq) { const i32x8 A_ = (i32x8){(int)V[0][bq][0], (int)V[0][bq][1], (int)V[1][bq][0], (int)V[1][bq][1], 0, 0, 0, 0}; \
              D[u_][bq] = __builtin_amdgcn_mfma_scale_f32_16x16x128_f8f6f4(A_, Bh_, D[u_][bq], 4, 0, 0, 127, 0, 127); } \
            } while (0)
        GRP_LOAD(ua, va, ga0, ga1, sa0, sa1, 0, 0);
#pragma unroll 1
        for (int j = 0; j < 16; ++j) {
            const int jn = (j + 1 < 16) ? j + 1 : 15;
            GRP_LOAD(ub, vb, gb0, gb1, sb0, sb1, 1, 8 * j);     GRP_COMP(ua, va, ga0, ga1, sa0, sa1, 0);
            GRP_LOAD(ua, va, ga0, ga1, sa0, sa1, 2, 8 * j);     GRP_COMP(ub, vb, gb0, gb1, sb0, sb1, 1);
            GRP_LOAD(ub, vb, gb0, gb1, sb0, sb1, 3, 8 * j);     GRP_COMP(ua, va, ga0, ga1, sa0, sa1, 2);
            GRP_LOAD(ua, va, ga0, ga1, sa0, sa1, 0, 8 * jn);    GRP_COMP(ub, vb, gb0, gb1, sb0, sb1, 3);
        }
#undef GRP_LOAD
#undef GRP_COMP
#undef BATCH_Z
#pragma unroll
        for (int u = 0; u < 4; ++u) {
            const int t = tok0 + 4 * wid + u, b = t / SEQ; const float* mod = (const float*)(F.ws + WS_MOD) + (size_t)b * 6144;
            const float gfu = gf[u];
#pragma unroll
            for (int bq = 0; bq < 4; ++bq) { const int c0 = 256 * bq + 64 * kqa + 4 * nq;
                const u32x2 xw = *(const LAS u32x2*)(F.lds + L_X1 + (4 * wid + u) * (DM * 2) + 2 * c0);
                const f32x4 g = *(const f32x4*)(mod + 5120 + c0); const f32x4 gmv = *(const f32x4*)(F.in[IN_G2] + c0) * (*(const f32x4*)(mod + 4096 + c0) + 1.0f);
                const f32x4 x = (f32x4){bflo(xw[0]), bfhi(xw[0]), bflo(xw[1]), bfhi(xw[1])} * (f32x4){__builtin_amdgcn_rcpf(gmv.x), __builtin_amdgcn_rcpf(gmv.y), __builtin_amdgcn_rcpf(gmv.z), __builtin_amdgcn_rcpf(gmv.w)};
                __builtin_nontemporal_store(x + g * (D[u][bq] * gfu), (f32x4*)(F.out + (size_t)t * DM + c0)); }
        }
    }
}
__device__ __forceinline__ void peer_phase(Frame& F) {
    for (int u = F.bid; u < T / TOK; u += F.G) {
        const int tok0 = u * TOK;
        route_head(F, tok0);
        __syncthreads();
        expert_tokens(F, tok0);
        __syncthreads();
    }
}
}

__global__ void __launch_bounds__(NTHREADS, 2) hybrid_fwd(Args args) {
    extern __shared__ __attribute__((aligned(16))) unsigned char lds_raw[];
    cg::grid_group grid = cg::this_grid();
    Frame F;
    F.lds = (LAS unsigned char*)lds_raw; F.ws = args.ws;
    F.tid = threadIdx.x; F.lane = F.tid & 63; F.wave = __builtin_amdgcn_readfirstlane(F.tid >> 6);
    F.G = gridDim.x; F.bid = blockIdx.x;
#pragma unroll
    for (int i = 0; i < 24; ++i) F.in[i] = args.in[i];
    F.out = args.out;
    unsigned char* ws = args.ws;
    const int lo = args.ph_lo, hi = args.ph_hi;
#define IN(k) (lo <= (k) && (k) < hi)
    unsigned nbar = 0; unsigned* barctr = (unsigned*)(ws + WS_BAR);
    volatile LAS unsigned* xst = (volatile LAS unsigned*)(F.lds + LDS_BYTES - 64);
    if (F.tid < 2) xst[F.tid] = 0u;
    __syncthreads();
    XcdBarrier xbar; xbar.bar = barctr; xbar.x = 0; xbar.st = xst;
#define SEAM(k) do { if (IN(k) && IN((k) + 1)) { if ((k) == 0) { asm volatile("s_waitcnt vmcnt(0) lgkmcnt(0)" ::: "memory"); __syncthreads(); grid.sync(); \
        __builtin_amdgcn_fence(__ATOMIC_ACQUIRE, "agent"); asm volatile("s_waitcnt vmcnt(0)" ::: "memory"); __syncthreads(); xbar = xcd_barrier_post(barctr, xst); } \
        else { ++nbar; grid_barrier(barctr, nbar * (unsigned)F.G); } } } while (0)
    if (IN(0)) { phase0(F); __syncthreads(); }
    SEAM(0);
    if (IN(1)) { phase1(F); }
    SEAM(1);
    if (IN(2)) {
        pg8::StaticOrder S; S.init((const bf16_t*)(ws + WS_XN), (const bf16_t*)(ws + WS_WIN), T, IN_PAD, DM, F.G, F.bid);
        EpiIn E{ws, F.in[IN_GAQ], F.in[IN_GAK], F.in[IN_GIDXK], F.in[IN_GMK]};
        pg8::gemm_phase(F.lds, DM, S, E);
    }
    SEAM(2);
    if (IN(3)) {
        { pg8::StaticOrder S; S.init((const bf16_t*)(ws + WS_CQ), (const bf16_t*)(ws + WS_WQUP), T, 768, QRANK, F.G, F.bid);
          EpiQup E{ws, F.in[IN_GMQ]}; pg8::gemm_phase(F.lds, QRANK, S, E); }
        { pg8::StaticOrder S; S.init((const bf16_t*)(ws + WS_CKV), (const bf16_t*)(ws + WS_WKVUP), T, 1024, KVRANK, F.G, F.bid);
          EpiKVup E{ws, F.in[IN_GMK]}; pg8::gemm_phase(F.lds, KVRANK, S, E); }
        indexer_phase(F);
    }
    SEAM(3);
    if (IN(4)) { att::attn_phase(F); }
    SEAM(4);
    if (IN(5)) {
        cvt_i4_rows(F.in[IN_PU], ws + WS_PU, (float*)(ws + WS_USC), PNEXP, F.bid * NWAVES + F.wave, F.G * NWAVES, F.lane);
        cvt_fp4_rows(F.in[IN_PV], ws + WS_PV, (float*)(ws + WS_VSC), PNEXP, F.bid * NWAVES + F.wave, F.G * NWAVES, F.lane);
        pg8::DualOrder S; S.A0 = (const char*)(ws + WS_QA); S.B0 = (const char*)(ws + WS_WOA); S.A1 = (const char*)(ws + WS_QMN); S.B1 = (const char*)(ws + WS_WOM);
        S.nM = T / 256; S.nN = DM / 256; S.G = F.G; S.c = F.bid; S.tstep = (size_t)256 * AW * 2;
        EpiMerge E{ws}; pg8::gemm_phase<true>(F.lds, AW, S, E);
    }
    SEAM(5);
    if (IN(6)) {
        pg8::StaticOrder S; S.init((const bf16_t*)(ws + WS_MIXED), (const bf16_t*)(ws + WS_WOUT), T, DM, DM, F.G, F.bid);
        EpiOut E{ws, F.in[IN_X], F.out, F.in[IN_G2]}; pg8::gemm_phase(F.lds, DM, S, E);
    }
    SEAM(6);
    if (IN(7)) {
        pg8::StaticOrder S; S.init((const bf16_t*)(ws + WS_X1G), (const bf16_t*)(ws + WS_WPQ), T, 2048, DM, F.G, F.bid);
        EpiPQ E{ws}; pg8::gemm_phase(F.lds, DM, S, E);
    }
    SEAM(7);
    if (IN(8)) { peer::peer_phase(F); }
#undef IN
#undef SEAM
}

extern "C" void kernel_launch(void* const* d_in, const int* in_sizes, int n_in, void* d_out, int out_size, void* d_ws, size_t ws_size, hipStream_t stream) {
    static int grid = 0;
    if (grid == 0) {
        if (n_in != 24 || out_size != T * DM || ws_size < WS_END) { fprintf(stderr, "kernel_launch: unexpected shapes (n_in %d, out %d, ws %zu < %zu)\n", n_in, out_size, ws_size, (size_t)WS_END); grid = -1; return; }
        int dev = 0, cus = 0, per_cu = 0;
        (void)hipGetDevice(&dev); (void)hipDeviceGetAttribute(&cus, hipDeviceAttributeMultiprocessorCount, dev);
        if (hipFuncSetAttribute((const void*)hybrid_fwd, hipFuncAttributeMaxDynamicSharedMemorySize, LDS_BYTES) != hipSuccess) { fprintf(stderr, "kernel_launch: hipFuncSetAttribute failed\n"); grid = -1; return; }
        if (hipOccupancyMaxActiveBlocksPerMultiprocessor(&per_cu, (const void*)hybrid_fwd, NTHREADS, LDS_BYTES) != hipSuccess || per_cu < 1) { fprintf(stderr, "kernel_launch: occupancy query says %d blocks/CU\n", per_cu); (void)hipGetLastError(); per_cu = 1; }
        grid = cus * (per_cu < 1 ? 1 : 1);
        fprintf(stderr, "kernel_launch: grid %d (cus %d, occupancy %d/CU)\n", grid, cus, per_cu);
    }
    if (grid < 0) return;
    Args a{};
    for (int i = 0; i < 24; ++i) a.in[i] = (const float*)d_in[i];
    a.out = (float*)d_out; a.ws = (unsigned char*)d_ws;
    a.ph_lo = 0; a.ph_hi = 9;
    void* kargs[] = {&a};
    hipError_t e = hipLaunchCooperativeKernel((const void*)hybrid_fwd, dim3(grid), dim3(NTHREADS), kargs, LDS_BYTES, stream);
    if (e != hipSuccess) fprintf(stderr, "kernel_launch: cooperative launch failed: %s (grid %d)\n", hipGetErrorString(e), grid);
}
```
